# Optimizing an MI355X kernel written in HIP

```python
import jax, jax.numpy as jnp
from jax import lax
import numpy as np

D_MODEL = 1024
BATCH = 8
SEQ = 4096
DEPTH = 1

MLA_HEADS = 8
MLA_NOPE = 64
MLA_ROPE = 32
MLA_QK = MLA_NOPE + MLA_ROPE
MLA_V = 64
Q_LORA = 256
KV_LORA = 128
ROPE_THETA = 10000.0
Q_BLOCK = 128
RWKV_HEADS = 8
RWKV_HEAD = 64
RWKV_WIDTH = RWKV_HEADS * RWKV_HEAD
DECAY_LORA = 64
AAA_LORA = 64
GATE_LORA = 128
RWKV_SLAB = 3 * RWKV_WIDTH + DECAY_LORA + AAA_LORA + GATE_LORA
GN_EPS = 64e-5
IN_SIZES = (Q_LORA, KV_LORA, MLA_ROPE, RWKV_SLAB, D_MODEL, D_MODEL)
D_IN = sum(IN_SIZES)
N_EXPERTS = 32
TOP_K = 4
D_FF = D_MODEL
SWIGLU_LIMIT = 7.0
SWIGLU_ALPHA = 1.702
EXPERT_BLOCK = 128
NORM_EPS = 1e-6

kernel_name = 'hybrid_mla_rwkv7_moe_adaln'


def _split(x, sizes):
    return jnp.split(x, np.cumsum(sizes)[:-1].tolist(), axis=-1)


def rms_norm(x, w):
    xf = x.astype(jnp.float32)
    y = xf * lax.rsqrt(jnp.mean(xf * xf, axis=-1, keepdims=True) + NORM_EPS)
    return (y * w.astype(jnp.float32)).astype(x.dtype)


def modulate(x, norm_w, shift, scale):
    return rms_norm(x, norm_w) * (1.0 + scale[:, None, :]) + shift[:, None, :]


def apply_rope(x, positions):
    half = x.shape[-1] // 2
    inv_freq = ROPE_THETA ** (-jnp.arange(half, dtype=jnp.float32) / half)
    ang = positions.astype(jnp.float32)[:, :, None] * inv_freq
    cos = jnp.cos(ang)[:, :, None, :]
    sin = jnp.sin(ang)[:, :, None, :]
    xf = x.astype(jnp.float32)
    x1, x2 = xf[..., :half], xf[..., half:]
    return jnp.concatenate([x1 * cos - x2 * sin, x2 * cos + x1 * sin], axis=-1).astype(x.dtype)


def causal_attention(q, k, v):
    B, S, H, Dq = q.shape
    scale = Dq ** -0.5
    outs = []
    for i in range(S // Q_BLOCK):
        lo, hi = i * Q_BLOCK, (i + 1) * Q_BLOCK
        s = jnp.einsum('bqhd,bkhd->bhqk', q[:, lo:hi], k[:, :hi],
                       preferred_element_type=jnp.float32) * scale
        q_pos = lo + jnp.arange(Q_BLOCK)
        k_pos = jnp.arange(hi)
        s = jnp.where(k_pos[None, :] <= q_pos[:, None], s, -jnp.inf)
        p = jax.nn.softmax(s, axis=-1).astype(v.dtype)
        outs.append(jnp.einsum('bhqk,bkhd->bqhd', p, v[:, :hi]))
    return jnp.concatenate(outs, axis=1)


def mla_branch(c_q, c_kv, k_rope, positions, q_a_norm_w, w_q_up, kv_a_norm_w, w_kv_up,
               q_norm_w, k_norm_w, w_o_mla):
    B, S, _ = c_q.shape
    q = (rms_norm(c_q, q_a_norm_w) @ w_q_up).reshape(B, S, MLA_HEADS, MLA_QK)
    kv = (rms_norm(c_kv, kv_a_norm_w) @ w_kv_up).reshape(B, S, MLA_HEADS, MLA_NOPE + MLA_V)
    k_nope, v = kv[..., :MLA_NOPE], kv[..., MLA_NOPE:]
    k_rope = jnp.broadcast_to(k_rope[:, :, None, :], (B, S, MLA_HEADS, MLA_ROPE)).astype(k_nope.dtype)
    k = jnp.concatenate([k_nope, k_rope], axis=-1)
    q = rms_norm(q, q_norm_w)
    k = rms_norm(k, k_norm_w)
    q = jnp.concatenate([q[..., :MLA_NOPE], apply_rope(q[..., MLA_NOPE:], positions)], axis=-1)
    k = jnp.concatenate([k[..., :MLA_NOPE], apply_rope(k[..., MLA_NOPE:], positions)], axis=-1)
    o = causal_attention(q, k, v)
    return o.reshape(B, S, MLA_HEADS * MLA_V) @ w_o_mla


def wkv7_scan(r, decay, k, v, a_vec, b_vec):
    B, S, H, N = r.shape

    def step(state, inp):
        r_t, w_t, k_t, v_t, a_t, b_t = inp
        sa = jnp.einsum('bhvk,bhk->bhv', state, a_t)
        state = (state * w_t[:, :, None, :] + sa[..., None] * b_t[:, :, None, :]
                 + v_t[..., None] * k_t[:, :, None, :])
        y = jnp.einsum('bhvk,bhk->bhv', state, r_t)
        return state, y

    xs = tuple(jnp.moveaxis(t.astype(jnp.float32), 1, 0) for t in (r, decay, k, v, a_vec, b_vec))
    s0 = jnp.zeros((B, H, N, N), jnp.float32)
    _, ys = lax.scan(step, s0, xs)
    return jnp.moveaxis(ys, 0, 1)


def rwkv7_branch(slab, rwkv_mu, w0, w2, a0, a2, g2, k_k, k_a, r_k, ln_w, ln_b, w_o):
    B, S, _ = slab.shape
    p = slab.astype(jnp.float32)
    prev = jnp.pad(p[:, :-1], ((0, 0), (1, 0), (0, 0)))
    p = p + (prev - p) * rwkv_mu
    r, k, v, w_lo, a_lo, g_lo = _split(
        p, (RWKV_WIDTH, RWKV_WIDTH, RWKV_WIDTH, DECAY_LORA, AAA_LORA, GATE_LORA))
    log_w = -jax.nn.softplus(-(w0 + jnp.tanh(w_lo) @ w2)) - 0.5
    decay = jnp.exp(-jnp.exp(log_w.astype(jnp.float32)))
    a = jax.nn.sigmoid(a0 + a_lo @ a2)
    g = jax.nn.sigmoid(g_lo) @ g2

    def heads(t):
        return t.reshape(B, S, RWKV_HEADS, RWKV_HEAD).astype(jnp.float32)

    kk = heads(k * k_k)
    kk = kk / jnp.maximum(jnp.sqrt(jnp.sum(kk * kk, axis=-1, keepdims=True)), 1e-12)
    k = k * (1.0 + (a - 1.0) * k_a)
    rh, kh, vh, ah = heads(r), heads(k), heads(v), heads(a)
    y = wkv7_scan(rh, heads(decay), kh, vh, -kk, kk * ah)
    mu = jnp.mean(y, axis=-1, keepdims=True)
    var = jnp.mean(jnp.square(y - mu), axis=-1, keepdims=True)
    y = ((y - mu) * lax.rsqrt(var + GN_EPS)).reshape(B, S, RWKV_WIDTH) * ln_w + ln_b
    bonus = jnp.sum(rh * kh * r_k, axis=-1, keepdims=True) * vh
    y = (y + bonus.reshape(B, S, RWKV_WIDTH)) * g
    return y @ w_o


def hybrid_mixer(h, positions, w_in, q_a_norm_w, w_q_up, kv_a_norm_w, w_kv_up, q_norm_w, k_norm_w,
                 w_o_mla, rwkv_mu, rwkv_w0, rwkv_w2, rwkv_a0, rwkv_a2, rwkv_g2, rwkv_k_k, rwkv_k_a,
                 rwkv_r_k, rwkv_ln_w, rwkv_ln_b, rwkv_w_o, w_out):
    c_q, c_kv, k_rope, slab, gate_a, gate_b = _split(h @ w_in, IN_SIZES)
    o_a = mla_branch(c_q, c_kv, k_rope, positions, q_a_norm_w, w_q_up, kv_a_norm_w, w_kv_up,
                     q_norm_w, k_norm_w, w_o_mla)
    o_b = rwkv7_branch(slab, rwkv_mu, rwkv_w0, rwkv_w2, rwkv_a0, rwkv_a2, rwkv_g2, rwkv_k_k,
                       rwkv_k_a, rwkv_r_k, rwkv_ln_w, rwkv_ln_b, rwkv_w_o)
    merged = (jax.nn.sigmoid(gate_a.astype(jnp.float32)) * o_a.astype(jnp.float32)
              + jax.nn.sigmoid(gate_b.astype(jnp.float32)) * o_b.astype(jnp.float32))
    return merged.astype(h.dtype) @ w_out


def moe_ffn(h, w_router, b_router, w_gate_up, b_gate_up, w_down, b_down):
    B, S, D = h.shape
    T = B * S
    n_assign = T * TOP_K
    hf = h.reshape(T, D)
    logits = jnp.dot(hf, w_router, preferred_element_type=jnp.float32) + b_router.astype(jnp.float32)
    top_v, top_e = lax.top_k(logits, TOP_K)
    top_w = jax.nn.softmax(top_v, axis=-1)
    flat_e = top_e.reshape(-1)
    flat_tok = jnp.arange(n_assign, dtype=jnp.int32) // TOP_K
    order = jnp.argsort(flat_e)
    sorted_e = flat_e[order]
    counts = jnp.bincount(flat_e, length=N_EXPERTS)
    padded = (counts + EXPERT_BLOCK - 1) // EXPERT_BLOCK * EXPERT_BLOCK
    pad_end = jnp.cumsum(padded)
    pad_start = pad_end - padded
    start = jnp.cumsum(counts) - counts
    dest = pad_start[sorted_e] + jnp.arange(n_assign) - start[sorted_e]
    n_rows = n_assign + N_EXPERTS * EXPERT_BLOCK
    n_blocks = n_rows // EXPERT_BLOCK
    row_tok = jnp.zeros((n_rows,), jnp.int32).at[dest].set(flat_tok[order])
    row_w = jnp.zeros((n_rows,), jnp.float32).at[dest].set(top_w.reshape(-1)[order])
    blk_e = jnp.minimum(jnp.searchsorted(pad_end, jnp.arange(n_blocks) * EXPERT_BLOCK, side='right'),
                        N_EXPERTS - 1)
    xs = hf[row_tok].reshape(n_blocks, EXPERT_BLOCK, D)

    def expert_block(args):
        xb, e = args
        gu = xb @ w_gate_up[e] + b_gate_up[e]
        gate = jnp.minimum(gu[:, 0::2], SWIGLU_LIMIT)
        up = jnp.clip(gu[:, 1::2], -SWIGLU_LIMIT, SWIGLU_LIMIT)
        act = (up + 1.0) * gate * jax.nn.sigmoid(SWIGLU_ALPHA * gate)
        return act @ w_down[e] + b_down[e]

    ys = lax.map(expert_block, (xs, blk_e)).reshape(n_rows, D)
    out = jnp.zeros((T, D), jnp.float32).at[row_tok].add(ys.astype(jnp.float32) * row_w[:, None])
    return out.reshape(B, S, D).astype(h.dtype)


def setup_inputs(seed: int = 0) -> dict:
    key = jax.random.key(seed)
    ks = iter(jax.random.split(key, 40))
    L, D = DEPTH, D_MODEL

    def nrm(shape, scale):
        return jax.random.normal(next(ks), shape, jnp.float32) * scale

    def gain(shape):
        return 1.0 + nrm(shape, 0.05)

    x = nrm((BATCH, SEQ, D), 1.0)
    c = nrm((BATCH, D), 1.0)
    offsets = jax.random.randint(next(ks), (BATCH, 1), 0, 1024, dtype=jnp.int32)
    positions = offsets + jnp.arange(SEQ, dtype=jnp.int32)[None, :]
    return dict(
        x=x, c=c, positions=positions,
        ada_w=nrm((L, D, 6 * D), 0.5 * D ** -0.5), ada_b=nrm((L, 6 * D), 0.1),
        norm_mix_w=gain((L, D)), norm_ffn_w=gain((L, D)),
        w_in=nrm((L, D, D_IN), D ** -0.5),
        q_a_norm_w=gain((L, Q_LORA)),
        w_q_up=nrm((L, Q_LORA, MLA_HEADS * MLA_QK), Q_LORA ** -0.5),
        kv_a_norm_w=gain((L, KV_LORA)),
        w_kv_up=nrm((L, KV_LORA, MLA_HEADS * (MLA_NOPE + MLA_V)), KV_LORA ** -0.5),
        q_norm_w=gain((L, MLA_QK)), k_norm_w=gain((L, MLA_QK)),
        w_o_mla=nrm((L, MLA_HEADS * MLA_V, D), (MLA_HEADS * MLA_V) ** -0.5),
        rwkv_mu=jax.random.uniform(next(ks), (L, RWKV_SLAB), jnp.float32, 0.0, 1.0),
        rwkv_w0=jax.random.uniform(next(ks), (L, RWKV_WIDTH), jnp.float32, -6.0, 1.0),
        rwkv_w2=nrm((L, DECAY_LORA, RWKV_WIDTH), 0.5 * DECAY_LORA ** -0.5),
        rwkv_a0=nrm((L, RWKV_WIDTH), 0.5),
        rwkv_a2=nrm((L, AAA_LORA, RWKV_WIDTH), 0.5 * AAA_LORA ** -0.5),
        rwkv_g2=nrm((L, GATE_LORA, RWKV_WIDTH), GATE_LORA ** -0.5),
        rwkv_k_k=0.85 + nrm((L, RWKV_WIDTH), 0.05),
        rwkv_k_a=1.0 + nrm((L, RWKV_WIDTH), 0.05),
        rwkv_r_k=nrm((L, RWKV_HEADS, RWKV_HEAD), 0.1),
        rwkv_ln_w=gain((L, RWKV_WIDTH)), rwkv_ln_b=nrm((L, RWKV_WIDTH), 0.02),
        rwkv_w_o=nrm((L, RWKV_WIDTH, D), RWKV_WIDTH ** -0.5),
        w_out=nrm((L, D, D), D ** -0.5),
        w_router=nrm((L, D, N_EXPERTS), D ** -0.5), b_router=nrm((L, N_EXPERTS), 0.01),
        w_gate_up=nrm((L, N_EXPERTS, D, 2 * D_FF), D ** -0.5),
        b_gate_up=nrm((L, N_EXPERTS, 2 * D_FF), 0.01),
        w_down=nrm((L, N_EXPERTS, D_FF, D), D_FF ** -0.5),
        b_down=nrm((L, N_EXPERTS, D), 0.01),
    )


def reference(x, c, positions, ada_w, ada_b, norm_mix_w, norm_ffn_w, w_in, q_a_norm_w, w_q_up,
              kv_a_norm_w, w_kv_up, q_norm_w, k_norm_w, w_o_mla, rwkv_mu, rwkv_w0, rwkv_w2,
              rwkv_a0, rwkv_a2, rwkv_g2, rwkv_k_k, rwkv_k_a, rwkv_r_k, rwkv_ln_w, rwkv_ln_b,
              rwkv_w_o, w_out, w_router, b_router, w_gate_up, b_gate_up, w_down, b_down):
    cond = jax.nn.silu(c)
    for l in range(DEPTH):
        mod = cond @ ada_w[l] + ada_b[l]
        shift1, scale1, gate1, shift2, scale2, gate2 = jnp.split(mod, 6, axis=-1)
        h = modulate(x, norm_mix_w[l], shift1, scale1)
        mix = hybrid_mixer(h, positions, w_in[l], q_a_norm_w[l], w_q_up[l], kv_a_norm_w[l],
                           w_kv_up[l], q_norm_w[l], k_norm_w[l], w_o_mla[l], rwkv_mu[l],
                           rwkv_w0[l], rwkv_w2[l], rwkv_a0[l], rwkv_a2[l], rwkv_g2[l], rwkv_k_k[l],
                           rwkv_k_a[l], rwkv_r_k[l], rwkv_ln_w[l], rwkv_ln_b[l], rwkv_w_o[l], w_out[l])
        x = x + (gate1[:, None, :] * mix).astype(x.dtype)
        h = modulate(x, norm_ffn_w[l], shift2, scale2)
        ffn = moe_ffn(h, w_router[l], b_router[l], w_gate_up[l], b_gate_up[l], w_down[l], b_down[l])
        x = x + (gate2[:, None, :] * ffn).astype(x.dtype)
    return x
```

```cpp
#include <hip/hip_runtime.h>
#include <cstdio>
#include <cstdint>
#include <cmath>
#include <cstring>
#ifndef MODE
#define MODE 0
#endif
#define GAS __attribute__((address_space(1)))
#define LAS __attribute__((address_space(3)))
typedef unsigned short bf16_t;
typedef short bf16x8 __attribute__((ext_vector_type(8)));
typedef short s16x4 __attribute__((ext_vector_type(4)));
typedef float f32x4 __attribute__((ext_vector_type(4)));
typedef float f32x2 __attribute__((ext_vector_type(2)));
typedef float f32x16 __attribute__((ext_vector_type(16)));
typedef unsigned u32x4 __attribute__((ext_vector_type(4)));
typedef unsigned u32x2 __attribute__((ext_vector_type(2)));

__device__ __forceinline__ unsigned cvt_pk_bf16(float lo, float hi) { unsigned r; asm volatile("v_cvt_pk_bf16_f32 %0, %1, %2" : "=v"(r) : "v"(lo), "v"(hi)); return r; }
__device__ __forceinline__ float bf_lo(unsigned w) { return __uint_as_float(w << 16); }
__device__ __forceinline__ float bf_hi(unsigned w) { return __uint_as_float(w & 0xffff0000u); }
__device__ __forceinline__ float fsigmoid(float x) { return 1.f / (1.f + __expf(-x)); }
__device__ __forceinline__ float wave_sum(float v) {
#pragma unroll
    for (int o = 1; o < 64; o <<= 1) v += __shfl_xor(v, o);
    return v;
}
__device__ __forceinline__ float sum8(float v) { v += __shfl_xor(v, 1); v += __shfl_xor(v, 2); v += __shfl_xor(v, 4); return v; }

namespace pg8 {
constexpr int BM = 256, BK = 64, HALF = 128, HTB = HALF * BK * 2, STAGE_BYTES = 8 * HTB, NXCD = 8, WGM = 8;
__host__ __device__ __forceinline__ int lds_byte(int r, int c) { const int st = (r >> 4) * 2 + (c >> 5), rr = r & 15, cc = c & 31, ob = rr * 64 + cc * 2; return st * 1024 + (ob ^ (((ob >> 9) & 1) << 5)); }
__host__ __device__ __forceinline__ void stage_rc(int b, int& R, int& C) { const int st = b / 1024, sb = b % 1024, swz = sb ^ (((sb >> 9) & 1) << 5); R = (st >> 1) * 16 + swz / 64; C = (st & 1) * 32 + (swz % 64) / 2; }
__host__ __device__ __forceinline__ int perm32(int rho) { const int n = rho >> 4, i = rho & 15; return 8 * (i >> 2) + 4 * n + (i & 3); }

struct Unit { int pm, pn, e; };
struct Gemm { const bf16_t* A; const bf16_t* Bt; int M, N, K; size_t bgs; };

struct StaticOrder {
    static constexpr bool GATHER = false;
    int nM, nN, nwg, G, c;
    __device__ void init(int M, int N, int G_, int c_) { nM = M / BM; nN = N / BM; nwg = nM * nN; G = G_; c = c_; }
    __device__ bool next(int i, Unit& u) const {
        const long L = (long)i * G + c; if (L >= nwg) return false;
        int wgid = (int)L; { const int q = nwg / NXCD, r = nwg % NXCD, xcd = wgid % NXCD, off = wgid / NXCD; wgid = (xcd < r ? xcd * (q + 1) : r * (q + 1) + (xcd - r) * q) + off; }
        const int nig = WGM * nN, gid = wgid / nig, fm = gid * WGM, gsz = (nM - fm) < WGM ? (nM - fm) : WGM;
        u.pm = fm + ((wgid % nig) % gsz); u.pn = (wgid % nig) / gsz; u.e = 0; return true;
    }
    __device__ __forceinline__ int arow(int, int) const { return 0; }
};
template <int NPN, bool GATH> struct MoeOrder {
    static constexpr bool GATHER = GATH;
    const LAS int* tpre; const LAS int* rowtab; int G, c;
    __device__ bool next(int i, Unit& u) const {
        const int L = i * G + c; const int total = tpre[32] * NPN; if (L >= total) return false;
        const int mt = L / NPN; u.pm = mt; u.pn = L % NPN; int e = 0;
#pragma unroll 1
        for (int k = 1; k < 32; ++k) e += (tpre[k] <= mt) ? 1 : 0;
        u.e = e; return true;
    }
    __device__ __forceinline__ int arow(int ui, int r) const { return rowtab[ui * 256 + r]; }
};

template <class Epi, class Sched, bool ALIGN_EPI = true>
__device__ __forceinline__ void gemm_phase(LAS unsigned char* lds, const Gemm g, const Sched& S, const Epi& E) {
    const int tid = threadIdx.x, wid = __builtin_amdgcn_readfirstlane(tid >> 6), lane = tid & 63, wr = wid >> 2, wc = wid & 3, fr = lane & 15, fq = lane >> 4;
    const int K = g.K, nt = K / BK;
    unsigned voffA[2], voffB[2];
#pragma unroll
    for (int i = 0; i < 2; ++i) { int R, C; stage_rc(tid * 16 + i * 8192, R, C); const int Rb = Epi::PERM ? ((R & ~31) + perm32(R & 31)) : R;
        voffA[i] = (unsigned)(R * K + C) * 2u; voffB[i] = (unsigned)(Rb * K + C) * 2u; }
    const size_t kstep = (size_t)(BK * 2);
    const size_t hstep = (size_t)HALF * K * 2;
    const size_t tstep = 2 * hstep;
    const unsigned ldsw = (unsigned)wid * 1024u;
    const int aoff = lds_byte(wr * 64 + fr, fq * 8), boff = lds_byte(wc * 32 + fr, fq * 8);
#define PG8_SA(b, h) (((b) * 2 + (h)) * HTB)
#define PG8_SB(b, h) ((4 + (b) * 2 + (h)) * HTB)
#define PG8_STAGE(bufoff, gbase, voff) do { _Pragma("unroll") for (int _i = 0; _i < 2; ++_i) \
        __builtin_amdgcn_global_load_lds((const unsigned*)((const char*)(gbase) + (voff)[_i]), (LAS unsigned*)(lds + (bufoff) + ldsw + _i * 8192), 16, 0, 0); } while (0)
#define PG8_LDA(dst, b, h) do { _Pragma("unroll") for (int m = 0; m < 4; ++m) _Pragma("unroll") for (int k = 0; k < 2; ++k) dst[m][k] = *(const LAS bf16x8*)(lds + PG8_SA(b, h) + aoff + m * 2048 + k * 1024); } while (0)
#define PG8_LDB(dst, b, h) do { _Pragma("unroll") for (int n = 0; n < 2; ++n) _Pragma("unroll") for (int k = 0; k < 2; ++k) dst[n][k] = *(const LAS bf16x8*)(lds + PG8_SB(b, h) + boff + n * 2048 + k * 1024); } while (0)
#define PG8_MMA(ai, bj, At, Bt) do { __builtin_amdgcn_s_setprio(1); _Pragma("unroll") for (int m = 0; m < 4; ++m) _Pragma("unroll") for (int n = 0; n < 2; ++n) _Pragma("unroll") for (int k = 0; k < 2; ++k) \
        acc[ai][bj][m][n] = __builtin_amdgcn_mfma_f32_16x16x32_bf16(Bt[n][k], At[m][k], acc[ai][bj][m][n], 0, 0, 0); __builtin_amdgcn_s_setprio(0); } while (0)
#define PG8_WAIT_V(n) asm volatile("s_waitcnt vmcnt(" #n ")" ::: "memory")
#define PG8_WAIT_L(n) asm volatile("s_waitcnt lgkmcnt(" #n ")" ::: "memory")
#define PG8_BAR __builtin_amdgcn_s_barrier()
#define PG8_SCHED __builtin_amdgcn_sched_barrier(0)
    Unit cur, nxt; int ui = 0;
    if (!S.next(0, cur)) return;
    f32x4 acc[2][2][4][2];
#pragma unroll
    for (int a = 0; a < 2; ++a)
#pragma unroll
        for (int b = 0; b < 2; ++b)
#pragma unroll
            for (int m = 0; m < 4; ++m)
#pragma unroll
                for (int n = 0; n < 2; ++n) acc[a][b][m][n] = (f32x4){0.f, 0.f, 0.f, 0.f};
    bf16x8 At[4][2], B0[2][2], B1[2][2];
    unsigned ga0[2], ga1[2];
    const char* cA; const char* cB = (const char*)g.Bt + (size_t)cur.e * g.bgs + (size_t)cur.pn * tstep;
#define PG8_GOFF(dst0, dst1, uidx) do { _Pragma("unroll") for (int _i = 0; _i < 2; ++_i) { int _R, _C; stage_rc(tid * 16 + _i * 8192, _R, _C); \
        dst0[_i] = (unsigned)S.arow((uidx), _R) * (unsigned)(K * 2) + (unsigned)_C * 2u; dst1[_i] = (unsigned)S.arow((uidx), HALF + _R) * (unsigned)(K * 2) + (unsigned)_C * 2u; } } while (0)
    if constexpr (Sched::GATHER) { cA = (const char*)g.A; PG8_GOFF(ga0, ga1, 0); }
    else { cA = (const char*)g.A + (size_t)cur.pm * tstep; }
#define PG8_STAGE_A(bufoff, kptr, h, offs) do { if constexpr (Sched::GATHER) { PG8_STAGE(bufoff, kptr, offs); } else { PG8_STAGE(bufoff, (kptr) + (h) * hstep, voffA); } } while (0)
    PG8_STAGE(PG8_SB(0, 0), cB, voffB); PG8_STAGE(PG8_SB(0, 1), cB + hstep, voffB); PG8_STAGE_A(PG8_SA(0, 0), cA, 0, ga0); PG8_STAGE_A(PG8_SA(0, 1), cA, 1, ga1);
    if (wr == 1) PG8_BAR;
    PG8_WAIT_V(2); PG8_BAR;
    PG8_STAGE(PG8_SB(1, 0), cB + kstep, voffB); PG8_STAGE_A(PG8_SA(1, 0), cA + kstep, 0, ga0); PG8_STAGE(PG8_SB(1, 1), cB + hstep + kstep, voffB);
    PG8_WAIT_V(6); PG8_BAR;
#pragma unroll 1
    for (;;) {
        const bool has_next = S.next(ui + 1, nxt);
        const char* nA; const char* nB;
        if constexpr (Sched::GATHER) nA = cA; else nA = has_next ? (const char*)g.A + (size_t)nxt.pm * tstep : cA;
        nB = has_next ? (const char*)g.Bt + (size_t)nxt.e * g.bgs + (size_t)nxt.pn * tstep : cB;
#pragma unroll 1
        for (int t = 0; t < nt; t += 2) {
            const bool last = (t == nt - 2);
            const char* a1 = cA + (size_t)(t + 1) * kstep;
            const char* a2 = last ? nA : cA + (size_t)(t + 2) * kstep; const char* b2 = last ? nB : cB + (size_t)(t + 2) * kstep;
            const char* a3 = a2 + kstep; const char* b3 = b2 + kstep;
            unsigned x0[2], x1[2];
            if constexpr (Sched::GATHER) { if (last && has_next) { PG8_GOFF(x0, x1, ui + 1); } else {
#pragma unroll
                for (int i = 0; i < 2; ++i) { x0[i] = ga0[i]; x1[i] = ga1[i]; } } }
            PG8_LDB(B0, 0, 0); PG8_LDB(B1, 0, 1); PG8_SCHED; PG8_LDA(At, 0, 0); PG8_STAGE_A(PG8_SA(1, 1), a1, 1, ga1);
            PG8_WAIT_V(8); PG8_WAIT_L(0); PG8_BAR; PG8_MMA(0, 0, At, B0); PG8_MMA(0, 1, At, B1); PG8_BAR; PG8_SCHED;
            PG8_LDA(At, 0, 1); PG8_STAGE(PG8_SB(0, 0), b2, voffB); PG8_STAGE(PG8_SB(0, 1), b2 + hstep, voffB); PG8_STAGE_A(PG8_SA(0, 0), a2, 0, x0);
            PG8_WAIT_V(8); PG8_WAIT_L(0); PG8_BAR; PG8_MMA(1, 0, At, B0); PG8_MMA(1, 1, At, B1); PG8_BAR; PG8_SCHED;
            PG8_LDB(B0, 1, 0); PG8_LDB(B1, 1, 1); PG8_SCHED; PG8_LDA(At, 1, 0); PG8_STAGE_A(PG8_SA(0, 1), a2, 1, x1);
            PG8_WAIT_V(8); PG8_WAIT_L(0); PG8_BAR; PG8_MMA(0, 0, At, B0); PG8_MMA(0, 1, At, B1); PG8_BAR; PG8_SCHED;
            PG8_LDA(At, 1, 1); PG8_STAGE(PG8_SB(1, 0), b3, voffB); PG8_STAGE(PG8_SB(1, 1), b3 + hstep, voffB); PG8_STAGE_A(PG8_SA(1, 0), a3, 0, x0);
            PG8_WAIT_V(8); PG8_WAIT_L(0); PG8_BAR; PG8_MMA(1, 0, At, B0); PG8_MMA(1, 1, At, B1); PG8_BAR; PG8_SCHED;
        }
        if constexpr (ALIGN_EPI) { if (wr == 0) PG8_BAR; }
        E(acc, cur, wr, wc, fr, fq);
        if (!has_next) break;
#pragma unroll
        for (int a = 0; a < 2; ++a)
#pragma unroll
            for (int b = 0; b < 2; ++b)
#pragma unroll
                for (int m = 0; m < 4; ++m)
#pragma unroll
                    for (int n = 0; n < 2; ++n) acc[a][b][m][n] = (f32x4){0.f, 0.f, 0.f, 0.f};
        cur = nxt; cA = nA; cB = nB; ++ui;
        if constexpr (Sched::GATHER) { PG8_GOFF(ga0, ga1, ui); }
        if constexpr (ALIGN_EPI) { if (wr == 1) PG8_BAR; }
    }
    PG8_WAIT_V(0);
    if constexpr (!ALIGN_EPI) { if (wr == 0) PG8_BAR; }
    PG8_BAR;
#undef PG8_SA
#undef PG8_SB
#undef PG8_STAGE
#undef PG8_STAGE_A
#undef PG8_GOFF
#undef PG8_LDA
#undef PG8_LDB
#undef PG8_MMA
#undef PG8_WAIT_V
#undef PG8_WAIT_L
#undef PG8_BAR
#undef PG8_SCHED
}
}

#define XB_TMO      128
#define XB_XCNT(j)  (256  + 64 * (j))
#define XB_XSUB(j)  (1280 + 64 * (j))
#define XB_XGEN(j)  (2304 + 64 * (j))
#define XB_TOP      3328
#define XB_TOPGEN   3392
#define XCD_BAR_WORDS 3456
#define XB_SPIN_CAP (1u << 25)
__device__ __forceinline__ unsigned xb_ld(unsigned* p)              { return __hip_atomic_load(p, __ATOMIC_RELAXED, __HIP_MEMORY_SCOPE_AGENT); }
__device__ __forceinline__ unsigned xb_add(unsigned* p, unsigned v) { return __hip_atomic_fetch_add(p, v, __ATOMIC_RELAXED, __HIP_MEMORY_SCOPE_AGENT); }
__device__ __forceinline__ unsigned xb_xcc_id() { return (unsigned)__builtin_amdgcn_s_getreg((3 << 11) | 20) & 0xFu; }
#define XB_SPIN(cond, bar) do { unsigned _sp = 0; while (cond) { __builtin_amdgcn_s_sleep(1); \
    if ((++_sp & 255u) == 0u) { if (xb_ld(&(bar)[XB_TMO])) break; if (_sp > XB_SPIN_CAP) { atomicAdd(&(bar)[XB_TMO], 1u); break; } } } } while (0)
struct XcdBarrier { unsigned* bar; unsigned x; volatile LAS unsigned* st; };
__device__ __forceinline__ XcdBarrier xcd_barrier_post(unsigned* bar, volatile LAS unsigned* st) {
    XcdBarrier b; b.bar = bar; b.x = xb_xcc_id(); b.st = st;
    if (threadIdx.x == 0) (void)xb_add(&bar[XB_XCNT(b.x)], 1u);
    return b;
}
__device__ __forceinline__ void xcd_barrier_complete(unsigned* bar, unsigned x, unsigned& nloc, unsigned& nx) {
    const unsigned G = gridDim.x * gridDim.y * gridDim.z;
    unsigned sum, cnt, mine, sp = 0u;
    for (;;) {
        sum = 0u; cnt = 0u; mine = 0u;
#pragma unroll
        for (unsigned j = 0; j < 16; ++j) { const unsigned c = xb_ld(&bar[XB_XCNT(j)]); sum += c; cnt += (c > 0u) ? 1u : 0u; mine = (j == x) ? c : mine; }
        if (sum == G) break;
        __builtin_amdgcn_s_sleep(1);
        if ((++sp & 255u) == 0u) { if (xb_ld(&bar[XB_TMO])) break; if (sp > XB_SPIN_CAP) { atomicAdd(&bar[XB_TMO], 1u); break; } }
    }
    nloc = mine > 0u ? mine : 1u; nx = cnt > 0u ? cnt : 1u;
}
__device__ __forceinline__ void xcd_barrier(const XcdBarrier& b) {
    asm volatile("s_waitcnt vmcnt(0)" ::: "memory");
    __syncthreads();
    if (threadIdx.x == 0) {
        unsigned* bar = b.bar;
        __builtin_amdgcn_s_waitcnt(0);
        unsigned nloc = b.st[0], nx = b.st[1];
        if (nloc == 0u) { xcd_barrier_complete(bar, b.x, nloc, nx); b.st[0] = nloc; b.st[1] = nx; }
        const unsigned old = xb_add(&bar[XB_XSUB(b.x)], 1u);
        const unsigned gen = old / nloc;
        if (old + 1u == (gen + 1u) * nloc) {
            __builtin_amdgcn_fence(__ATOMIC_RELEASE, "agent");
            asm volatile("s_waitcnt vmcnt(0)" ::: "memory");
            const unsigned og = xb_add(&bar[XB_TOP], 1u);
            const unsigned tg = og / nx;
            if (og + 1u == (tg + 1u) * nx) xb_add(&bar[XB_TOPGEN], 1u);
            else XB_SPIN(xb_ld(&bar[XB_TOPGEN]) == tg, bar);
            __builtin_amdgcn_fence(__ATOMIC_ACQUIRE, "agent");
            xb_add(&bar[XB_XGEN(b.x)], 1u);
            asm volatile("s_waitcnt vmcnt(0)" ::: "memory");
        } else {
            XB_SPIN(xb_ld(&bar[XB_XGEN(b.x)]) == gen, bar);
            __builtin_amdgcn_fence(__ATOMIC_ACQUIRE, "agent");
            asm volatile("s_waitcnt vmcnt(0)" ::: "memory");
        }
    }
    __syncthreads();
}

namespace fk {
constexpr int T = 32768, D = 1024, SEQ = 4096, NB = 8, NWAVES = 8, NTHR = 512;
constexpr int NPS = 2304;
constexpr int NIN = 4352;
constexpr int MAXSLOT = 131072 + 8192;
constexpr float QSCALE = 0.10206207261596577f * 1.4426950408889634f;
constexpr size_t MiB = 1u << 20;
constexpr size_t WS_CTL = 0, CTL_ZERO_BYTES = 1 * MiB;
constexpr size_t WS_MODP = 1 * MiB;
constexpr size_t WS_MOD = 4 * MiB;
constexpr size_t WS_ROPE = 5 * MiB;
constexpr size_t WS_TOPE = 9 * MiB;
constexpr size_t WS_TOPW = WS_TOPE + 512 * 1024;
constexpr size_t WS_TOKSLOT = WS_TOPW + 512 * 1024;
constexpr size_t WS_ROWTOK = WS_TOKSLOT + 512 * 1024;
constexpr size_t WS_ROWW = WS_ROWTOK + 768 * 1024;
constexpr size_t WS_HIST = WS_ROWW + 768 * 1024;
constexpr size_t WS_TPRE = WS_HIST + 64 * 1024;
constexpr size_t WS_WIN = 13 * MiB;
constexpr size_t WS_WQ = WS_WIN + (size_t)NIN * 1024 * 2;
constexpr size_t WS_WKV = WS_WQ + 768 * 256 * 2;
constexpr size_t WS_WLORA = WS_WKV + 1024 * 256 * 2;
constexpr size_t WS_WOA = WS_WLORA + 1536 * 256 * 2;
constexpr size_t WS_WOB = WS_WOA + 1024 * 512 * 2;
constexpr size_t WS_WOUT = WS_WOB + 1024 * 512 * 2;
static_assert(WS_WOUT + 1024 * 1024 * 2 <= 28 * MiB, "small weights");
constexpr size_t WS_PS = 28 * MiB;
constexpr size_t WS_H = 172 * MiB;
constexpr size_t WS_AQ = 236 * MiB, WS_AKV = 252 * MiB, WS_ALORA = 268 * MiB;
constexpr size_t WS_QRAW = 284 * MiB;
constexpr size_t WS_KVRAW = 332 * MiB;
constexpr size_t WS_DEC = 396 * MiB;
constexpr size_t WS_AA = 460 * MiB;
constexpr size_t WS_GG = 492 * MiB;
constexpr size_t WS_Q = 524 * MiB;
constexpr size_t WS_K = 572 * MiB;
constexpr size_t WS_V = 620 * MiB;
constexpr size_t WS_SCANIN = 652 * MiB;
constexpr size_t WS_OA = 172 * MiB;
constexpr size_t WS_OBIN = 204 * MiB;
constexpr size_t WS_Y = 236 * MiB;
constexpr size_t WS_M1 = 300 * MiB;
constexpr size_t WS_MERGED = 396 * MiB;
constexpr size_t WS_WGU = 460 * MiB;
constexpr size_t WS_WDN = 588 * MiB;
constexpr size_t WS_ACT = 652 * MiB;
constexpr size_t WS_YS = 28 * MiB;
constexpr size_t WS_END = 924 * MiB;
constexpr int CW_BAR = 4096;
constexpr int RING_BYTES = 131072, MISC_OFF = RING_BYTES, XTRA_OFF = RING_BYTES + 1024, LDS_BYTES = 163840;
constexpr int NPHASE = 15;

struct Args {
    const float* in[34]; float* out; unsigned char* ws; int ph_lo, ph_hi, bar_region, pad;
};
struct Frame {
    LAS unsigned char* lds; int tid, lane, wave, vcu, G;
};

#define EPI_LOOP_BEGIN \
    _Pragma("unroll") for (int ai = 0; ai < 2; ++ai) _Pragma("unroll") for (int m = 0; m < 4; ++m) { const int row = u.pm * 256 + ai * 128 + wr * 64 + m * 16 + fr; \
    _Pragma("unroll") for (int bj = 0; bj < 2; ++bj) { const int colt = bj * 128 + wc * 32 + 8 * fq; const f32x4 v0 = acc[ai][bj][m][0], v1 = acc[ai][bj][m][1];
#define EPI_LOOP_END } }
__device__ __forceinline__ u32x4 pack8(f32x4 a, f32x4 b) { u32x4 w; w.x = cvt_pk_bf16(a[0], a[1]); w.y = cvt_pk_bf16(a[2], a[3]); w.z = cvt_pk_bf16(b[0], b[1]); w.w = cvt_pk_bf16(b[2], b[3]); return w; }
__device__ __forceinline__ void unpack8(u32x4 w, f32x4& a, f32x4& b) { a = (f32x4){bf_lo(w.x), bf_hi(w.x), bf_lo(w.y), bf_hi(w.y)}; b = (f32x4){bf_lo(w.z), bf_hi(w.z), bf_lo(w.w), bf_hi(w.w)}; }
__device__ __forceinline__ f32x4 sig4(f32x4 v) { return (f32x4){fsigmoid(v[0]), fsigmoid(v[1]), fsigmoid(v[2]), fsigmoid(v[3])}; }

struct EpiP {
    static constexpr bool PERM = true; bf16_t* PS; bf16_t* Gt;
    __device__ __forceinline__ void operator()(const f32x4 (&acc)[2][2][4][2], const pg8::Unit& u, int wr, int wc, int fr, int fq) const {
        const bool gate = u.pn >= 9;
        EPI_LOOP_BEGIN
            if (gate) { *(u32x4*)(Gt + (size_t)row * 2048 + (u.pn - 9) * 256 + colt) = pack8(sig4(v0), sig4(v1)); }
            else { *(u32x4*)(PS + (size_t)row * NPS + u.pn * 256 + colt) = pack8(v0, v1); }
        EPI_LOOP_END
    }
};
struct EpiPlain {
    static constexpr bool PERM = true; bf16_t* O; int ldc;
    __device__ __forceinline__ void operator()(const f32x4 (&acc)[2][2][4][2], const pg8::Unit& u, int wr, int wc, int fr, int fq) const {
        EPI_LOOP_BEGIN
            *(u32x4*)(O + (size_t)row * ldc + u.pn * 256 + colt) = pack8(v0, v1);
        EPI_LOOP_END
    }
};
struct EpiLora {
    static constexpr bool PERM = true; float* DEC; bf16_t* AA; bf16_t* GG;
    __device__ __forceinline__ void operator()(const f32x4 (&acc)[2][2][4][2], const pg8::Unit& u, int wr, int wc, int fr, int fq) const {
        const int kind = u.pn >> 1; const int cb = (u.pn & 1) * 256; bf16_t* O = (kind == 1) ? AA : GG;
        EPI_LOOP_BEGIN
            const int c = cb + colt;
            if (kind == 0) { *(f32x4*)(DEC + (size_t)row * 512 + c) = v0; *(f32x4*)(DEC + (size_t)row * 512 + c + 4) = v1; }
            else { *(u32x4*)(O + (size_t)row * 512 + c) = pack8(v0, v1); }
        EPI_LOOP_END
    }
};
struct EpiOA {
    static constexpr bool PERM = true; const bf16_t* Gt; bf16_t* M1;
    __device__ __forceinline__ void operator()(const f32x4 (&acc)[2][2][4][2], const pg8::Unit& u, int wr, int wc, int fr, int fq) const {
        EPI_LOOP_BEGIN
            const int c = u.pn * 256 + colt; f32x4 g0, g1; unpack8(*(const u32x4*)(Gt + (size_t)row * 2048 + c), g0, g1);
            *(u32x4*)(M1 + (size_t)row * 1024 + c) = pack8(g0 * v0, g1 * v1);
        EPI_LOOP_END
    }
};
struct EpiOB {
    static constexpr bool PERM = true; const bf16_t* Gt; const bf16_t* M1; bf16_t* MG;
    __device__ __forceinline__ void operator()(const f32x4 (&acc)[2][2][4][2], const pg8::Unit& u, int wr, int wc, int fr, int fq) const {
        EPI_LOOP_BEGIN
            const int c = u.pn * 256 + colt; f32x4 g0, g1, p0, p1; unpack8(*(const u32x4*)(Gt + (size_t)row * 2048 + 1024 + c), g0, g1); unpack8(*(const u32x4*)(M1 + (size_t)row * 1024 + c), p0, p1);
            *(u32x4*)(MG + (size_t)row * 1024 + c) = pack8(p0 + g0 * v0, p1 + g1 * v1);
        EPI_LOOP_END
    }
};
struct EpiOut {
    static constexpr bool PERM = true; const float* x; const float* mod; float* out;
    __device__ __forceinline__ void operator()(const f32x4 (&acc)[2][2][4][2], const pg8::Unit& u, int wr, int wc, int fr, int fq) const {
        const float* g1p = mod + (size_t)((u.pm * 256) >> 12) * 6144 + 2 * 1024;
        EPI_LOOP_BEGIN
            const int c = u.pn * 256 + colt; const size_t o = (size_t)row * 1024 + c;
            const f32x4 ga = *(const f32x4*)(g1p + c), gb = *(const f32x4*)(g1p + c + 4), xa = *(const f32x4*)(x + o), xb = *(const f32x4*)(x + o + 4);
            *(f32x4*)(out + o) = xa + ga * v0; *(f32x4*)(out + o + 4) = xb + gb * v1;
        EPI_LOOP_END
    }
};
struct EpiGU {
    static constexpr bool PERM = true; const float* bias; bf16_t* ACT;
    __device__ __forceinline__ void operator()(const f32x4 (&acc)[2][2][4][2], const pg8::Unit& u, int wr, int wc, int fr, int fq) const {
        const float* bp = bias + (size_t)u.e * 2048;
        EPI_LOOP_BEGIN
            const int c = u.pn * 256 + colt; const f32x4 b0 = *(const f32x4*)(bp + c), b1 = *(const f32x4*)(bp + c + 4); const f32x4 a = v0 + b0, b = v1 + b1;
            float g[4] = {a[0], a[2], b[0], b[2]}, up[4] = {a[1], a[3], b[1], b[3]}, r[4];
#pragma unroll
            for (int j = 0; j < 4; ++j) { const float gt = fminf(g[j], 7.f), uu = fminf(fmaxf(up[j], -7.f), 7.f); r[j] = (uu + 1.f) * gt * fsigmoid(1.702f * gt); }
            u32x2 w; w.x = cvt_pk_bf16(r[0], r[1]); w.y = cvt_pk_bf16(r[2], r[3]);
            *(u32x2*)(ACT + (size_t)row * 1024 + (c >> 1)) = w;
        EPI_LOOP_END
    }
};
struct EpiDN {
    static constexpr bool PERM = true; const float* bias; const float* roww; bf16_t* YS;
    __device__ __forceinline__ void operator()(const f32x4 (&acc)[2][2][4][2], const pg8::Unit& u, int wr, int wc, int fr, int fq) const {
        const float* bp = bias + (size_t)u.e * 1024;
        EPI_LOOP_BEGIN
            const int c = u.pn * 256 + colt; const f32x4 b0 = *(const f32x4*)(bp + c), b1 = *(const f32x4*)(bp + c + 4); const float w = roww[row];
            *(u32x4*)(YS + (size_t)row * 1024 + c) = pack8((v0 + b0) * w, (v1 + b1) * w);
        EPI_LOOP_END
    }
};

__device__ __forceinline__ void transpose_item(const float* W, int N, bf16_t* WT, int ldk, int koff, int row_off, LAS float* scr, int kb, int nb, int lane) {
    const int k0 = 64 * kb, n0 = 32 * nb;
#pragma unroll 8
    for (int i = 0; i < 32; ++i) { const int kk = 2 * i + (lane >> 5); scr[kk * 33 + (lane & 31)] = W[(size_t)(k0 + kk) * N + n0 + (lane & 31)]; }
    asm volatile("s_waitcnt lgkmcnt(0)" ::: "memory");
    const int c = lane & 7;
#pragma unroll
    for (int j = 0; j < 4; ++j) { const int n = (lane >> 3) + 8 * j; const LAS float* s = scr + (8 * c) * 33 + n;
        u32x4 o; o.x = cvt_pk_bf16(s[0 * 33], s[1 * 33]); o.y = cvt_pk_bf16(s[2 * 33], s[3 * 33]); o.z = cvt_pk_bf16(s[4 * 33], s[5 * 33]); o.w = cvt_pk_bf16(s[6 * 33], s[7 * 33]);
        *(u32x4*)(WT + (size_t)(row_off + n0 + n) * ldk + koff + k0 + 8 * c) = o; }
    asm volatile("s_waitcnt lgkmcnt(0)" ::: "memory");
}
__device__ __forceinline__ bool tr_try(int& r, const float* W, int K, int N, bf16_t* WT, int ldk, int koff, int row_off, LAS float* scr, int lane) {
    const int nblk = N / 32, items = (K / 64) * nblk;
    if (r < items) { transpose_item(W, N, WT, ldk, koff, row_off, scr, r / nblk, r % nblk, lane); return true; }
    r -= items; return false;
}
__device__ __forceinline__ void zero_block(bf16_t* WT, int ldk, int r0, int nr, int k0, int k1, int gthread, int nthreads) {
    const int per = (k1 - k0) / 8; const int total = nr * per;
    for (int i = gthread; i < total; i += nthreads) { const int r = i / per, c = i % per; *(u32x4*)(WT + (size_t)(r0 + r) * ldk + k0 + 8 * c) = (u32x4){0u, 0u, 0u, 0u}; }
}

__device__ __forceinline__ int crow(int r, int hi) { return (r & 3) + 8 * (r >> 2) + 4 * hi; }
constexpr int AT_KB = 12288, AT_VB = 8192, AT_BUF = AT_KB + AT_VB;
constexpr int AT_WSF = 2 * AT_BUF, AT_OST = AT_WSF + NWAVES * 256, AT_LDS = AT_OST + NWAVES * 4096;
__device__ __forceinline__ void attn_stage(LAS unsigned char* lds, int buf, const bf16_t* Kt, const bf16_t* Vt, int wid, int lane) {
    LAS unsigned char* kb = lds + buf * AT_BUF; LAS unsigned char* vb = kb + AT_KB;
    __builtin_amdgcn_global_load_lds((const unsigned*)((const char*)Kt + wid * 1024 + lane * 16), (LAS unsigned*)(kb + wid * 1024), 16, 0, 0);
    if (wid < 4) __builtin_amdgcn_global_load_lds((const unsigned*)((const char*)Kt + (8 + wid) * 1024 + lane * 16), (LAS unsigned*)(kb + (8 + wid) * 1024), 16, 0, 0);
    __builtin_amdgcn_global_load_lds((const unsigned*)((const char*)Vt + wid * 1024 + lane * 16), (LAS unsigned*)(vb + wid * 1024), 16, 0, 0);
}
__device__ __forceinline__ void attn_unit(LAS unsigned char* lds, int bh, int qb, const bf16_t* Q, const bf16_t* Kg, const bf16_t* Vg, bf16_t* OA) {
    const int tid = threadIdx.x, lane = tid & 63, r32 = lane & 31, hi = lane >> 5; const int wid = __builtin_amdgcn_readfirstlane(tid >> 6);
    const int b = bh >> 3, h = bh & 7; const int q0 = qb * 256;
    const bf16_t* Qw = Q + ((size_t)bh * SEQ + q0 + wid * 32) * 96;
    const bf16_t* Kt = Kg + (size_t)bh * 64 * 6144; const bf16_t* Vt = Vg + (size_t)bh * 64 * 4096;
    LAS float* wsf = (LAS float*)(lds + AT_WSF) + wid * 64;
    const int NT = 4 * (qb + 1);
    __syncthreads();
    attn_stage(lds, 0, Kt, Vt, wid, lane);
    bf16x8 qr[6];
#pragma unroll
    for (int d0 = 0; d0 < 6; ++d0) qr[d0] = *(const bf16x8*)(Qw + (size_t)r32 * 96 + d0 * 16 + hi * 8);
    float mrun = -1e30f, lrun = 0.f; f32x16 o0 = {}, o1 = {};
    const int qrel = wid * 32 + r32;
    for (int t = 0; t < NT; ++t) {
        asm volatile("s_waitcnt vmcnt(0)" ::: "memory"); __syncthreads();
        if (t + 1 < NT) attn_stage(lds, (t + 1) & 1, Kt + (size_t)(t + 1) * 6144, Vt + (size_t)(t + 1) * 4096, wid, lane);
        const LAS unsigned char* kb = lds + (t & 1) * AT_BUF + hi * 1024 + r32 * 16; const LAS unsigned char* vbase = lds + (t & 1) * AT_BUF + AT_KB;
        f32x16 p0 = {}, p1 = {};
#pragma unroll
        for (int d0 = 0; d0 < 6; ++d0) { const bf16x8 a0 = *(const LAS bf16x8*)(kb + d0 * 2048), a1 = *(const LAS bf16x8*)(kb + d0 * 2048 + 512);
            p0 = __builtin_amdgcn_mfma_f32_32x32x16_bf16(a0, qr[d0], p0, 0, 0, 0); p1 = __builtin_amdgcn_mfma_f32_32x32x16_bf16(a1, qr[d0], p1, 0, 0, 0); }
        const int jb = t - (NT - 4);
        if (jb >= 0) { const int kbase = 64 * jb + 4 * hi;
#pragma unroll
            for (int r = 0; r < 16; ++r) { const int kv = kbase + (r & 3) + 8 * (r >> 2); if (kv > qrel) p0[r] = -INFINITY; if (kv + 32 > qrel) p1[r] = -INFINITY; } }
        float rm = p0[0];
#pragma unroll
        for (int r = 1; r < 16; ++r) rm = fmaxf(rm, p0[r]);
#pragma unroll
        for (int r = 0; r < 16; ++r) rm = fmaxf(rm, p1[r]);
        rm = fmaxf(rm, __shfl_xor(rm, 32));
        const float mnew = fmaxf(mrun, rm); const float alpha = __builtin_amdgcn_exp2f(mrun - mnew); mrun = mnew;
        float ps = 0.f;
#pragma unroll
        for (int r = 0; r < 16; ++r) { p0[r] = __builtin_amdgcn_exp2f(p0[r] - mnew); p1[r] = __builtin_amdgcn_exp2f(p1[r] - mnew); ps += p0[r] + p1[r]; }
        lrun = lrun * alpha + ps;
        if (hi == 0) wsf[r32] = alpha;
        asm volatile("s_waitcnt lgkmcnt(0)" ::: "memory");
#pragma unroll
        for (int r = 0; r < 16; ++r) { const float f = wsf[crow(r, hi)]; o0[r] *= f; o1[r] *= f; }
        bf16x8 pa[4];
#pragma unroll
        for (int s = 0; s < 2; ++s) { u32x4 w0, w1;
            w0.x = cvt_pk_bf16(p0[8 * s + 0], p0[8 * s + 1]); w0.y = cvt_pk_bf16(p0[8 * s + 2], p0[8 * s + 3]); w0.z = cvt_pk_bf16(p0[8 * s + 4], p0[8 * s + 5]); w0.w = cvt_pk_bf16(p0[8 * s + 6], p0[8 * s + 7]);
            w1.x = cvt_pk_bf16(p1[8 * s + 0], p1[8 * s + 1]); w1.y = cvt_pk_bf16(p1[8 * s + 2], p1[8 * s + 3]); w1.z = cvt_pk_bf16(p1[8 * s + 4], p1[8 * s + 5]); w1.w = cvt_pk_bf16(p1[8 * s + 6], p1[8 * s + 7]);
            pa[s] = __builtin_bit_cast(bf16x8, w0); pa[2 + s] = __builtin_bit_cast(bf16x8, w1); }
        const LAS unsigned char* vp = vbase + ((lane >> 4) & 1) * 32 + (lane & 3) * 8 + (4 * hi + ((lane & 15) >> 2)) * 64;
#pragma unroll
        for (int d0 = 0; d0 < 2; ++d0)
#pragma unroll
            for (int ks = 0; ks < 4; ++ks) {
                const s16x4 lo = __builtin_bit_cast(s16x4, __builtin_amdgcn_ds_read_tr16_b64_v4i16((LAS s16x4*)(vp + d0 * 4096 + ks * 1024)));
                const s16x4 hh = __builtin_bit_cast(s16x4, __builtin_amdgcn_ds_read_tr16_b64_v4i16((LAS s16x4*)(vp + d0 * 4096 + ks * 1024 + 512)));
                const bf16x8 vf = (bf16x8){lo[0], lo[1], lo[2], lo[3], hh[0], hh[1], hh[2], hh[3]};
                if (d0 == 0) o0 = __builtin_amdgcn_mfma_f32_32x32x16_bf16(pa[ks], vf, o0, 0, 0, 0); else o1 = __builtin_amdgcn_mfma_f32_32x32x16_bf16(pa[ks], vf, o1, 0, 0, 0);
            }
    }
    lrun += __shfl_xor(lrun, 32);
    if (hi == 0) wsf[32 + r32] = 1.f / lrun;
    asm volatile("s_waitcnt lgkmcnt(0)" ::: "memory");
    LAS bf16_t* stg = (LAS bf16_t*)(lds + AT_OST) + wid * 2048;
#pragma unroll
    for (int r = 0; r < 16; ++r) { const int orow = crow(r, hi); const float il = wsf[32 + orow];
        stg[orow * 64 + r32] = (bf16_t)(cvt_pk_bf16(o0[r] * il, 0.f) & 0xffffu); stg[orow * 64 + 32 + r32] = (bf16_t)(cvt_pk_bf16(o1[r] * il, 0.f) & 0xffffu); }
    asm volatile("s_waitcnt lgkmcnt(0)" ::: "memory");
    bf16_t* Ow = OA + ((size_t)b * SEQ + q0 + wid * 32) * 512 + h * 64;
#pragma unroll
    for (int i = 0; i < 4; ++i) { const int row = i * 8 + (lane >> 3), ch = lane & 7; const u32x4 v = *(const LAS u32x4*)(stg + row * 64 + ch * 8); *(u32x4*)(Ow + (size_t)row * 512 + ch * 8) = v; }
}

constexpr int SC_CH = 32;
constexpr int SC_BUF = SC_CH * 384 * 4;
constexpr int SC_Y = 2 * SC_BUF;
__device__ __forceinline__ void scan_unit(LAS unsigned char* lds, int bh, const bf16_t* SIN, float* Y) {
    const int tid = threadIdx.x, v = tid >> 3, kq = tid & 7; const int b = bh >> 3, h = bh & 7;
    const bf16_t* src = SIN + (size_t)bh * SEQ * 384;
    float S[8];
#pragma unroll
    for (int i = 0; i < 8; ++i) S[i] = 0.f;
    u32x4 st[3];
    auto load_chunk = [&](int c) {
#pragma unroll
        for (int j = 0; j < 3; ++j) st[j] = *(const u32x4*)((const char*)src + (size_t)c * (SC_CH * 768) + (size_t)(j * 512 + tid) * 16); };
    auto write_chunk = [&](int buf) { LAS float* dst = (LAS float*)(lds + buf * SC_BUF);
#pragma unroll
        for (int j = 0; j < 3; ++j) { const int e0 = (j * 512 + tid) * 8; f32x4 a, bq; unpack8(st[j], a, bq); *(LAS f32x4*)(dst + e0) = a; *(LAS f32x4*)(dst + e0 + 4) = bq; } };
    __syncthreads();
    load_chunk(0); write_chunk(0);
    const int NCH = SEQ / SC_CH;
    LAS float* yb = (LAS float*)(lds + SC_Y);
    for (int c = 0; c < NCH; ++c) {
        __syncthreads();
        if (c + 1 < NCH) load_chunk(c + 1);
        const LAS float* in = (const LAS float*)(lds + (c & 1) * SC_BUF);
#pragma unroll 2
        for (int t = 0; t < SC_CH; ++t) {
            const LAS float* p = in + t * 384 + 8 * kq;
            const f32x4 r0 = *(const LAS f32x4*)(p), r1 = *(const LAS f32x4*)(p + 4);
            const f32x4 x0 = *(const LAS f32x4*)(p + 64), x1 = *(const LAS f32x4*)(p + 68);
            const f32x4 k0 = *(const LAS f32x4*)(p + 128), k1 = *(const LAS f32x4*)(p + 132);
            const f32x4 n0 = *(const LAS f32x4*)(p + 256), n1 = *(const LAS f32x4*)(p + 260);
            const f32x4 b0 = *(const LAS f32x4*)(p + 320), b1 = *(const LAS f32x4*)(p + 324);
            const float vv = in[t * 384 + 192 + v];
            float sa = (S[0] * n0[0] + S[1] * n0[1]) + (S[2] * n0[2] + S[3] * n0[3]) + (S[4] * n1[0] + S[5] * n1[1]) + (S[6] * n1[2] + S[7] * n1[3]);
            sa = -sum8(sa);
            float yy = 0.f;
#pragma unroll
            for (int i = 0; i < 4; ++i) { S[i] = S[i] - S[i] * x0[i] + sa * b0[i] + vv * k0[i]; S[4 + i] = S[4 + i] - S[4 + i] * x1[i] + sa * b1[i] + vv * k1[i]; }
            yy = (S[0] * r0[0] + S[1] * r0[1]) + (S[2] * r0[2] + S[3] * r0[3]) + (S[4] * r1[0] + S[5] * r1[1]) + (S[6] * r1[2] + S[7] * r1[3]);
            yy = sum8(yy);
            if (kq == 0) yb[t * 64 + v] = yy;
        }
        __syncthreads();
        { const int e0 = tid * 4; const int t = e0 >> 6, vv0 = e0 & 63; const f32x4 yv = *(const LAS f32x4*)(yb + e0);
          *(f32x4*)(Y + ((size_t)b * SEQ + (size_t)c * SC_CH + t) * 512 + h * 64 + vv0) = yv; }
        if (c + 1 < NCH) write_chunk((c + 1) & 1);
    }
}
}

namespace fk {
#define LDSW() asm volatile("s_waitcnt lgkmcnt(0)" ::: "memory")

__device__ __forceinline__ void phase_p0(const Frame& F, const Args& a) {
    unsigned char* ws = a.ws;
    LAS float* scr = (LAS float*)(F.lds + F.wave * 16384);
    const int gw = F.vcu * NWAVES + F.wave, NGW = F.G * NWAVES;
    const int gthread = gw * 64 + F.lane, nthreads = NGW * 64;
    bf16_t* WinT = (bf16_t*)(ws + WS_WIN); bf16_t* WqT = (bf16_t*)(ws + WS_WQ); bf16_t* WkvT = (bf16_t*)(ws + WS_WKV); bf16_t* WloT = (bf16_t*)(ws + WS_WLORA);
    bf16_t* WoaT = (bf16_t*)(ws + WS_WOA); bf16_t* WobT = (bf16_t*)(ws + WS_WOB); bf16_t* WoutT = (bf16_t*)(ws + WS_WOUT);
    constexpr int I_IN = 16 * 133;
    constexpr int NITEMS = I_IN + 96 + 64 + 16 + 16 + 32 + 256 + 256 + 512;
    for (int it = gw; it < NITEMS; it += NGW) {
        int r = it;
        if (r < I_IN) { const int kb = r / 133, nb = r % 133; transpose_item(a.in[7], 4256, WinT, 1024, 0, (nb >= 13) ? 96 : 0, scr, kb, nb, F.lane); continue; } r -= I_IN;
        if (tr_try(r, a.in[9], 256, 768, WqT, 256, 0, 0, scr, F.lane)) continue;
        if (tr_try(r, a.in[11], 128, 1024, WkvT, 256, 0, 0, scr, F.lane)) continue;
        if (tr_try(r, a.in[17], 64, 512, WloT, 256, 0, 0, scr, F.lane)) continue;
        if (tr_try(r, a.in[19], 64, 512, WloT, 256, 64, 512, scr, F.lane)) continue;
        if (tr_try(r, a.in[20], 128, 512, WloT, 256, 128, 1024, scr, F.lane)) continue;
        if (tr_try(r, a.in[14], 512, 1024, WoaT, 512, 0, 0, scr, F.lane)) continue;
        if (tr_try(r, a.in[26], 512, 1024, WobT, 512, 0, 0, scr, F.lane)) continue;
        tr_try(r, a.in[27], 1024, 1024, WoutT, 1024, 0, 0, scr, F.lane);
    }
    zero_block(WinT, 1024, 416, 96, 0, 1024, gthread, nthreads);
    zero_block(WkvT, 256, 0, 1024, 128, 256, gthread, nthreads);
    zero_block(WloT, 256, 0, 512, 64, 256, gthread, nthreads);
    zero_block(WloT, 256, 512, 512, 0, 64, gthread, nthreads);
    zero_block(WloT, 256, 512, 512, 128, 256, gthread, nthreads);
    zero_block(WloT, 256, 1024, 512, 0, 128, gthread, nthreads);
    const float* c = a.in[1]; const float* ada_w = a.in[3]; float* MODP = (float*)(ws + WS_MODP);
    for (int it = gw; it < 96 * 16; it += NGW) {
        const int cg = it % 96, ks = it / 96; const int n = cg * 64 + F.lane;
        float acc[8];
#pragma unroll
        for (int b = 0; b < 8; ++b) acc[b] = 0.f;
        for (int k = ks * 64; k < ks * 64 + 64; ++k) { const float w = ada_w[(size_t)k * 6144 + n];
#pragma unroll
            for (int b = 0; b < 8; ++b) { const float cv = c[b * 1024 + k]; acc[b] += (cv / (1.f + __expf(-cv))) * w; } }
#pragma unroll
        for (int b = 0; b < 8; ++b) MODP[((size_t)ks * 8 + b) * 6144 + n] = acc[b];
    }
    const int* pos = (const int*)a.in[2]; float* ROPE = (float*)(ws + WS_ROPE);
    for (int i = gthread; i < T * 16; i += nthreads) { const int t = i >> 4, j = i & 15; const float inv = powf(10000.f, -(float)j / 16.f); const float ang = (float)pos[t] * inv;
        ROPE[(size_t)t * 32 + j] = cosf(ang); ROPE[(size_t)t * 32 + 16 + j] = sinf(ang); }
}

__device__ __forceinline__ void load_row16(const float* xr, int lane, f32x4 (&v)[4]) {
#pragma unroll
    for (int j = 0; j < 4; ++j) v[j] = *(const f32x4*)(xr + 4 * lane + 256 * j);
}
__device__ __forceinline__ void phase_p1(const Frame& F, const Args& a) {
    unsigned char* ws = a.ws; const float* MODP = (const float*)(ws + WS_MODP); float* MOD = (float*)(ws + WS_MOD); const float* ada_b = a.in[4];
    const int wg = F.vcu;
    if (F.tid < 192) { const int i = wg * 192 + F.tid; const int b = i / 6144, n = i % 6144; float s = ada_b[n];
#pragma unroll
        for (int ks = 0; ks < 16; ++ks) s += MODP[((size_t)ks * 8 + b) * 6144 + n];
        MOD[i] = s; }
    const int b = (wg * 128) >> 12; LAS float* LA = (LAS float*)F.lds; LAS float* LB = LA + 1024; const float* nw = a.in[5];
    for (int i = F.tid; i < 1024; i += NTHR) { float sh = ada_b[i], sc = ada_b[1024 + i];
#pragma unroll
        for (int ks = 0; ks < 16; ++ks) { sh += MODP[((size_t)ks * 8 + b) * 6144 + i]; sc += MODP[((size_t)ks * 8 + b) * 6144 + 1024 + i]; }
        LA[i] = nw[i] * (1.f + sc); LB[i] = sh; }
    __syncthreads();
    const float* x = a.in[0]; bf16_t* H = (bf16_t*)(ws + WS_H);
    for (int rr = 0; rr < 16; ++rr) { const int row = wg * 128 + F.wave * 16 + rr; f32x4 v[4]; load_row16(x + (size_t)row * 1024, F.lane, v); float ss = 0.f;
#pragma unroll
        for (int j = 0; j < 4; ++j) ss += (v[j][0] * v[j][0] + v[j][1] * v[j][1]) + (v[j][2] * v[j][2] + v[j][3] * v[j][3]);
        const float rstd = rsqrtf(wave_sum(ss) * (1.f / 1024.f) + 1e-6f);
#pragma unroll
        for (int j = 0; j < 4; ++j) { const f32x4 A = *(const LAS f32x4*)(LA + 4 * F.lane + 256 * j), B = *(const LAS f32x4*)(LB + 4 * F.lane + 256 * j); const f32x4 o = v[j] * rstd * A + B;
            u32x2 w; w.x = cvt_pk_bf16(o[0], o[1]); w.y = cvt_pk_bf16(o[2], o[3]); *(u32x2*)(H + (size_t)row * 1024 + 4 * F.lane + 256 * j) = w; } }
}

__device__ __forceinline__ f32x4 ld4bf(const bf16_t* p) { const u32x2 w = *(const u32x2*)p; return (f32x4){bf_lo(w.x), bf_hi(w.x), bf_lo(w.y), bf_hi(w.y)}; }
__device__ __forceinline__ void st4bf(bf16_t* p, f32x4 v) { u32x2 w; w.x = cvt_pk_bf16(v[0], v[1]); w.y = cvt_pk_bf16(v[2], v[3]); *(u32x2*)p = w; }
__device__ __forceinline__ void phase_p3(const Frame& F, const Args& a) {
    unsigned char* ws = a.ws; const bf16_t* PS = (const bf16_t*)(ws + WS_PS); bf16_t* AQ = (bf16_t*)(ws + WS_AQ); bf16_t* AKV = (bf16_t*)(ws + WS_AKV); bf16_t* AL = (bf16_t*)(ws + WS_ALORA);
    const float* qaw = a.in[8]; const float* kvaw = a.in[10]; const float* mu = a.in[15];
    const int gw = F.vcu * NWAVES + F.wave, NGW = F.G * NWAVES, l = F.lane;
    const f32x4 wq = *(const f32x4*)(qaw + 4 * l); const f32x4 wkv = (l < 32) ? *(const f32x4*)(kvaw + 4 * l) : (f32x4){0.f, 0.f, 0.f, 0.f}; const f32x4 mul = *(const f32x4*)(mu + 1536 + 4 * l);
    for (int t = gw; t < T; t += NGW) {
        const bf16_t* ps = PS + (size_t)t * NPS;
        const f32x4 cq = ld4bf(ps + 4 * l); const f32x4 ck = (l < 32) ? ld4bf(ps + 256 + 4 * l) : (f32x4){0.f, 0.f, 0.f, 0.f};
        const f32x4 cur = ld4bf(ps + 2048 + 4 * l); const f32x4 prv = ((t & (SEQ - 1)) != 0) ? ld4bf(ps - NPS + 2048 + 4 * l) : (f32x4){0.f, 0.f, 0.f, 0.f};
        const float sq = wave_sum((cq[0] * cq[0] + cq[1] * cq[1]) + (cq[2] * cq[2] + cq[3] * cq[3])); const float sk = wave_sum((ck[0] * ck[0] + ck[1] * ck[1]) + (ck[2] * ck[2] + ck[3] * ck[3]));
        const float rq = rsqrtf(sq * (1.f / 256.f) + 1e-6f), rk = rsqrtf(sk * (1.f / 128.f) + 1e-6f);
        st4bf(AQ + (size_t)t * 256 + 4 * l, cq * rq * wq); st4bf(AKV + (size_t)t * 256 + 4 * l, ck * rk * wkv);
        f32x4 p = cur + (prv - cur) * mul;
        if (l < 16) { p = (f32x4){tanhf(p[0]), tanhf(p[1]), tanhf(p[2]), tanhf(p[3])}; } else if (l >= 32) { p = sig4(p); }
        st4bf(AL + (size_t)t * 256 + 4 * l, p);
    }
}

__device__ __forceinline__ void ld8bf(const bf16_t* p, float (&v)[8]) { const u32x4 w = *(const u32x4*)p; v[0] = bf_lo(w.x); v[1] = bf_hi(w.x); v[2] = bf_lo(w.y); v[3] = bf_hi(w.y); v[4] = bf_lo(w.z); v[5] = bf_hi(w.z); v[6] = bf_lo(w.w); v[7] = bf_hi(w.w); }
__device__ __forceinline__ void st8bf(bf16_t* p, const float (&v)[8]) { u32x4 w; w.x = cvt_pk_bf16(v[0], v[1]); w.y = cvt_pk_bf16(v[2], v[3]); w.z = cvt_pk_bf16(v[4], v[5]); w.w = cvt_pk_bf16(v[6], v[7]); *(u32x4*)p = w; }
__device__ __forceinline__ void ld8f(const float* p, float (&v)[8]) { const f32x4 a = *(const f32x4*)p, b = *(const f32x4*)(p + 4); v[0] = a[0]; v[1] = a[1]; v[2] = a[2]; v[3] = a[3]; v[4] = b[0]; v[5] = b[1]; v[6] = b[2]; v[7] = b[3]; }
__device__ __forceinline__ void phase_p5(const Frame& F, const Args& a) {
    unsigned char* ws = a.ws; const bf16_t* PS = (const bf16_t*)(ws + WS_PS); const bf16_t* QRAW = (const bf16_t*)(ws + WS_QRAW); const bf16_t* KVRAW = (const bf16_t*)(ws + WS_KVRAW);
    const float* DEC = (const float*)(ws + WS_DEC); const bf16_t* AA = (const bf16_t*)(ws + WS_AA); const float* ROPE = (const float*)(ws + WS_ROPE);
    bf16_t* Qo = (bf16_t*)(ws + WS_Q); bf16_t* Ko = (bf16_t*)(ws + WS_K); bf16_t* Vo = (bf16_t*)(ws + WS_V); bf16_t* SIN = (bf16_t*)(ws + WS_SCANIN);
    const float* qnw = a.in[12]; const float* knw = a.in[13]; const float* mu = a.in[15]; const float* k_k = a.in[21]; const float* k_a = a.in[22];
    const int gw = F.vcu * NWAVES + F.wave, NGW = F.G * NWAVES, l = F.lane, h = l >> 3, j = l & 7, c0 = h * 64 + 8 * j;
    float qw[8], kw[8]; ld8f(qnw + 8 * j, qw); ld8f(knw + 8 * j, kw);
    const float qwr0 = qnw[64 + 2 * j], qwr1 = qnw[65 + 2 * j], qwr2 = qnw[80 + 2 * j], qwr3 = qnw[81 + 2 * j];
    const float kwr0 = knw[64 + 2 * j], kwr1 = knw[65 + 2 * j], kwr2 = knw[80 + 2 * j], kwr3 = knw[81 + 2 * j];
    float mur[8], muk[8], muv[8], kkc[8], kac[8], w0c[8], a0c[8]; ld8f(mu + c0, mur); ld8f(mu + 512 + c0, muk); ld8f(mu + 1024 + c0, muv); ld8f(k_k + c0, kkc); ld8f(k_a + c0, kac); ld8f(a.in[16] + c0, w0c); ld8f(a.in[18] + c0, a0c);
    for (int t = gw; t < T; t += NGW) {
        const int b = t >> 12, s = t & (SEQ - 1), bh = b * 8 + h, key = s & 63, tile = s >> 6;
        const float cs0 = ROPE[(size_t)t * 32 + 2 * j], cs1 = ROPE[(size_t)t * 32 + 2 * j + 1], sn0 = ROPE[(size_t)t * 32 + 16 + 2 * j], sn1 = ROPE[(size_t)t * 32 + 17 + 2 * j];
        { float q[8]; ld8bf(QRAW + (size_t)t * 768 + h * 96 + 8 * j, q); const unsigned ra = *(const unsigned*)(QRAW + (size_t)t * 768 + h * 96 + 64 + 2 * j), rb = *(const unsigned*)(QRAW + (size_t)t * 768 + h * 96 + 80 + 2 * j);
          float x10 = bf_lo(ra), x11 = bf_hi(ra), x20 = bf_lo(rb), x21 = bf_hi(rb); float ss = x10 * x10 + x11 * x11 + x20 * x20 + x21 * x21;
#pragma unroll
          for (int i = 0; i < 8; ++i) ss += q[i] * q[i];
          const float rq = rsqrtf(sum8(ss) * (1.f / 96.f) + 1e-6f) * QSCALE;
#pragma unroll
          for (int i = 0; i < 8; ++i) q[i] = q[i] * rq * qw[i];
          x10 *= rq * qwr0; x11 *= rq * qwr1; x20 *= rq * qwr2; x21 *= rq * qwr3;
          bf16_t* qo = Qo + ((size_t)bh * SEQ + s) * 96; st8bf(qo + 8 * j, q);
          *(unsigned*)(qo + 64 + 2 * j) = cvt_pk_bf16(x10 * cs0 - x20 * sn0, x11 * cs1 - x21 * sn1); *(unsigned*)(qo + 80 + 2 * j) = cvt_pk_bf16(x20 * cs0 + x10 * sn0, x21 * cs1 + x11 * sn1); }
        { float k[8]; ld8bf(KVRAW + (size_t)t * 1024 + h * 128 + 8 * j, k); const unsigned ra = *(const unsigned*)(PS + (size_t)t * NPS + 384 + 2 * j), rb = *(const unsigned*)(PS + (size_t)t * NPS + 400 + 2 * j);
          float x10 = bf_lo(ra), x11 = bf_hi(ra), x20 = bf_lo(rb), x21 = bf_hi(rb); float ss = x10 * x10 + x11 * x11 + x20 * x20 + x21 * x21;
#pragma unroll
          for (int i = 0; i < 8; ++i) ss += k[i] * k[i];
          const float rk = rsqrtf(sum8(ss) * (1.f / 96.f) + 1e-6f);
#pragma unroll
          for (int i = 0; i < 8; ++i) k[i] = k[i] * rk * kw[i];
          x10 *= rk * kwr0; x11 *= rk * kwr1; x20 *= rk * kwr2; x21 *= rk * kwr3;
          bf16_t* kt = Ko + ((size_t)bh * 64 + tile) * 6144; st8bf(kt + j * 512 + key * 8, k);
          *(unsigned*)(kt + (8 + (j >> 2)) * 512 + key * 8 + ((2 * j) & 7)) = cvt_pk_bf16(x10 * cs0 - x20 * sn0, x11 * cs1 - x21 * sn1);
          *(unsigned*)(kt + (10 + (j >> 2)) * 512 + key * 8 + ((2 * j) & 7)) = cvt_pk_bf16(x20 * cs0 + x10 * sn0, x21 * cs1 + x11 * sn1); }
        { const u32x4 vv = *(const u32x4*)(KVRAW + (size_t)t * 1024 + h * 128 + 64 + 8 * j);
          *(u32x4*)(Vo + ((size_t)bh * 64 + tile) * 4096 + ((j >> 2) * 4 + (key >> 4)) * 512 + (key & 15) * 32 + 8 * (j & 3)) = vv; }
        { const bf16_t* ps = PS + (size_t)t * NPS + 512; const bool hp = s != 0;
          float r[8], k[8], v[8], pr[8], pk[8], pv[8], dec[8], aa[8];
          ld8bf(ps + c0, r); ld8bf(ps + 512 + c0, k); ld8bf(ps + 1024 + c0, v);
          if (hp) { ld8bf(ps - NPS + c0, pr); ld8bf(ps - NPS + 512 + c0, pk); ld8bf(ps - NPS + 1024 + c0, pv); }
          else {
#pragma unroll
              for (int i = 0; i < 8; ++i) { pr[i] = 0.f; pk[i] = 0.f; pv[i] = 0.f; } }
          ld8f(DEC + (size_t)t * 512 + c0, dec); ld8bf(AA + (size_t)t * 512 + c0, aa);
#pragma unroll
          for (int i = 0; i < 8; ++i) { const float z = -(w0c[i] + dec[i]); const float sp = z > 20.f ? z : __logf(1.f + __expf(z)); dec[i] = __expf(-__expf(-sp - 0.5f)); aa[i] = fsigmoid(a0c[i] + aa[i]); }
          float kk[8], kp[8], bb[8], xx[8]; float ss = 0.f;
#pragma unroll
          for (int i = 0; i < 8; ++i) { r[i] += (pr[i] - r[i]) * mur[i]; k[i] += (pk[i] - k[i]) * muk[i]; v[i] += (pv[i] - v[i]) * muv[i]; kk[i] = k[i] * kkc[i]; ss += kk[i] * kk[i]; }
          const float inv = 1.f / fmaxf(sqrtf(sum8(ss)), 1e-12f);
#pragma unroll
          for (int i = 0; i < 8; ++i) { kk[i] *= inv; kp[i] = k[i] * (1.f + (aa[i] - 1.f) * kac[i]); bb[i] = kk[i] * aa[i]; xx[i] = 1.f - dec[i]; }
          bf16_t* so = SIN + ((size_t)bh * SEQ + s) * 384 + 8 * j;
          st8bf(so, r); st8bf(so + 64, xx); st8bf(so + 128, kp); st8bf(so + 192, v); st8bf(so + 256, kk); st8bf(so + 320, bb); }
    }
}

__device__ __forceinline__ void phase_p6b(const Frame& F, const Args& a) {
    unsigned char* ws = a.ws; const float* Y = (const float*)(ws + WS_Y); const bf16_t* SIN = (const bf16_t*)(ws + WS_SCANIN); const bf16_t* GG = (const bf16_t*)(ws + WS_GG); bf16_t* OB = (bf16_t*)(ws + WS_OBIN);
    const float* r_k = a.in[23]; const float* ln_w = a.in[24]; const float* ln_b = a.in[25];
    const int gw = F.vcu * NWAVES + F.wave, NGW = F.G * NWAVES, l = F.lane, h = l >> 3, j = l & 7, c0 = h * 64 + 8 * j;
    float rkc[8], lw[8], lb[8]; ld8f(r_k + c0, rkc); ld8f(ln_w + c0, lw); ld8f(ln_b + c0, lb);
    for (int t = gw; t < T; t += NGW) {
        const int b = t >> 12, s = t & (SEQ - 1), bh = b * 8 + h;
        float y[8], r[8], kp[8], v[8], g[8]; ld8f(Y + (size_t)t * 512 + c0, y);
        const bf16_t* si = SIN + ((size_t)bh * SEQ + s) * 384 + 8 * j; ld8bf(si, r); ld8bf(si + 128, kp); ld8bf(si + 192, v); ld8bf(GG + (size_t)t * 512 + c0, g);
        float sm = 0.f, bs = 0.f;
#pragma unroll
        for (int i = 0; i < 8; ++i) { sm += y[i]; bs += r[i] * kp[i] * rkc[i]; }
        const float mean = sum8(sm) * (1.f / 64.f); bs = sum8(bs); float vs = 0.f;
#pragma unroll
        for (int i = 0; i < 8; ++i) { y[i] -= mean; vs += y[i] * y[i]; }
        const float rstd = rsqrtf(sum8(vs) * (1.f / 64.f) + 64e-5f); float o[8];
#pragma unroll
        for (int i = 0; i < 8; ++i) o[i] = (y[i] * rstd * lw[i] + lb[i] + bs * v[i]) * g[i];
        st8bf(OB + (size_t)t * 512 + c0, o);
    }
}

__device__ __forceinline__ void phase_p9(const Frame& F, const Args& a) {
    unsigned char* ws = a.ws; const float* MOD = (const float*)(ws + WS_MOD); const float* x1 = a.out; bf16_t* H = (bf16_t*)(ws + WS_H);
    int* TOPE = (int*)(ws + WS_TOPE); float* TOPW = (float*)(ws + WS_TOPW); int* HIST = (int*)(ws + WS_HIST);
    const float* nw = a.in[6]; const float* wr = a.in[28]; const float* br = a.in[29];
    const int wg = F.vcu, b = (wg * 128) >> 12, l = F.lane;
    LAS float* LWR = (LAS float*)F.lds;
    LAS float* LA = (LAS float*)(F.lds + XTRA_OFF); LAS float* LB = LA + 1024; LAS int* LH = (LAS int*)(LB + 1024);
    for (int i = F.tid; i < 32 * 1024; i += NTHR) { const int k = i >> 5, e = i & 31; LWR[e * 1024 + k] = wr[i]; }
    for (int i = F.tid; i < 1024; i += NTHR) { LA[i] = nw[i] * (1.f + MOD[(size_t)b * 6144 + 4 * 1024 + i]); LB[i] = MOD[(size_t)b * 6144 + 3 * 1024 + i]; }
    if (F.tid < 32) LH[F.tid] = 0;
    __syncthreads();
    const float mybias = br[l >> 1];
    for (int rr = 0; rr < 16; ++rr) { const int row = wg * 128 + F.wave * 16 + rr; f32x4 v[4]; load_row16(x1 + (size_t)row * 1024, l, v); float ss = 0.f;
#pragma unroll
        for (int j = 0; j < 4; ++j) ss += (v[j][0] * v[j][0] + v[j][1] * v[j][1]) + (v[j][2] * v[j][2] + v[j][3] * v[j][3]);
        const float rstd = rsqrtf(wave_sum(ss) * (1.f / 1024.f) + 1e-6f);
#pragma unroll
        for (int j = 0; j < 4; ++j) { const f32x4 A = *(const LAS f32x4*)(LA + 4 * l + 256 * j), B = *(const LAS f32x4*)(LB + 4 * l + 256 * j); v[j] = v[j] * rstd * A + B;
            u32x2 w; w.x = cvt_pk_bf16(v[j][0], v[j][1]); w.y = cvt_pk_bf16(v[j][2], v[j][3]); *(u32x2*)(H + (size_t)row * 1024 + 4 * l + 256 * j) = w; }
        float p[32];
#pragma unroll
        for (int e = 0; e < 32; ++e) { float s = 0.f;
#pragma unroll
            for (int j = 0; j < 4; ++j) { const f32x4 w = *(const LAS f32x4*)(LWR + e * 1024 + 4 * l + 256 * j); s += (v[j][0] * w[0] + v[j][1] * w[1]) + (v[j][2] * w[2] + v[j][3] * w[3]); }
            p[e] = s; }
#define TRED(N, XM) { const bool up = (l & XM) != 0; _Pragma("unroll") for (int i = 0; i < N; ++i) { const float keep = up ? p[N + i] : p[i]; const float send = up ? p[i] : p[N + i]; p[i] = keep + __shfl_xor(send, XM); } }
        TRED(16, 32) TRED(8, 16) TRED(4, 8) TRED(2, 4) TRED(1, 2)
#undef TRED
        float lg = p[0] + __shfl_xor(p[0], 1) + mybias;
        int te[4]; float tv[4];
#pragma unroll
        for (int k = 0; k < 4; ++k) { float m = lg;
#pragma unroll
            for (int o = 1; o < 64; o <<= 1) m = fmaxf(m, __shfl_xor(m, o));
            const unsigned long long bal = __ballot(lg == m); const int ln = __ffsll((long long)bal) - 1; const int e = ln >> 1;
            te[k] = e; tv[k] = m; if ((l >> 1) == e) lg = -INFINITY; }
        if (l == 0) { const float p1 = __expf(tv[1] - tv[0]), p2 = __expf(tv[2] - tv[0]), p3 = __expf(tv[3] - tv[0]); const float inv = 1.f / (1.f + p1 + p2 + p3);
            *(int4*)(TOPE + (size_t)row * 4) = make_int4(te[0], te[1], te[2], te[3]); *(float4*)(TOPW + (size_t)row * 4) = make_float4(inv, p1 * inv, p2 * inv, p3 * inv);
            __hip_atomic_fetch_add(&LH[te[0]], 1, __ATOMIC_RELAXED, __HIP_MEMORY_SCOPE_WORKGROUP); __hip_atomic_fetch_add(&LH[te[1]], 1, __ATOMIC_RELAXED, __HIP_MEMORY_SCOPE_WORKGROUP); __hip_atomic_fetch_add(&LH[te[2]], 1, __ATOMIC_RELAXED, __HIP_MEMORY_SCOPE_WORKGROUP); __hip_atomic_fetch_add(&LH[te[3]], 1, __ATOMIC_RELAXED, __HIP_MEMORY_SCOPE_WORKGROUP); }
    }
    __syncthreads();
    if (F.tid < 32) HIST[wg * 32 + F.tid] = LH[F.tid];
    __syncthreads();
    LAS float* scr = (LAS float*)(F.lds + F.wave * 16384);
    const int gw = F.vcu * NWAVES + F.wave, NGW = F.G * NWAVES;
    bf16_t* WGU = (bf16_t*)(ws + WS_WGU); bf16_t* WDN = (bf16_t*)(ws + WS_WDN);
    constexpr int IG = 16 * 64, ID = 16 * 32;
    for (int it = gw; it < 32 * (IG + ID); it += NGW) {
        if (it < 32 * IG) { const int e = it / IG, r = it % IG; transpose_item(a.in[30] + (size_t)e * 1024 * 2048, 2048, WGU + (size_t)e * 2048 * 1024, 1024, 0, 0, scr, r / 64, r % 64, l); }
        else { const int q = it - 32 * IG; const int e = q / ID, r = q % ID; transpose_item(a.in[32] + (size_t)e * 1024 * 1024, 1024, WDN + (size_t)e * 1024 * 1024, 1024, 0, 0, scr, r / 32, r % 32, l); }
    }
}

__device__ __forceinline__ void phase_p10(const Frame& F, const Args& a) {
    unsigned char* ws = a.ws; const int* HIST = (const int*)(ws + WS_HIST); const int* TOPE = (const int*)(ws + WS_TOPE); const float* TOPW = (const float*)(ws + WS_TOPW);
    int* TOKSLOT = (int*)(ws + WS_TOKSLOT); int* ROWTOK = (int*)(ws + WS_ROWTOK); float* ROWW = (float*)(ws + WS_ROWW); int* TPRE = (int*)(ws + WS_TPRE);
    LAS int* Lcnt = (LAS int*)F.lds; LAS int* Lbase = Lcnt + 32; LAS int* Lpad = Lbase + 32; LAS int* Lrun = Lpad + 33; LAS int* Lred = Lrun + 32;
    const int wg = F.vcu;
    { const int e = F.tid & 31, w0 = F.tid >> 5; int tot = 0, bas = 0;
      for (int w = w0; w < F.G; w += 16) { const int c = HIST[w * 32 + e]; tot += c; bas += (w < wg) ? c : 0; }
      Lred[w0 * 64 + e] = tot; Lred[w0 * 64 + 32 + e] = bas; }
    __syncthreads();
    if (F.tid < 32) { int tot = 0, bas = 0;
#pragma unroll
        for (int w = 0; w < 16; ++w) { tot += Lred[w * 64 + F.tid]; bas += Lred[w * 64 + 32 + F.tid]; }
        Lcnt[F.tid] = tot; Lbase[F.tid] = bas; Lrun[F.tid] = 0; }
    __syncthreads();
    if (F.tid == 0) { int acc = 0; for (int e = 0; e < 32; ++e) { Lpad[e] = acc; acc += (Lcnt[e] + 255) >> 8; } Lpad[32] = acc; }
    __syncthreads();
    if (wg == 0 && F.tid < 33) TPRE[F.tid] = Lpad[F.tid];
    { const int row = wg * 128 + (F.tid >> 2), k = F.tid & 3; const int e = TOPE[(size_t)row * 4 + k]; const float w = TOPW[(size_t)row * 4 + k];
      const int rank = __hip_atomic_fetch_add(&Lrun[e], 1, __ATOMIC_RELAXED, __HIP_MEMORY_SCOPE_WORKGROUP); const int slot = Lpad[e] * 256 + Lbase[e] + rank;
      ROWTOK[slot] = row; ROWW[slot] = w; TOKSLOT[(size_t)row * 4 + k] = slot; }
    if (wg == 0) { for (int e = 0; e < 32; ++e) { const int s0 = Lpad[e] * 256 + Lcnt[e], s1 = Lpad[e + 1] * 256; for (int s = s0 + F.tid; s < s1; s += NTHR) { ROWTOK[s] = 0; ROWW[s] = 0.f; } } }
}

__device__ __forceinline__ void phase_p13(const Frame& F, const Args& a) {
    unsigned char* ws = a.ws; const float* MOD = (const float*)(ws + WS_MOD); const bf16_t* YS = (const bf16_t*)(ws + WS_YS); const int* TOKSLOT = (const int*)(ws + WS_TOKSLOT); float* out = a.out;
    const int gw = F.vcu * NWAVES + F.wave, NGW = F.G * NWAVES, l = F.lane;
    for (int t = gw; t < T; t += NGW) { const int b = t >> 12; const int4 sl = *(const int4*)(TOKSLOT + (size_t)t * 4);
#pragma unroll
        for (int j = 0; j < 4; ++j) { const int c = 4 * l + 256 * j; const f32x4 g2 = *(const f32x4*)(MOD + (size_t)b * 6144 + 5 * 1024 + c); const f32x4 xv = *(const f32x4*)(out + (size_t)t * 1024 + c);
            const f32x4 y = (ld4bf(YS + (size_t)sl.x * 1024 + c) + ld4bf(YS + (size_t)sl.y * 1024 + c)) + (ld4bf(YS + (size_t)sl.z * 1024 + c) + ld4bf(YS + (size_t)sl.w * 1024 + c));
            *(f32x4*)(out + (size_t)t * 1024 + c) = xv + g2 * y; } }
}

__global__ void __launch_bounds__(NTHR, 2) mega(Args args) {
    extern __shared__ __attribute__((aligned(16))) unsigned char lds_raw[];
    Frame F; F.lds = (LAS unsigned char*)lds_raw; F.tid = threadIdx.x; F.lane = F.tid & 63; F.wave = __builtin_amdgcn_readfirstlane(F.tid >> 6);
    F.G = gridDim.x; { const int bx = blockIdx.x; F.vcu = (F.G % 8 == 0) ? (bx % 8) * (F.G / 8) + bx / 8 : bx; }
    volatile LAS unsigned* MISC = (volatile LAS unsigned*)(F.lds + MISC_OFF);
    unsigned char* ws = args.ws;
    for (int u = F.tid; u < 64; u += NTHR) MISC[u] = 0u;
    __syncthreads();
    const int lo = args.ph_lo, hi = args.ph_hi;
    XcdBarrier bar; bar.bar = (unsigned*)(ws + WS_CTL) + CW_BAR + args.bar_region * XCD_BAR_WORDS; bar.x = 0; bar.st = nullptr;
    if (hi - lo > 1) bar = xcd_barrier_post((unsigned*)(ws + WS_CTL) + CW_BAR + args.bar_region * XCD_BAR_WORDS, MISC + 8);
#ifndef ONLY
#define ONLY -1
#endif
#define IN(k) (lo <= (k) && (k) < hi && (ONLY < 0 || ONLY == (k)))
#define SEAM(k) do { if (IN(k) && IN((k) + 1)) xcd_barrier(bar); } while (0)
    bf16_t* Gt = (bf16_t*)args.out;
    if (IN(0)) { phase_p0(F, args); } SEAM(0);
    if (IN(1)) { phase_p1(F, args); } SEAM(1);
    if (IN(2)) { pg8::Gemm g{(const bf16_t*)(ws + WS_H), (const bf16_t*)(ws + WS_WIN), T, NIN, 1024, 0}; pg8::StaticOrder S; S.init(T, NIN, F.G, (int)blockIdx.x);
        EpiP E{(bf16_t*)(ws + WS_PS), Gt}; pg8::gemm_phase<EpiP, pg8::StaticOrder>(F.lds, g, S, E); } SEAM(2);
    if (IN(3)) { phase_p3(F, args); } SEAM(3);
    if (IN(4)) {
        { pg8::Gemm g{(const bf16_t*)(ws + WS_AQ), (const bf16_t*)(ws + WS_WQ), T, 768, 256, 0}; pg8::StaticOrder S; S.init(T, 768, F.G, (int)blockIdx.x);
          EpiPlain E{(bf16_t*)(ws + WS_QRAW), 768}; pg8::gemm_phase<EpiPlain, pg8::StaticOrder>(F.lds, g, S, E); }
        { pg8::Gemm g{(const bf16_t*)(ws + WS_AKV), (const bf16_t*)(ws + WS_WKV), T, 1024, 256, 0}; pg8::StaticOrder S; S.init(T, 1024, F.G, (int)blockIdx.x);
          EpiPlain E{(bf16_t*)(ws + WS_KVRAW), 1024}; pg8::gemm_phase<EpiPlain, pg8::StaticOrder>(F.lds, g, S, E); }
        { pg8::Gemm g{(const bf16_t*)(ws + WS_ALORA), (const bf16_t*)(ws + WS_WLORA), T, 1536, 256, 0}; pg8::StaticOrder S; S.init(T, 1536, F.G, (int)blockIdx.x);
          EpiLora E{(float*)(ws + WS_DEC), (bf16_t*)(ws + WS_AA), (bf16_t*)(ws + WS_GG)}; pg8::gemm_phase<EpiLora, pg8::StaticOrder>(F.lds, g, S, E); }
    } SEAM(4);
    if (IN(5)) { phase_p5(F, args); } SEAM(5);
    if (IN(6)) {
        if (F.vcu < 64) { scan_unit(F.lds, F.vcu, (const bf16_t*)(ws + WS_SCANIN), (float*)(ws + WS_Y)); }
        else { const int c = F.vcu - 64;
            for (int r = 0; r < 6; ++r) { const int pos = (r & 1) ? 191 - c : c; const int uidx = r * 192 + pos; if (uidx >= 1024) continue;
                const int qb = 15 - (uidx >> 6), bh = uidx & 63;
                attn_unit(F.lds, bh, qb, (const bf16_t*)(ws + WS_Q), (const bf16_t*)(ws + WS_K), (const bf16_t*)(ws + WS_V), (bf16_t*)(ws + WS_OA)); } }
    } SEAM(6);
    if (IN(7)) { phase_p6b(F, args); } SEAM(7);
    if (IN(8)) {
        { pg8::Gemm g{(const bf16_t*)(ws + WS_OA), (const bf16_t*)(ws + WS_WOA), T, 1024, 512, 0}; pg8::StaticOrder S; S.init(T, 1024, F.G, (int)blockIdx.x);
          EpiOA E{Gt, (bf16_t*)(ws + WS_M1)}; pg8::gemm_phase<EpiOA, pg8::StaticOrder>(F.lds, g, S, E); }
        { pg8::Gemm g{(const bf16_t*)(ws + WS_OBIN), (const bf16_t*)(ws + WS_WOB), T, 1024, 512, 0}; pg8::StaticOrder S; S.init(T, 1024, F.G, (int)blockIdx.x);
          EpiOB E{Gt, (const bf16_t*)(ws + WS_M1), (bf16_t*)(ws + WS_MERGED)}; pg8::gemm_phase<EpiOB, pg8::StaticOrder>(F.lds, g, S, E); }
    } SEAM(8);
    if (IN(9)) { pg8::Gemm g{(const bf16_t*)(ws + WS_MERGED), (const bf16_t*)(ws + WS_WOUT), T, 1024, 1024, 0}; pg8::StaticOrder S; S.init(T, 1024, F.G, (int)blockIdx.x);
        EpiOut E{args.in[0], (const float*)(ws + WS_MOD), args.out}; pg8::gemm_phase<EpiOut, pg8::StaticOrder>(F.lds, g, S, E); } SEAM(9);
    if (IN(10)) { phase_p9(F, args); } SEAM(10);
    if (IN(11)) { phase_p10(F, args); } SEAM(11);
    if (IN(12) || IN(13)) {
        LAS int* tpre = (LAS int*)(F.lds + XTRA_OFF); LAS int* rowtab = tpre + 64;
        const int* TPRE = (const int*)(ws + WS_TPRE); const int* ROWTOK = (const int*)(ws + WS_ROWTOK);
        if (F.tid < 33) tpre[F.tid] = TPRE[F.tid];
        __syncthreads();
        if (IN(12)) {
            pg8::MoeOrder<8, true> S; S.tpre = tpre; S.rowtab = rowtab; S.G = F.G; S.c = F.vcu;
            { pg8::Unit u; for (int i = 0; S.next(i, u); ++i) { if (F.tid < 256) rowtab[i * 256 + F.tid] = ROWTOK[u.pm * 256 + F.tid]; } }
            __syncthreads();
            pg8::Gemm g{(const bf16_t*)(ws + WS_H), (const bf16_t*)(ws + WS_WGU), MAXSLOT, 2048, 1024, (size_t)2048 * 1024 * 2};
            EpiGU E{args.in[31], (bf16_t*)(ws + WS_ACT)}; pg8::gemm_phase<EpiGU, pg8::MoeOrder<8, true>>(F.lds, g, S, E);
        }
        SEAM(12);
        if (IN(13)) {
            pg8::MoeOrder<4, false> S; S.tpre = tpre; S.rowtab = rowtab; S.G = F.G; S.c = F.vcu;
            pg8::Gemm g{(const bf16_t*)(ws + WS_ACT), (const bf16_t*)(ws + WS_WDN), MAXSLOT, 1024, 1024, (size_t)1024 * 1024 * 2};
            EpiDN E{args.in[33], (const float*)(ws + WS_ROWW), (bf16_t*)(ws + WS_YS)}; pg8::gemm_phase<EpiDN, pg8::MoeOrder<4, false>>(F.lds, g, S, E);
        }
    }
    SEAM(13);
    if (IN(14)) { phase_p13(F, args); }
#undef IN
#undef SEAM
}

static int g_grid = 0;
inline bool host_init(size_t ws_size) {
    if (g_grid) return g_grid > 0;
    int dev = 0, cus = 0;
    if (hipGetDevice(&dev) != hipSuccess || hipDeviceGetAttribute(&cus, hipDeviceAttributeMultiprocessorCount, dev) != hipSuccess) { g_grid = -1; return false; }
    if (hipFuncSetAttribute((const void*)mega, hipFuncAttributeMaxDynamicSharedMemorySize, LDS_BYTES) != hipSuccess) { fprintf(stderr, "hipFuncSetAttribute failed\n"); g_grid = -1; return false; }
    if (ws_size < WS_END) { fprintf(stderr, "workspace too small: %zu < %zu\n", ws_size, (size_t)WS_END); g_grid = -1; return false; }
    (void)hipGetLastError();
    g_grid = cus;
    if (g_grid != 256) fprintf(stderr, "note: %d CUs (kernel tuned for 256)\n", g_grid);
    return true;
}
inline void fill_args(Args& a, void* const* d_in, void* d_out, void* d_ws) { memset(&a, 0, sizeof(a)); for (int i = 0; i < 34; ++i) a.in[i] = (const float*)d_in[i]; a.out = (float*)d_out; a.ws = (unsigned char*)d_ws; }
inline void launch_range(hipStream_t st, Args a, int lo, int hi, int region) { a.ph_lo = lo; a.ph_hi = hi; a.bar_region = region; hipLaunchKernelGGL(mega, dim3(g_grid), dim3(NTHR), LDS_BYTES, st, a); }
}

#if MODE == 2
namespace orc {
constexpr int D = 1024, SEQ = 4096, NB = 8;
constexpr int DIN = 4256, SLAB = 1792;
constexpr int OFF_CQ = 0, OFF_CKV = 256, OFF_KR = 384, OFF_SLAB = 416, OFF_GA = 2208, OFF_GB = 3232;

__device__ __forceinline__ float sigmoidf_(float x) { return 1.f / (1.f + expf(-x)); }
__device__ __forceinline__ float softplusf_(float x) { return x > 20.f ? x : log1pf(expf(x)); }

__global__ void k_mod(const float* c, const float* ada_w, const float* ada_b, float* mod, int b) {
    int n = blockIdx.x * blockDim.x + threadIdx.x; if (n >= 6 * D) return;
    float acc = 0.f;
    for (int k = 0; k < D; ++k) { float cv = c[b * D + k]; float s = cv / (1.f + expf(-cv)); acc += s * ada_w[(size_t)k * 6 * D + n]; }
    mod[n] = acc + ada_b[n];
}
__global__ void k_adaln(const float* x, const float* w, const float* shift, const float* scale, float* h) {
    __shared__ float red[256];
    const float* xr = x + (size_t)blockIdx.x * D; float ss = 0.f;
    for (int i = threadIdx.x; i < D; i += 256) ss += xr[i] * xr[i];
    red[threadIdx.x] = ss; __syncthreads();
    for (int o = 128; o > 0; o >>= 1) { if (threadIdx.x < o) red[threadIdx.x] += red[threadIdx.x + o]; __syncthreads(); }
    float r = rsqrtf(red[0] / D + 1e-6f);
    for (int i = threadIdx.x; i < D; i += 256) h[(size_t)blockIdx.x * D + i] = xr[i] * r * w[i] * (1.f + scale[i]) + shift[i];
}
__global__ void k_rmsrows(const float* in, int ld, int off, int n, const float* w, float* out, int rows) {
    int row = blockIdx.x * (blockDim.x / 64) + (threadIdx.x >> 6), lane = threadIdx.x & 63; if (row >= rows) return;
    const float* p = in + (size_t)row * ld + off; float ss = 0.f;
    for (int i = lane; i < n; i += 64) ss += p[i] * p[i];
    for (int o = 32; o > 0; o >>= 1) ss += __shfl_xor(ss, o);
    float r = rsqrtf(ss / n + 1e-6f);
    for (int i = lane; i < n; i += 64) out[(size_t)row * n + i] = p[i] * r * w[i];
}
struct GA { const float* A; const int* aidx; const float* W; size_t wstride; float* C; const float* bias; const int* goff; const int* gcnt; int lda, ldw, ldc, bstride, M, N, K, pad; };
__global__ __launch_bounds__(256) void k_gemm(GA g) {
    __shared__ float As[16][64 + 4], Ws[16][64 + 4];
    const int z = blockIdx.z; const int rowbase = g.goff ? g.goff[z] : 0; const int M = g.gcnt ? g.gcnt[z] : g.M;
    const int m0 = blockIdx.y * 64, n0 = blockIdx.x * 64; if (m0 >= M) return;
    const float* W = g.W + (size_t)z * g.wstride; const float* bias = g.bias ? g.bias + (size_t)z * g.bstride : nullptr;
    const int tx = threadIdx.x & 15, ty = threadIdx.x >> 4;
    float acc[4][4] = {};
    const int ar = threadIdx.x >> 2, ak = (threadIdx.x & 3) * 4;
    const int wk = threadIdx.x >> 4, wn = (threadIdx.x & 15) * 4;
    long arow = -1; if (m0 + ar < M) { int rr = rowbase + m0 + ar; arow = g.aidx ? g.aidx[rr] : rr; }
    for (int k0 = 0; k0 < g.K; k0 += 16) {
        float4 av = make_float4(0, 0, 0, 0);
        if (arow >= 0) av = *(const float4*)(g.A + (size_t)arow * g.lda + k0 + ak);
        As[ak + 0][ar] = av.x; As[ak + 1][ar] = av.y; As[ak + 2][ar] = av.z; As[ak + 3][ar] = av.w;
#pragma unroll
        for (int j = 0; j < 4; ++j) { int n = n0 + wn + j; Ws[wk][wn + j] = (n < g.N) ? W[(size_t)(k0 + wk) * g.ldw + n] : 0.f; }
        __syncthreads();
#pragma unroll
        for (int kk = 0; kk < 16; ++kk) {
            float a[4], w[4];
#pragma unroll
            for (int i = 0; i < 4; ++i) { a[i] = As[kk][ty * 4 + i]; w[i] = Ws[kk][tx * 4 + i]; }
#pragma unroll
            for (int i = 0; i < 4; ++i)
#pragma unroll
                for (int j = 0; j < 4; ++j) acc[i][j] += a[i] * w[j];
        }
        __syncthreads();
    }
#pragma unroll
    for (int i = 0; i < 4; ++i) { int m = m0 + ty * 4 + i; if (m >= M) continue;
#pragma unroll
        for (int j = 0; j < 4; ++j) { int n = n0 + tx * 4 + j; if (n >= g.N) continue;
            g.C[(size_t)(rowbase + m) * g.ldc + n] = acc[i][j] + (bias ? bias[n] : 0.f); } }
}
__global__ void k_qkfin(const float* q, const float* kv, const float* P, const int* positions, int b, const float* q_norm_w, const float* k_norm_w,
                        float* qf, float* kf, float* vf, int So) {
    int idx = blockIdx.x * (blockDim.x / 64) + (threadIdx.x >> 6), lane = threadIdx.x & 63; if (idx >= So * 8) return;
    int s = idx >> 3, h = idx & 7;
    float pos = (float)positions[b * SEQ + s];
    float q0 = q[(size_t)s * 768 + h * 96 + lane], q1 = lane < 32 ? q[(size_t)s * 768 + h * 96 + 64 + lane] : 0.f;
    float k0 = kv[(size_t)s * 1024 + h * 128 + lane], k1 = lane < 32 ? P[(size_t)s * DIN + OFF_KR + lane] : 0.f;
    float sq = q0 * q0 + q1 * q1, sk = k0 * k0 + k1 * k1;
    for (int o = 32; o > 0; o >>= 1) { sq += __shfl_xor(sq, o); sk += __shfl_xor(sk, o); }
    float rq = rsqrtf(sq / 96.f + 1e-6f), rk = rsqrtf(sk / 96.f + 1e-6f);
    q0 = q0 * rq * q_norm_w[lane]; k0 = k0 * rk * k_norm_w[lane];
    if (lane < 32) { q1 = q1 * rq * q_norm_w[64 + lane]; k1 = k1 * rk * k_norm_w[64 + lane]; }
    int i = lane & 15; float inv = powf(10000.f, -(float)i / 16.f); float ang = pos * inv; float cs = cosf(ang), sn = sinf(ang);
    float qo = __shfl(q1, lane ^ 16), ko = __shfl(k1, lane ^ 16);
    float q1r, k1r;
    if (lane < 16) { q1r = q1 * cs - qo * sn; k1r = k1 * cs - ko * sn; } else { q1r = q1 * cs + qo * sn; k1r = k1 * cs + ko * sn; }
    qf[((size_t)s * 8 + h) * 96 + lane] = q0; kf[((size_t)s * 8 + h) * 96 + lane] = k0;
    if (lane < 32) { qf[((size_t)s * 8 + h) * 96 + 64 + lane] = q1r; kf[((size_t)s * 8 + h) * 96 + 64 + lane] = k1r; }
    vf[((size_t)s * 8 + h) * 64 + lane] = kv[(size_t)s * 1024 + h * 128 + 64 + lane];
}
__global__ __launch_bounds__(64) void k_attn(const float* qf, const float* kf, const float* vf, float* oa) {
    __shared__ float Ks[64][96], Vs[64][64];
    const int qb = blockIdx.x, h = blockIdx.y, lane = threadIdx.x; const int sq = qb * 64 + lane;
    float q[96], o[64];
#pragma unroll
    for (int d = 0; d < 96; ++d) q[d] = qf[((size_t)sq * 8 + h) * 96 + d] * 0.10206207261596577f;
#pragma unroll
    for (int d = 0; d < 64; ++d) o[d] = 0.f;
    float m = -INFINITY, l = 0.f;
    for (int t = 0; t <= qb; ++t) {
        __syncthreads();
        for (int i = lane; i < 64 * 96; i += 64) { int r = i / 96, d = i % 96; Ks[r][d] = kf[((size_t)(t * 64 + r) * 8 + h) * 96 + d]; }
        for (int i = lane; i < 64 * 64; i += 64) { int r = i / 64, d = i % 64; Vs[r][d] = vf[((size_t)(t * 64 + r) * 8 + h) * 64 + d]; }
        __syncthreads();
        for (int j = 0; j < 64; ++j) {
            int sk = t * 64 + j; if (sk > sq) break;
            float s = 0.f;
#pragma unroll
            for (int d = 0; d < 96; ++d) s += q[d] * Ks[j][d];
            float mn = fmaxf(m, s), f = expf(m - mn), p = expf(s - mn);
            l = l * f + p;
#pragma unroll
            for (int d = 0; d < 64; ++d) o[d] = o[d] * f + p * Vs[j][d];
            m = mn;
        }
    }
    float il = 1.f / l;
#pragma unroll
    for (int d = 0; d < 64; ++d) oa[(size_t)sq * 512 + h * 64 + d] = o[d] * il;
}
__global__ void k_rwkv_prep1(const float* P, const float* mu, float* r, float* k, float* v, float* tw, float* al, float* sg, int So) {
    int s = blockIdx.x;
    for (int i = threadIdx.x; i < SLAB; i += blockDim.x) {
        float cur = P[(size_t)s * DIN + OFF_SLAB + i]; float prev = s > 0 ? P[(size_t)(s - 1) * DIN + OFF_SLAB + i] : 0.f;
        float p = cur + (prev - cur) * mu[i];
        if (i < 512) r[(size_t)s * 512 + i] = p; else if (i < 1024) k[(size_t)s * 512 + i - 512] = p; else if (i < 1536) v[(size_t)s * 512 + i - 1024] = p;
        else if (i < 1600) tw[(size_t)s * 64 + i - 1536] = tanhf(p); else if (i < 1664) al[(size_t)s * 64 + i - 1600] = p; else sg[(size_t)s * 128 + i - 1664] = sigmoidf_(p);
    }
}
__global__ void k_rwkv_prep2(const float* r, const float* k, const float* v, const float* dw, const float* da, const float* w0, const float* a0,
                             const float* k_k, const float* k_a, const float* r_k, float* scan_in, float* bonus, int So) {
    int idx = blockIdx.x * (blockDim.x / 64) + (threadIdx.x >> 6), lane = threadIdx.x & 63; if (idx >= So * 8) return;
    int s = idx >> 3, h = idx & 7, c = h * 64 + lane;
    float rv = r[(size_t)s * 512 + c], kv_ = k[(size_t)s * 512 + c], vv = v[(size_t)s * 512 + c];
    float lw = -softplusf_(-(w0[c] + dw[(size_t)s * 512 + c])) - 0.5f; float dec = expf(-expf(lw));
    float a = sigmoidf_(a0[c] + da[(size_t)s * 512 + c]);
    float kk = kv_ * k_k[c]; float ss = kk * kk; for (int o = 32; o > 0; o >>= 1) ss += __shfl_xor(ss, o);
    kk = kk / fmaxf(sqrtf(ss), 1e-12f);
    float kp = kv_ * (1.f + (a - 1.f) * k_a[c]);
    float bs = rv * kp * r_k[c]; for (int o = 32; o > 0; o >>= 1) bs += __shfl_xor(bs, o);
    float* si = scan_in + ((size_t)h * So + s) * 6 * 64;
    si[0 * 64 + lane] = rv; si[1 * 64 + lane] = dec; si[2 * 64 + lane] = kp; si[3 * 64 + lane] = vv; si[4 * 64 + lane] = kk; si[5 * 64 + lane] = kk * a;
    bonus[(size_t)s * 512 + c] = bs * vv;
}
__global__ __launch_bounds__(256) void k_scan(const float* scan_in, float* y, int So) {
    __shared__ float buf[32][6][64];
    const int h = blockIdx.x, tid = threadIdx.x, vrow = tid >> 2, kq = tid & 3;
    float S[16];
#pragma unroll
    for (int i = 0; i < 16; ++i) S[i] = 0.f;
    for (int s0 = 0; s0 < So; s0 += 32) {
        __syncthreads();
        const float* src = scan_in + ((size_t)h * So + s0) * 384;
        for (int i = tid; i < 32 * 384; i += 256) (&buf[0][0][0])[i] = src[i];
        __syncthreads();
        for (int t = 0; t < 32; ++t) {
            const float* rr = &buf[t][0][kq * 16]; const float* ww = &buf[t][1][kq * 16]; const float* kp = &buf[t][2][kq * 16];
            const float* kk = &buf[t][4][kq * 16]; const float* bb = &buf[t][5][kq * 16]; const float vv = buf[t][3][vrow];
            float sa = 0.f;
#pragma unroll
            for (int i = 0; i < 16; ++i) sa += S[i] * kk[i];
            sa += __shfl_xor(sa, 1); sa += __shfl_xor(sa, 2); sa = -sa;
            float yy = 0.f;
#pragma unroll
            for (int i = 0; i < 16; ++i) { S[i] = S[i] * ww[i] + sa * bb[i] + vv * kp[i]; yy += S[i] * rr[i]; }
            yy += __shfl_xor(yy, 1); yy += __shfl_xor(yy, 2);
            if (kq == 0) y[(size_t)(s0 + t) * 512 + h * 64 + vrow] = yy;
        }
    }
}
__global__ void k_rwkv_post(const float* y, const float* bonus, const float* g, const float* ln_w, const float* ln_b, float* yb, int So) {
    int idx = blockIdx.x * (blockDim.x / 64) + (threadIdx.x >> 6), lane = threadIdx.x & 63; if (idx >= So * 8) return;
    int s = idx >> 3, h = idx & 7, c = h * 64 + lane;
    float yv = y[(size_t)s * 512 + c]; float sm = yv; for (int o = 32; o > 0; o >>= 1) sm += __shfl_xor(sm, o);
    float mu = sm / 64.f; float d = yv - mu; float vs = d * d; for (int o = 32; o > 0; o >>= 1) vs += __shfl_xor(vs, o);
    float yn = d * rsqrtf(vs / 64.f + 64e-5f) * ln_w[c] + ln_b[c];
    yb[(size_t)s * 512 + c] = (yn + bonus[(size_t)s * 512 + c]) * g[(size_t)s * 512 + c];
}
__global__ void k_merge(const float* P, const float* oa, const float* ob, float* merged, int So) {
    size_t i = (size_t)blockIdx.x * blockDim.x + threadIdx.x; if (i >= (size_t)So * D) return; size_t s = i / D; int n = i % D;
    merged[i] = sigmoidf_(P[s * DIN + OFF_GA + n]) * oa[i] + sigmoidf_(P[s * DIN + OFF_GB + n]) * ob[i];
}
__global__ void k_resid(const float* x, const float* gate, const float* mix, float* out, int So) {
    size_t i = (size_t)blockIdx.x * blockDim.x + threadIdx.x; if (i >= (size_t)So * D) return; int n = i % D;
    out[i] = x[i] + gate[n] * mix[i];
}
__global__ void k_topk(const float* logits, int* top_e, float* top_w, int So) {
    int s = blockIdx.x * blockDim.x + threadIdx.x; if (s >= So) return;
    float l[32];
#pragma unroll
    for (int e = 0; e < 32; ++e) l[e] = logits[(size_t)s * 32 + e];
    unsigned taken = 0u; int ie0 = 0, ie1 = 0, ie2 = 0, ie3 = 0; float ve0 = 0, ve1 = 0, ve2 = 0, ve3 = 0;
#pragma unroll
    for (int k = 0; k < 4; ++k) { int bi = 0; float bv = -INFINITY;
#pragma unroll
        for (int e = 0; e < 32; ++e) { bool ok = !((taken >> e) & 1u) && (l[e] > bv); bv = ok ? l[e] : bv; bi = ok ? e : bi; }
        taken |= 1u << bi;
        if (k == 0) { ie0 = bi; ve0 = bv; } else if (k == 1) { ie1 = bi; ve1 = bv; } else if (k == 2) { ie2 = bi; ve2 = bv; } else { ie3 = bi; ve3 = bv; } }
    float p0 = 1.f, p1 = expf(ve1 - ve0), p2 = expf(ve2 - ve0), p3 = expf(ve3 - ve0); float inv = 1.f / (p0 + p1 + p2 + p3);
    top_e[s * 4 + 0] = ie0; top_e[s * 4 + 1] = ie1; top_e[s * 4 + 2] = ie2; top_e[s * 4 + 3] = ie3;
    top_w[s * 4 + 0] = p0 * inv; top_w[s * 4 + 1] = p1 * inv; top_w[s * 4 + 2] = p2 * inv; top_w[s * 4 + 3] = p3 * inv;
}
__global__ __launch_bounds__(1024) void k_dispatch(const int* top_e, int* cnt, int* off, int* slot_tok, int* tok_slot, int So) {
    __shared__ int c[32], o[32], run[32];
    if (threadIdx.x < 32) { c[threadIdx.x] = 0; run[threadIdx.x] = 0; } __syncthreads();
    for (int i = threadIdx.x; i < So * 4; i += 1024) atomicAdd(&c[top_e[i]], 1);
    __syncthreads();
    if (threadIdx.x == 0) { int a = 0; for (int e = 0; e < 32; ++e) { o[e] = a; a += c[e]; } }
    __syncthreads();
    if (threadIdx.x < 32) { cnt[threadIdx.x] = c[threadIdx.x]; off[threadIdx.x] = o[threadIdx.x]; }
    for (int i = threadIdx.x; i < So * 4; i += 1024) { int e = top_e[i]; int sl = o[e] + atomicAdd(&run[e], 1); slot_tok[sl] = i >> 2; tok_slot[i] = sl; }
}
__global__ void k_swiglu(const float* gu, float* act, int rows) {
    size_t i = (size_t)blockIdx.x * blockDim.x + threadIdx.x; if (i >= (size_t)rows * 1024) return; size_t r = i / 1024; int j = i % 1024;
    float gte = fminf(gu[r * 2048 + 2 * j], 7.f), up = fminf(fmaxf(gu[r * 2048 + 2 * j + 1], -7.f), 7.f);
    act[i] = (up + 1.f) * gte * sigmoidf_(1.702f * gte);
}
__global__ void k_combine(const float* x1, const float* gate2, const float* ye, const int* tok_slot, const float* top_w, float* out, int So) {
    size_t i = (size_t)blockIdx.x * blockDim.x + threadIdx.x; if (i >= (size_t)So * D) return; size_t s = i / D; int n = i % D;
    float acc = 0.f; for (int k = 0; k < 4; ++k) acc += top_w[s * 4 + k] * ye[(size_t)tok_slot[s * 4 + k] * D + n];
    out[i] = x1[i] + gate2[n] * acc;
}

struct Buf {
    float *mod, *h, *P, *cqn, *ckvn, *q, *kv, *qf, *kf, *vf, *oa, *o_a, *r, *k, *v, *tw, *al, *sg, *dw, *da, *g, *scan_in, *bonus, *y, *yb, *o_b, *merged, *mix, *x1, *h2, *logits, *top_w, *gu, *act, *ye;
    int *top_e, *cnt, *off, *slot_tok, *tok_slot;
    size_t bytes;
};
inline Buf carve(char* base, int So) {
    Buf B; size_t o = 0; auto F = [&](size_t n) { float* p = (float*)(base + o); o += ((n * 4 + 255) / 256) * 256; return p; };
    size_t S = So;
    B.mod = F(6 * D); B.h = F(S * D); B.P = F(S * DIN); B.cqn = F(S * 256); B.ckvn = F(S * 128); B.q = F(S * 768); B.kv = F(S * 1024);
    B.qf = F(S * 768); B.kf = F(S * 768); B.vf = F(S * 512); B.oa = F(S * 512); B.o_a = F(S * D);
    B.r = F(S * 512); B.k = F(S * 512); B.v = F(S * 512); B.tw = F(S * 64); B.al = F(S * 64); B.sg = F(S * 128); B.dw = F(S * 512); B.da = F(S * 512); B.g = F(S * 512);
    B.scan_in = F(S * 8 * 384); B.bonus = F(S * 512); B.y = F(S * 512); B.yb = F(S * 512); B.o_b = F(S * D); B.merged = F(S * D); B.mix = F(S * D); B.x1 = F(S * D); B.h2 = F(S * D);
    B.logits = F(S * 32); B.top_w = F(S * 4); B.top_e = (int*)F(S * 4); B.cnt = (int*)F(64); B.off = (int*)F(64); B.slot_tok = (int*)F(S * 4); B.tok_slot = (int*)F(S * 4);
    B.gu = F(S * 4 * 2048); B.act = F(S * 4 * 1024); B.ye = F(S * 4 * 1024);
    B.bytes = o; return B;
}
inline void gemm(hipStream_t st, const float* A, int lda, const float* W, int ldw, float* C, int ldc, const float* bias, int M, int N, int K) {
    GA g; memset(&g, 0, sizeof(g)); g.A = A; g.lda = lda; g.W = W; g.ldw = ldw; g.C = C; g.ldc = ldc; g.bias = bias; g.M = M; g.N = N; g.K = K;
    hipLaunchKernelGGL(k_gemm, dim3((N + 63) / 64, (M + 63) / 64, 1), dim3(256), 0, st, g);
}
inline void run(hipStream_t st, void* const* d_in, int b, int So, const Buf& B, float* out_rows) {
    const float* x = (const float*)d_in[0] + (size_t)b * SEQ * D; const float* c = (const float*)d_in[1]; const int* positions = (const int*)d_in[2];
    const float *ada_w = (const float*)d_in[3], *ada_b = (const float*)d_in[4], *norm_mix_w = (const float*)d_in[5], *norm_ffn_w = (const float*)d_in[6], *w_in = (const float*)d_in[7];
    const float *q_a_norm_w = (const float*)d_in[8], *w_q_up = (const float*)d_in[9], *kv_a_norm_w = (const float*)d_in[10], *w_kv_up = (const float*)d_in[11];
    const float *q_norm_w = (const float*)d_in[12], *k_norm_w = (const float*)d_in[13], *w_o_mla = (const float*)d_in[14];
    const float *mu = (const float*)d_in[15], *w0 = (const float*)d_in[16], *w2 = (const float*)d_in[17], *a0 = (const float*)d_in[18], *a2 = (const float*)d_in[19], *g2 = (const float*)d_in[20];
    const float *k_k = (const float*)d_in[21], *k_a = (const float*)d_in[22], *r_k = (const float*)d_in[23], *ln_w = (const float*)d_in[24], *ln_b = (const float*)d_in[25], *rw_o = (const float*)d_in[26];
    const float *w_out = (const float*)d_in[27], *w_router = (const float*)d_in[28], *b_router = (const float*)d_in[29], *w_gu = (const float*)d_in[30], *b_gu = (const float*)d_in[31], *w_dn = (const float*)d_in[32], *b_dn = (const float*)d_in[33];
    const int nW = (So * 8 + 3) / 4;
    hipLaunchKernelGGL(k_mod, dim3(24), dim3(256), 0, st, c, ada_w, ada_b, B.mod, b);
    hipLaunchKernelGGL(k_adaln, dim3(So), dim3(256), 0, st, x, norm_mix_w, B.mod + 0 * D, B.mod + 1 * D, B.h);
    gemm(st, B.h, D, w_in, DIN, B.P, DIN, nullptr, So, DIN, D);
    hipLaunchKernelGGL(k_rmsrows, dim3((So + 3) / 4), dim3(256), 0, st, B.P, DIN, OFF_CQ, 256, q_a_norm_w, B.cqn, So);
    hipLaunchKernelGGL(k_rmsrows, dim3((So + 3) / 4), dim3(256), 0, st, B.P, DIN, OFF_CKV, 128, kv_a_norm_w, B.ckvn, So);
    gemm(st, B.cqn, 256, w_q_up, 768, B.q, 768, nullptr, So, 768, 256);
    gemm(st, B.ckvn, 128, w_kv_up, 1024, B.kv, 1024, nullptr, So, 1024, 128);
    hipLaunchKernelGGL(k_qkfin, dim3(nW), dim3(256), 0, st, B.q, B.kv, B.P, positions, b, q_norm_w, k_norm_w, B.qf, B.kf, B.vf, So);
    hipLaunchKernelGGL(k_attn, dim3(So / 64, 8), dim3(64), 0, st, B.qf, B.kf, B.vf, B.oa);
    gemm(st, B.oa, 512, w_o_mla, D, B.o_a, D, nullptr, So, D, 512);
    hipLaunchKernelGGL(k_rwkv_prep1, dim3(So), dim3(256), 0, st, B.P, mu, B.r, B.k, B.v, B.tw, B.al, B.sg, So);
    gemm(st, B.tw, 64, w2, 512, B.dw, 512, nullptr, So, 512, 64);
    gemm(st, B.al, 64, a2, 512, B.da, 512, nullptr, So, 512, 64);
    gemm(st, B.sg, 128, g2, 512, B.g, 512, nullptr, So, 512, 128);
    hipLaunchKernelGGL(k_rwkv_prep2, dim3(nW), dim3(256), 0, st, B.r, B.k, B.v, B.dw, B.da, w0, a0, k_k, k_a, r_k, B.scan_in, B.bonus, So);
    hipLaunchKernelGGL(k_scan, dim3(8), dim3(256), 0, st, B.scan_in, B.y, So);
    hipLaunchKernelGGL(k_rwkv_post, dim3(nW), dim3(256), 0, st, B.y, B.bonus, B.g, ln_w, ln_b, B.yb, So);
    gemm(st, B.yb, 512, rw_o, D, B.o_b, D, nullptr, So, D, 512);
    hipLaunchKernelGGL(k_merge, dim3((So * D + 255) / 256), dim3(256), 0, st, B.P, B.o_a, B.o_b, B.merged, So);
    gemm(st, B.merged, D, w_out, D, B.mix, D, nullptr, So, D, D);
    hipLaunchKernelGGL(k_resid, dim3((So * D + 255) / 256), dim3(256), 0, st, x, B.mod + 2 * D, B.mix, B.x1, So);
    hipLaunchKernelGGL(k_adaln, dim3(So), dim3(256), 0, st, B.x1, norm_ffn_w, B.mod + 3 * D, B.mod + 4 * D, B.h2);
    gemm(st, B.h2, D, w_router, 32, B.logits, 32, b_router, So, 32, D);
    hipLaunchKernelGGL(k_topk, dim3((So + 255) / 256), dim3(256), 0, st, B.logits, B.top_e, B.top_w, So);
    hipLaunchKernelGGL(k_dispatch, dim3(1), dim3(1024), 0, st, B.top_e, B.cnt, B.off, B.slot_tok, B.tok_slot, So);
    { GA g; memset(&g, 0, sizeof(g)); g.A = B.h2; g.lda = D; g.aidx = B.slot_tok; g.W = w_gu; g.ldw = 2048; g.wstride = (size_t)D * 2048; g.C = B.gu; g.ldc = 2048; g.bias = b_gu; g.bstride = 2048;
      g.M = So; g.N = 2048; g.K = D; g.goff = B.off; g.gcnt = B.cnt;
      hipLaunchKernelGGL(k_gemm, dim3(2048 / 64, (So + 63) / 64, 32), dim3(256), 0, st, g); }
    hipLaunchKernelGGL(k_swiglu, dim3((So * 4 * 1024 + 255) / 256), dim3(256), 0, st, B.gu, B.act, So * 4);
    { GA g; memset(&g, 0, sizeof(g)); g.A = B.act; g.lda = D; g.W = w_dn; g.ldw = D; g.wstride = (size_t)D * D; g.C = B.ye; g.ldc = D; g.bias = b_dn; g.bstride = D;
      g.M = So; g.N = D; g.K = D; g.goff = B.off; g.gcnt = B.cnt;
      hipLaunchKernelGGL(k_gemm, dim3(D / 64, (So + 63) / 64, 32), dim3(256), 0, st, g); }
    hipLaunchKernelGGL(k_combine, dim3((So * D + 255) / 256), dim3(256), 0, st, B.x1, B.mod + 5 * D, B.ye, B.tok_slot, B.top_w, out_rows, So);
}
}

namespace dbg {
constexpr int OB = 5, SO = 512;
struct CmpArgs { const void* fast; const float* ref; float* res; int mode, rows, C, ldf, coff, ref_ld, ref_off, stage; };
__global__ void k_cmp(CmpArgs a) {
    const size_t n = (size_t)a.rows * a.C; float num = 0.f, den = 0.f;
    for (size_t i = (size_t)blockIdx.x * blockDim.x + threadIdx.x; i < n; i += (size_t)gridDim.x * blockDim.x) {
        int s = (int)(i / a.C), c = (int)(i % a.C); const size_t t = (size_t)OB * 4096 + s; float fv, rv;
        if (a.mode == 5) {
            const int h = (int)(i / ((size_t)a.rows / 8 * 384)); const size_t rem = i % ((size_t)a.rows / 8 * 384); s = (int)(rem / 384); const int q = (int)(rem % 384); const int arr = q / 64;
            rv = a.ref[i]; const unsigned short* f = (const unsigned short*)a.fast; fv = __uint_as_float((unsigned)f[(((size_t)(OB * 8 + h) * 4096 + s) * 384) + q] << 16); if (arr == 1) fv = 1.f - fv;
        } else {
            rv = a.ref[(size_t)s * a.ref_ld + a.ref_off + c];
            if (a.mode == 7) fv = ((const float*)a.fast)[c];
            else if (a.mode == 0) fv = ((const float*)a.fast)[t * a.ldf + a.coff + c];
            else { const unsigned short* f = (const unsigned short*)a.fast; size_t idx;
                if (a.mode == 1 || a.mode == 6) idx = t * a.ldf + a.coff + c;
                else if (a.mode == 2) { const int h = c / 96, d = c % 96; idx = ((size_t)(OB * 8 + h) * 4096 + s) * 96 + d; }
                else if (a.mode == 3) { const int h = c / 96, d = c % 96; idx = ((size_t)(OB * 8 + h) * 64 + (s >> 6)) * 6144 + (d >> 3) * 512 + (s & 63) * 8 + (d & 7); }
                else { const int h = c / 64, d = c % 64, key = s & 63; idx = ((size_t)(OB * 8 + h) * 64 + (s >> 6)) * 4096 + ((d >> 5) * 4 + (key >> 4)) * 512 + (key & 15) * 32 + (d & 31); }
                fv = __uint_as_float((unsigned)f[idx] << 16);
                if (a.mode == 2) fv *= (1.f / fk::QSCALE);
                if (a.mode == 6) rv = 1.f / (1.f + expf(-rv)); }
        }
        const float d = fv - rv; num += d * d; den += rv * rv; if (!(d == d)) num = INFINITY;
    }
    for (int o = 32; o > 0; o >>= 1) { num += __shfl_xor(num, o); den += __shfl_xor(den, o); }
    if ((threadIdx.x & 63) == 0) { atomicAdd(a.res + 2 * a.stage, num); atomicAdd(a.res + 2 * a.stage + 1, den); }
}
__global__ void k_cmp_topk(const int* fe, const int* re, float* res, int stage) {
    int s = blockIdx.x * blockDim.x + threadIdx.x; if (s >= SO) return; const size_t t = (size_t)OB * 4096 + s; int bad = 0;
    for (int k = 0; k < 4; ++k) bad |= (fe[t * 4 + k] != re[s * 4 + k]);
    atomicAdd(res + 2 * stage, (float)bad); atomicAdd(res + 2 * stage + 1, 1.f);
}
__global__ void k_verdict(const float* res, int nstage, float* out, size_t n) {
    int fail = 0;
    for (int s = nstage - 1; s >= 0; --s) { const float num = res[2 * s], den = res[2 * s + 1]; const float rel = sqrtf(num / fmaxf(den, 1e-30f)); const float tol = (s == 0) ? 1e-3f : (s == 20 ? 0.2f : 4e-2f);
        if (!(rel <= tol) || den == 0.f) fail = s + 1; }
    if (fail == 0) return;
    for (size_t i = (size_t)blockIdx.x * blockDim.x + threadIdx.x; i < n; i += (size_t)gridDim.x * blockDim.x) out[i] = (float)fail;
}
inline void cmp(hipStream_t st, float* res, int stage, const void* fast, int mode, int ldf, int coff, const float* ref, int ref_ld, int ref_off, int rows, int C) {
    CmpArgs a; memset(&a, 0, sizeof(a)); a.fast = fast; a.ref = ref; a.res = res; a.mode = mode; a.rows = rows; a.C = C; a.ldf = ldf; a.coff = coff; a.ref_ld = ref_ld; a.ref_off = ref_off; a.stage = stage;
    hipLaunchKernelGGL(k_cmp, dim3(512), dim3(256), 0, st, a);
}
}
#endif
extern "C" void kernel_launch(void* const* d_in, const int* in_sizes, int n_in, void* d_out, int out_size, void* d_ws, size_t ws_size, hipStream_t stream) {
    using namespace fk;
    if (!host_init(ws_size)) return;
    Args a; fill_args(a, d_in, d_out, d_ws);
    hipMemsetAsync((char*)d_ws + WS_CTL, 0, CTL_ZERO_BYTES, stream);
#if MODE == 0
    launch_range(stream, a, 0, NPHASE, 0);
#elif MODE == 1
    for (int p = 0; p < NPHASE; ++p) launch_range(stream, a, p, p + 1, 0);
#else
    unsigned char* ws = (unsigned char*)d_ws;
    char* obase = (char*)d_ws + WS_END; orc::Buf B = orc::carve(obase, dbg::SO); float* oout = (float*)(obase + B.bytes);
    if (WS_END + B.bytes + (size_t)dbg::SO * 4096 + 4096 > ws_size) { fprintf(stderr, "debug: ws too small\n"); return; }
    float* res = (float*)(ws + 512 * 1024);
    orc::run(stream, d_in, dbg::OB, dbg::SO, B, oout);
    const int SO = dbg::SO; int st = 0;
    auto P = [&](int p) { launch_range(stream, a, p, p + 1, 0); };
    P(0); P(1);
    dbg::cmp(stream, res, 0, ws + WS_MOD + (size_t)dbg::OB * 6144 * 4, 7, 6144, 0, B.mod, 6144, 0, 1, 6144);
    P(2);
    dbg::cmp(stream, res, 1, ws + WS_PS, 1, NPS, 0, B.P, 4256, 0, SO, 416);
    dbg::cmp(stream, res, 2, ws + WS_PS, 1, NPS, 512, B.P, 4256, 416, SO, 1792);
    dbg::cmp(stream, res, 3, d_out, 6, 2048, 0, B.P, 4256, 2208, SO, 2048);
    P(3); P(4);
    dbg::cmp(stream, res, 4, ws + WS_QRAW, 1, 768, 0, B.q, 768, 0, SO, 768);
    dbg::cmp(stream, res, 5, ws + WS_KVRAW, 1, 1024, 0, B.kv, 1024, 0, SO, 1024);
    dbg::cmp(stream, res, 6, ws + WS_GG, 1, 512, 0, B.g, 512, 0, SO, 512);
    P(5);
    dbg::cmp(stream, res, 7, ws + WS_Q, 2, 0, 0, B.qf, 768, 0, SO, 768);
    dbg::cmp(stream, res, 8, ws + WS_K, 3, 0, 0, B.kf, 768, 0, SO, 768);
    dbg::cmp(stream, res, 9, ws + WS_V, 4, 0, 0, B.vf, 512, 0, SO, 512);
    dbg::cmp(stream, res, 10, ws + WS_SCANIN, 5, 0, 0, B.scan_in, 0, 0, SO * 8, 384);
    P(6);
    dbg::cmp(stream, res, 11, ws + WS_OA, 1, 512, 0, B.oa, 512, 0, SO, 512);
    dbg::cmp(stream, res, 12, ws + WS_Y, 0, 512, 0, B.y, 512, 0, SO, 512);
    P(7);
    dbg::cmp(stream, res, 13, ws + WS_OBIN, 1, 512, 0, B.yb, 512, 0, SO, 512);
    P(8);
    dbg::cmp(stream, res, 14, ws + WS_MERGED, 1, 1024, 0, B.merged, 1024, 0, SO, 1024);
    P(9);
    dbg::cmp(stream, res, 15, d_out, 0, 1024, 0, B.x1, 1024, 0, SO, 1024);
    P(10);
    dbg::cmp(stream, res, 16, ws + WS_H, 1, 1024, 0, B.h2, 1024, 0, SO, 1024);
    hipLaunchKernelGGL(dbg::k_cmp_topk, dim3((SO + 255) / 256), dim3(256), 0, stream, (const int*)(ws + WS_TOPE), B.top_e, res, 20);
    P(11); P(12); P(13); P(14);
    dbg::cmp(stream, res, 17, d_out, 0, 1024, 0, oout, 1024, 0, SO, 1024);
    hipLaunchKernelGGL(dbg::k_verdict, dim3(1024), dim3(256), 0, stream, res, 21, (float*)d_out, (size_t)T * 1024);
    (void)st;
#endif
}
```

```cpp
#include <hip/hip_runtime.h>
#include <cstdio>
#include <cstdint>
#include <cmath>
#include <cstring>
#ifndef MODE
#define MODE 0
#endif
#define GAS __attribute__((address_space(1)))
#define LAS __attribute__((address_space(3)))
typedef unsigned short bf16_t;
typedef short bf16x8 __attribute__((ext_vector_type(8)));
typedef short s16x4 __attribute__((ext_vector_type(4)));
typedef float f32x4 __attribute__((ext_vector_type(4)));
typedef float f32x2 __attribute__((ext_vector_type(2)));
typedef float f32x16 __attribute__((ext_vector_type(16)));
typedef unsigned u32x4 __attribute__((ext_vector_type(4)));
typedef unsigned u32x2 __attribute__((ext_vector_type(2)));
typedef int v4i_t __attribute__((ext_vector_type(4)));
typedef int v8i_t __attribute__((ext_vector_type(8)));

typedef __bf16 bf16x2_t __attribute__((ext_vector_type(2)));
__device__ __forceinline__ unsigned cvt_pk_bf16(float lo, float hi) { f32x2 v = {lo, hi}; bf16x2_t b = __builtin_convertvector(v, bf16x2_t); return __builtin_bit_cast(unsigned, b); }
__device__ __forceinline__ float bf_lo(unsigned w) { return __uint_as_float(w << 16); }
__device__ __forceinline__ float bf_hi(unsigned w) { return __uint_as_float(w & 0xffff0000u); }
__device__ __forceinline__ float fsigmoid(float x) { return __builtin_amdgcn_rcpf(1.f + __builtin_amdgcn_exp2f(-1.4426950408889634f * x)); }
__device__ __forceinline__ float wave_sum(float v) {
#pragma unroll
    for (int o = 1; o < 64; o <<= 1) v += __shfl_xor(v, o);
    return v;
}
__device__ __forceinline__ float sum8(float v) { v += __shfl_xor(v, 1); v += __shfl_xor(v, 2); v += __shfl_xor(v, 4); return v; }

namespace pg8 {
constexpr int BM = 256, BK = 64, HALF = 128, HTB = HALF * BK * 2, STAGE_BYTES = 8 * HTB, NXCD = 8, WGM = 8;
__host__ __device__ __forceinline__ int lds_byte(int r, int c) { const int st = (r >> 4) * 2 + (c >> 5), rr = r & 15, cc = c & 31, ob = rr * 64 + cc * 2; return st * 1024 + (ob ^ (((ob >> 9) & 1) << 5)); }
__host__ __device__ __forceinline__ void stage_rc(int b, int& R, int& C) { const int st = b / 1024, sb = b % 1024, swz = sb ^ (((sb >> 9) & 1) << 5); R = (st >> 1) * 16 + swz / 64; C = (st & 1) * 32 + (swz % 64) / 2; }
__host__ __device__ __forceinline__ int perm32(int rho) { const int n = rho >> 4, i = rho & 15; return 8 * (i >> 2) + 4 * n + (i & 3); }

struct Unit { int pm, pn, e; };
struct Gemm { const bf16_t* A; const bf16_t* Bt; int M, N, K; size_t bgs; };

struct StaticOrder {
    static constexpr bool GATHER = false;
    int nM, nN, nwg, G, c;
    __device__ void init(int M, int N, int G_, int c_) { nM = M / BM; nN = N / BM; nwg = nM * nN; G = G_; c = c_; }
    __device__ bool next(int i, Unit& u) const {
        const long L = (long)i * G + c; if (L >= nwg) return false;
        int wgid = (int)L; { const int q = nwg / NXCD, r = nwg % NXCD, xcd = wgid % NXCD, off = wgid / NXCD; wgid = (xcd < r ? xcd * (q + 1) : r * (q + 1) + (xcd - r) * q) + off; }
        const int nig = WGM * nN, gid = wgid / nig, fm = gid * WGM, gsz = (nM - fm) < WGM ? (nM - fm) : WGM;
        u.pm = fm + ((wgid % nig) % gsz); u.pn = (wgid % nig) / gsz; u.e = 0; return true;
    }
    __device__ __forceinline__ int arow(int, int) const { return 0; }
};
template <int NPN, bool GATH> struct MoeOrder {
    static constexpr bool GATHER = GATH;
    const LAS int* tpre; const LAS int* rowtab; int G, c;
    __device__ bool next(int i, Unit& u) const {
        const int L = i * G + c; const int total = tpre[32] * NPN; if (L >= total) return false;
        const int mt = L / NPN; u.pm = mt; u.pn = L % NPN; int e = 0;
#pragma unroll 1
        for (int k = 1; k < 32; ++k) e += (tpre[k] <= mt) ? 1 : 0;
        u.e = e; return true;
    }
    __device__ __forceinline__ int arow(int ui, int r) const { return rowtab[ui * 256 + r]; }
};

template <class Epi, class Sched, bool ALIGN_EPI = true, bool FP8 = false>
__device__ __forceinline__ void gemm_phase(LAS unsigned char* lds, const Gemm g, const Sched& S, const Epi& E) {
    const int tid = threadIdx.x, wid = __builtin_amdgcn_readfirstlane(tid >> 6), lane = tid & 63, wr = wid >> 2, wc = wid & 3, fr = lane & 15, fq = lane >> 4;
    const int K = g.K, nt = K / BK;
    unsigned voffA[2], voffB[2];
#pragma unroll
    for (int i = 0; i < 2; ++i) { int R, C; stage_rc(tid * 16 + i * 8192, R, C); const int Rb = Epi::PERM ? ((R & ~31) + perm32(R & 31)) : R;
        voffA[i] = (unsigned)(R * K + C) * 2u; voffB[i] = (unsigned)(Rb * K + C) * 2u; }
    const size_t kstep = (size_t)(BK * 2);
    const size_t hstep = (size_t)HALF * K * 2;
    const size_t tstep = 2 * hstep;
    const unsigned ldsw = (unsigned)wid * 1024u;
    const int aoff = lds_byte(wr * 64 + fr, fq * 8), boff = lds_byte(wc * 32 + fr, fq * 8);
#define PG8_SA(b, h) (((b) * 2 + (h)) * HTB)
#define PG8_SB(b, h) ((4 + (b) * 2 + (h)) * HTB)
#define PG8_STAGE(bufoff, gbase, voff) do { _Pragma("unroll") for (int _i = 0; _i < 2; ++_i) \
        __builtin_amdgcn_global_load_lds((const unsigned*)((const char*)(gbase) + (voff)[_i]), (LAS unsigned*)(lds + (bufoff) + ldsw + _i * 8192), 16, 0, 0); } while (0)
#define PG8_CAT(x, y) __builtin_shufflevector((x), (y), 0, 1, 2, 3, 4, 5, 6, 7)
#define PG8_LDA(dst, b, h) do { _Pragma("unroll") for (int m = 0; m < 4; ++m) { if constexpr (FP8) { dst##8[m] = PG8_CAT(*(const LAS v4i_t*)(lds + PG8_SA(b, h) + aoff + m * 2048), *(const LAS v4i_t*)(lds + PG8_SA(b, h) + aoff + m * 2048 + 1024)); } \
        else { _Pragma("unroll") for (int k = 0; k < 2; ++k) dst[m][k] = *(const LAS bf16x8*)(lds + PG8_SA(b, h) + aoff + m * 2048 + k * 1024); } } } while (0)
#define PG8_LDB(dst, b, h) do { _Pragma("unroll") for (int n = 0; n < 2; ++n) { if constexpr (FP8) { dst##8[n] = PG8_CAT(*(const LAS v4i_t*)(lds + PG8_SB(b, h) + boff + n * 2048), *(const LAS v4i_t*)(lds + PG8_SB(b, h) + boff + n * 2048 + 1024)); } \
        else { _Pragma("unroll") for (int k = 0; k < 2; ++k) dst[n][k] = *(const LAS bf16x8*)(lds + PG8_SB(b, h) + boff + n * 2048 + k * 1024); } } } while (0)
#define PG8_MMA(ai, bj, At, Bt) do { __builtin_amdgcn_s_setprio(1); _Pragma("unroll") for (int m = 0; m < 4; ++m) _Pragma("unroll") for (int n = 0; n < 2; ++n) { \
        if constexpr (FP8) { asm volatile("v_mfma_scale_f32_16x16x128_f8f6f4 %0, %1, %2, %0, %3, %3 op_sel_hi:[0,0,0]" : "+v"(acc[ai][bj][m][n]) : "v"(Bt##8[n]), "v"(At##8[m]), "v"(sc1)); } \
        else { _Pragma("unroll") for (int k = 0; k < 2; ++k) acc[ai][bj][m][n] = __builtin_amdgcn_mfma_f32_16x16x32_bf16(Bt[n][k], At[m][k], acc[ai][bj][m][n], 0, 0, 0); } } \
        __builtin_amdgcn_s_setprio(0); } while (0)
#define PG8_WAIT_V(n) asm volatile("s_waitcnt vmcnt(" #n ")" ::: "memory")
#define PG8_WAIT_L(n) asm volatile("s_waitcnt lgkmcnt(" #n ")" ::: "memory")
#define PG8_BAR __builtin_amdgcn_s_barrier()
#define PG8_SCHED __builtin_amdgcn_sched_barrier(0)
    Unit cur, nxt; int ui = 0;
    if (!S.next(0, cur)) return;
    f32x4 acc[2][2][4][2];
#pragma unroll
    for (int a = 0; a < 2; ++a)
#pragma unroll
        for (int b = 0; b < 2; ++b)
#pragma unroll
            for (int m = 0; m < 4; ++m)
#pragma unroll
                for (int n = 0; n < 2; ++n) acc[a][b][m][n] = (f32x4){0.f, 0.f, 0.f, 0.f};
    int sc1 = 0x7f7f7f7f; asm volatile("" : "+v"(sc1));
    bf16x8 At[4][2], B0[2][2], B1[2][2]; v8i_t At8[4], B08[2], B18[2];
    const char* cA; const char* cB = (const char*)g.Bt + (size_t)cur.e * g.bgs + (size_t)cur.pn * tstep;
    if constexpr (Sched::GATHER) cA = (const char*)g.A; else cA = (const char*)g.A + (size_t)cur.pm * tstep;
#define PG8_STAGE_A(bufoff, kptr, h, uidx) do { if constexpr (Sched::GATHER) { _Pragma("unroll") for (int _i = 0; _i < 2; ++_i) { int _R, _C; stage_rc(tid * 16 + _i * 8192, _R, _C); \
            const unsigned _o = (unsigned)S.arow((uidx), (h) * HALF + _R) * (unsigned)(K * 2) + (unsigned)_C * 2u; \
            __builtin_amdgcn_global_load_lds((const unsigned*)((const char*)(kptr) + _o), (LAS unsigned*)(lds + (bufoff) + ldsw + _i * 8192), 16, 0, 0); } } \
        else { PG8_STAGE(bufoff, (kptr) + (h) * hstep, voffA); } } while (0)
    PG8_STAGE(PG8_SB(0, 0), cB, voffB); PG8_STAGE(PG8_SB(0, 1), cB + hstep, voffB); PG8_STAGE_A(PG8_SA(0, 0), cA, 0, 0); PG8_STAGE_A(PG8_SA(0, 1), cA, 1, 0);
    if (wr == 1) PG8_BAR;
    PG8_WAIT_V(2); PG8_BAR;
    PG8_STAGE(PG8_SB(1, 0), cB + kstep, voffB); PG8_STAGE_A(PG8_SA(1, 0), cA + kstep, 0, 0); PG8_STAGE(PG8_SB(1, 1), cB + hstep + kstep, voffB);
    PG8_WAIT_V(6); PG8_BAR;
#pragma unroll 1
    for (;;) {
        const bool has_next = S.next(ui + 1, nxt);
        const char* nA; const char* nB;
        if constexpr (Sched::GATHER) nA = cA; else nA = has_next ? (const char*)g.A + (size_t)nxt.pm * tstep : cA;
        nB = has_next ? (const char*)g.Bt + (size_t)nxt.e * g.bgs + (size_t)nxt.pn * tstep : cB;
#pragma unroll 1
        for (int t = 0; t < nt; t += 2) {
            const bool last = (t == nt - 2);
            const char* a1 = cA + (size_t)(t + 1) * kstep;
            const char* a2 = last ? nA : cA + (size_t)(t + 2) * kstep; const char* b2 = last ? nB : cB + (size_t)(t + 2) * kstep;
            const char* a3 = a2 + kstep; const char* b3 = b2 + kstep;
            const int u2 = (last && has_next) ? ui + 1 : ui;
            PG8_LDB(B0, 0, 0); PG8_LDB(B1, 0, 1); PG8_SCHED; PG8_LDA(At, 0, 0); PG8_STAGE_A(PG8_SA(1, 1), a1, 1, ui);
            PG8_WAIT_V(8); PG8_WAIT_L(0); PG8_BAR; PG8_MMA(0, 0, At, B0); PG8_MMA(0, 1, At, B1); PG8_BAR; PG8_SCHED;
            PG8_LDA(At, 0, 1); PG8_STAGE(PG8_SB(0, 0), b2, voffB); PG8_STAGE(PG8_SB(0, 1), b2 + hstep, voffB); PG8_STAGE_A(PG8_SA(0, 0), a2, 0, u2);
            PG8_WAIT_V(8); PG8_WAIT_L(0); PG8_BAR; PG8_MMA(1, 0, At, B0); PG8_MMA(1, 1, At, B1); PG8_BAR; PG8_SCHED;
            PG8_LDB(B0, 1, 0); PG8_LDB(B1, 1, 1); PG8_SCHED; PG8_LDA(At, 1, 0); PG8_STAGE_A(PG8_SA(0, 1), a2, 1, u2);
            PG8_WAIT_V(8); PG8_WAIT_L(0); PG8_BAR; PG8_MMA(0, 0, At, B0); PG8_MMA(0, 1, At, B1); PG8_BAR; PG8_SCHED;
            PG8_LDA(At, 1, 1); PG8_STAGE(PG8_SB(1, 0), b3, voffB); PG8_STAGE(PG8_SB(1, 1), b3 + hstep, voffB); PG8_STAGE_A(PG8_SA(1, 0), a3, 0, u2);
            PG8_WAIT_V(8); PG8_WAIT_L(0); PG8_BAR; PG8_MMA(1, 0, At, B0); PG8_MMA(1, 1, At, B1); PG8_BAR; PG8_SCHED;
        }
        if constexpr (ALIGN_EPI) { if (wr == 0) PG8_BAR; }
        if constexpr (FP8) asm volatile("s_nop 15\n\ts_nop 7" ::: "memory");
        E(acc, cur, wr, wc, fr, fq);
#ifdef EPIREP
        if constexpr (FP8) { for (int _e = 0; _e < EPIREP; ++_e) { asm volatile("" ::: "memory"); E(acc, cur, wr, wc, fr, fq); } }
#endif
        if (!has_next) break;
#pragma unroll
        for (int a = 0; a < 2; ++a)
#pragma unroll
            for (int b = 0; b < 2; ++b)
#pragma unroll
                for (int m = 0; m < 4; ++m)
#pragma unroll
                    for (int n = 0; n < 2; ++n) acc[a][b][m][n] = (f32x4){0.f, 0.f, 0.f, 0.f};
        cur = nxt; cA = nA; cB = nB; ++ui;
        if constexpr (ALIGN_EPI) { if (wr == 1) PG8_BAR; }
    }
    PG8_WAIT_V(0);
    if constexpr (!ALIGN_EPI) { if (wr == 0) PG8_BAR; }
    PG8_BAR;
#undef PG8_SA
#undef PG8_SB
#undef PG8_STAGE
#undef PG8_STAGE_A
#undef PG8_LDA
#undef PG8_LDB
#undef PG8_MMA
#undef PG8_CAT
#undef PG8_WAIT_V
#undef PG8_WAIT_L
#undef PG8_BAR
#undef PG8_SCHED
}
}

#define XB_TMO      128
#define XB_XCNT(j)  (256  + 64 * (j))
#define XB_XSUB(j)  (1280 + 64 * (j))
#define XB_XGEN(j)  (2304 + 64 * (j))
#define XB_TOP      3328
#define XB_TOPGEN   3392
#define XCD_BAR_WORDS 3456
#define XB_SPIN_CAP (1u << 25)
__device__ __forceinline__ unsigned xb_ld(unsigned* p)              { return __hip_atomic_load(p, __ATOMIC_RELAXED, __HIP_MEMORY_SCOPE_AGENT); }
__device__ __forceinline__ unsigned xb_add(unsigned* p, unsigned v) { return __hip_atomic_fetch_add(p, v, __ATOMIC_RELAXED, __HIP_MEMORY_SCOPE_AGENT); }
__device__ __forceinline__ unsigned xb_xcc_id() { return (unsigned)__builtin_amdgcn_s_getreg((3 << 11) | 20) & 0xFu; }
#define XB_SPIN(cond, bar) do { unsigned _sp = 0; while (cond) { __builtin_amdgcn_s_sleep(1); \
    if ((++_sp & 255u) == 0u) { if (xb_ld(&(bar)[XB_TMO])) break; if (_sp > XB_SPIN_CAP) { atomicAdd(&(bar)[XB_TMO], 1u); break; } } } } while (0)
struct XcdBarrier { unsigned* bar; unsigned x; volatile LAS unsigned* st; };
__device__ __forceinline__ XcdBarrier xcd_barrier_post(unsigned* bar, volatile LAS unsigned* st) {
    XcdBarrier b; b.bar = bar; b.x = xb_xcc_id(); b.st = st;
    if (threadIdx.x == 0) (void)xb_add(&bar[XB_XCNT(b.x)], 1u);
    return b;
}
__device__ __forceinline__ void xcd_barrier_complete(unsigned* bar, unsigned x, unsigned& nloc, unsigned& nx) {
    const unsigned G = gridDim.x * gridDim.y * gridDim.z;
    unsigned sum, cnt, mine, sp = 0u;
    for (;;) {
        sum = 0u; cnt = 0u; mine = 0u;
#pragma unroll
        for (unsigned j = 0; j < 16; ++j) { const unsigned c = xb_ld(&bar[XB_XCNT(j)]); sum += c; cnt += (c > 0u) ? 1u : 0u; mine = (j == x) ? c : mine; }
        if (sum == G) break;
        __builtin_amdgcn_s_sleep(1);
        if ((++sp & 255u) == 0u) { if (xb_ld(&bar[XB_TMO])) break; if (sp > XB_SPIN_CAP) { atomicAdd(&bar[XB_TMO], 1u); break; } }
    }
    nloc = mine > 0u ? mine : 1u; nx = cnt > 0u ? cnt : 1u;
}
__device__ __forceinline__ void xcd_barrier(const XcdBarrier& b) {
    asm volatile("s_waitcnt vmcnt(0)" ::: "memory");
    __syncthreads();
    if (threadIdx.x == 0) {
        unsigned* bar = b.bar;
        __builtin_amdgcn_s_waitcnt(0);
        unsigned nloc = b.st[0], nx = b.st[1];
        if (nloc == 0u) { xcd_barrier_complete(bar, b.x, nloc, nx); b.st[0] = nloc; b.st[1] = nx; }
        const unsigned old = xb_add(&bar[XB_XSUB(b.x)], 1u);
        const unsigned gen = old / nloc;
        if (old + 1u == (gen + 1u) * nloc) {
            __builtin_amdgcn_fence(__ATOMIC_RELEASE, "agent");
            asm volatile("s_waitcnt vmcnt(0)" ::: "memory");
            const unsigned og = xb_add(&bar[XB_TOP], 1u);
            const unsigned tg = og / nx;
            if (og + 1u == (tg + 1u) * nx) xb_add(&bar[XB_TOPGEN], 1u);
            else XB_SPIN(xb_ld(&bar[XB_TOPGEN]) == tg, bar);
            __builtin_amdgcn_fence(__ATOMIC_ACQUIRE, "agent");
            xb_add(&bar[XB_XGEN(b.x)], 1u);
            asm volatile("s_waitcnt vmcnt(0)" ::: "memory");
        } else {
            XB_SPIN(xb_ld(&bar[XB_XGEN(b.x)]) == gen, bar);
            __builtin_amdgcn_fence(__ATOMIC_ACQUIRE, "agent");
            asm volatile("s_waitcnt vmcnt(0)" ::: "memory");
        }
    }
    __syncthreads();
}

namespace fk {
constexpr int T = 32768, D = 1024, SEQ = 4096, NB = 8, NWAVES = 8, NTHR = 512;
constexpr int NPS = 2304;
constexpr int NIN = 4352;
constexpr int MAXSLOT = 131072 + 8192;
constexpr float QSCALE = 0.10206207261596577f * 1.4426950408889634f;
constexpr size_t MiB = 1u << 20;
constexpr size_t WS_CTL = 0, CTL_ZERO_BYTES = 1 * MiB;
constexpr size_t WS_MODP = 1 * MiB;
constexpr size_t WS_MOD = 4 * MiB;
constexpr size_t WS_ROPE = 5 * MiB;
constexpr size_t WS_TOPE = 9 * MiB;
constexpr size_t WS_TOPW = WS_TOPE + 512 * 1024;
constexpr size_t WS_TOKSLOT = WS_TOPW + 512 * 1024;
constexpr size_t WS_ROWTOK = WS_TOKSLOT + 512 * 1024;
constexpr size_t WS_ROWW = WS_ROWTOK + 768 * 1024;
constexpr size_t WS_HIST = WS_ROWW + 768 * 1024;
constexpr size_t WS_TPRE = WS_HIST + 64 * 1024;
constexpr size_t WS_WIN = 13 * MiB;
constexpr size_t WS_WQ = WS_WIN + (size_t)NIN * 1024 * 2;
constexpr size_t WS_WKV = WS_WQ + 768 * 256 * 2;
constexpr size_t WS_WLORA = WS_WKV + 1024 * 256 * 2;
constexpr size_t WS_WOA = WS_WLORA + 1536 * 256 * 2;
constexpr size_t WS_WOB = WS_WOA + 1024 * 512 * 2;
constexpr size_t WS_WOUT = WS_WOB + 1024 * 512 * 2;
static_assert(WS_WOUT + 1024 * 1024 * 2 <= 28 * MiB, "small weights");
constexpr size_t WS_PS = 28 * MiB;
constexpr size_t WS_H = 172 * MiB;
constexpr size_t WS_AQ = 236 * MiB, WS_AKV = 252 * MiB, WS_ALORA = 268 * MiB;
constexpr size_t WS_QRAW = 284 * MiB;
constexpr size_t WS_KVRAW = 332 * MiB;
constexpr size_t WS_DEC = 396 * MiB;
constexpr size_t WS_AA = 460 * MiB;
constexpr size_t WS_GG = 492 * MiB;
constexpr size_t WS_Q = 524 * MiB;
constexpr size_t WS_K = 572 * MiB;
constexpr size_t WS_V = 620 * MiB;
constexpr size_t WS_SCANIN = 652 * MiB;
constexpr size_t WS_OA = 172 * MiB;
constexpr size_t WS_OBIN = 204 * MiB;
constexpr size_t WS_Y = 236 * MiB;
constexpr size_t WS_M1 = 300 * MiB;
constexpr size_t WS_MERGED = 396 * MiB;
constexpr size_t WS_WGU = 780 * MiB;
constexpr size_t WS_WDN = 364 * MiB;
constexpr size_t WS_ACT = 620 * MiB;
constexpr size_t WS_YS = 28 * MiB;
constexpr size_t WS_X1B = 460 * MiB;
constexpr size_t WS_END = 924 * MiB;
constexpr int CW_BAR = 4096;
constexpr int RING_BYTES = 131072, XTRA_OFF = RING_BYTES + 1024, LDS_BYTES = 163840, MISC_OFF = LDS_BYTES - 256;
constexpr int NPHASE = 16;

struct Args {
    const float* in[34]; float* out; unsigned char* ws; int ph_lo, ph_hi, bar_region, pad;
};
struct Frame {
    LAS unsigned char* lds; int tid, lane, wave, vcu, G;
};

#define EPI_LOOP_BEGIN \
    _Pragma("unroll") for (int ai = 0; ai < 2; ++ai) _Pragma("unroll") for (int m = 0; m < 4; ++m) { const int row = u.pm * 256 + ai * 128 + wr * 64 + m * 16 + fr; \
    _Pragma("unroll") for (int bj = 0; bj < 2; ++bj) { const int colt = bj * 128 + wc * 32 + 8 * fq; const f32x4 v0 = acc[ai][bj][m][0], v1 = acc[ai][bj][m][1];
#define EPI_LOOP_END } }
__device__ __forceinline__ u32x4 pack8(f32x4 a, f32x4 b) { u32x4 w; w.x = cvt_pk_bf16(a[0], a[1]); w.y = cvt_pk_bf16(a[2], a[3]); w.z = cvt_pk_bf16(b[0], b[1]); w.w = cvt_pk_bf16(b[2], b[3]); return w; }
__device__ __forceinline__ void unpack8(u32x4 w, f32x4& a, f32x4& b) { a = (f32x4){bf_lo(w.x), bf_hi(w.x), bf_lo(w.y), bf_hi(w.y)}; b = (f32x4){bf_lo(w.z), bf_hi(w.z), bf_lo(w.w), bf_hi(w.w)}; }
__device__ __forceinline__ f32x4 sig4(f32x4 v) { return (f32x4){fsigmoid(v[0]), fsigmoid(v[1]), fsigmoid(v[2]), fsigmoid(v[3])}; }

struct EpiP {
    static constexpr bool PERM = true; bf16_t* PS; bf16_t* Gt;
    __device__ __forceinline__ void operator()(const f32x4 (&acc)[2][2][4][2], const pg8::Unit& u, int wr, int wc, int fr, int fq) const {
        const bool gate = u.pn >= 9;
        EPI_LOOP_BEGIN
            if (gate) { *(u32x4*)(Gt + (size_t)row * 2048 + (u.pn - 9) * 256 + colt) = pack8(sig4(v0), sig4(v1)); }
            else { *(u32x4*)(PS + (size_t)row * NPS + u.pn * 256 + colt) = pack8(v0, v1); }
        EPI_LOOP_END
    }
};
struct EpiPlain {
    static constexpr bool PERM = true; bf16_t* O; int ldc;
    __device__ __forceinline__ void operator()(const f32x4 (&acc)[2][2][4][2], const pg8::Unit& u, int wr, int wc, int fr, int fq) const {
        EPI_LOOP_BEGIN
            *(u32x4*)(O + (size_t)row * ldc + u.pn * 256 + colt) = pack8(v0, v1);
        EPI_LOOP_END
    }
};
struct EpiLora {
    static constexpr bool PERM = true; bf16_t* DEC; bf16_t* AA; bf16_t* GG;
    __device__ __forceinline__ void operator()(const f32x4 (&acc)[2][2][4][2], const pg8::Unit& u, int wr, int wc, int fr, int fq) const {
        const int kind = u.pn >> 1; const int cb = (u.pn & 1) * 256; bf16_t* O = (bf16_t*)((unsigned char*)GG - (size_t)(kind == 0) * ((unsigned char*)GG - (unsigned char*)DEC) - (size_t)(kind == 1) * ((unsigned char*)GG - (unsigned char*)AA));
        EPI_LOOP_BEGIN
            const int c = cb + colt;
            *(u32x4*)(O + (size_t)row * 512 + c) = pack8(v0, v1);
        EPI_LOOP_END
    }
};
struct EpiOA {
    static constexpr bool PERM = true; const bf16_t* Gt; bf16_t* M1;
    __device__ __forceinline__ void operator()(const f32x4 (&acc)[2][2][4][2], const pg8::Unit& u, int wr, int wc, int fr, int fq) const {
        EPI_LOOP_BEGIN
            const int c = u.pn * 256 + colt; f32x4 g0, g1; unpack8(*(const u32x4*)(Gt + (size_t)row * 2048 + c), g0, g1);
            *(u32x4*)(M1 + (size_t)row * 1024 + c) = pack8(g0 * v0, g1 * v1);
        EPI_LOOP_END
    }
};
struct EpiOB {
    static constexpr bool PERM = true; const bf16_t* Gt; const bf16_t* M1; bf16_t* MG;
    __device__ __forceinline__ void operator()(const f32x4 (&acc)[2][2][4][2], const pg8::Unit& u, int wr, int wc, int fr, int fq) const {
        EPI_LOOP_BEGIN
            const int c = u.pn * 256 + colt; f32x4 g0, g1, p0, p1; unpack8(*(const u32x4*)(Gt + (size_t)row * 2048 + 1024 + c), g0, g1); unpack8(*(const u32x4*)(M1 + (size_t)row * 1024 + c), p0, p1);
            *(u32x4*)(MG + (size_t)row * 1024 + c) = pack8(p0 + g0 * v0, p1 + g1 * v1);
        EPI_LOOP_END
    }
};
struct EpiOut {
    static constexpr bool PERM = true; const float* x; const float* mod; bf16_t* out;
    __device__ __forceinline__ void operator()(const f32x4 (&acc)[2][2][4][2], const pg8::Unit& u, int wr, int wc, int fr, int fq) const {
        const float* g1p = mod + (size_t)((u.pm * 256) >> 12) * 6144 + 2 * 1024;
        EPI_LOOP_BEGIN
            const int c = u.pn * 256 + colt; const size_t o = (size_t)row * 1024 + c;
            const f32x4 ga = *(const f32x4*)(g1p + c), gb = *(const f32x4*)(g1p + c + 4), xa = *(const f32x4*)(x + o), xb = *(const f32x4*)(x + o + 4);
            *(u32x4*)(out + o) = pack8(xa + ga * v0, xb + gb * v1);
        EPI_LOOP_END
    }
};
constexpr float GUSC = 1.f / 64.f;
struct EpiGU {
    static constexpr bool PERM = true; const float* bias; bf16_t* ACT;
    __device__ __forceinline__ void operator()(const f32x4 (&acc)[2][2][4][2], const pg8::Unit& u, int wr, int wc, int fr, int fq) const {
        const float* bp = bias + (size_t)u.e * 2048 + u.pn * 256 + wc * 32 + 8 * fq;
        unsigned char* ob = (unsigned char*)ACT + (size_t)(u.pm * 256 + wr * 64 + fr) * 1024 + ((u.pn * 256 + wc * 32 + 8 * fq) >> 1);
#pragma unroll
        for (int bj = 0; bj < 2; ++bj) { const f32x4 b0 = *(const f32x4*)(bp + bj * 128), b1 = *(const f32x4*)(bp + bj * 128 + 4);
#pragma unroll
            for (int ai = 0; ai < 2; ++ai)
#pragma unroll
                for (int m = 0; m < 4; ++m) { const f32x4 a = acc[ai][bj][m][0] * GUSC + b0, b = acc[ai][bj][m][1] * GUSC + b1;
                    const float g0 = fminf(a[0], 7.f), g1 = fminf(a[2], 7.f), g2 = fminf(b[0], 7.f), g3 = fminf(b[2], 7.f);
                    const float u0 = fminf(fmaxf(a[1], -7.f), 7.f) + 1.f, u1 = fminf(fmaxf(a[3], -7.f), 7.f) + 1.f, u2 = fminf(fmaxf(b[1], -7.f), 7.f) + 1.f, u3 = fminf(fmaxf(b[3], -7.f), 7.f) + 1.f;
                    const float r0 = u0 * g0 * fsigmoid(1.702f * g0), r1 = u1 * g1 * fsigmoid(1.702f * g1), r2 = u2 * g2 * fsigmoid(1.702f * g2), r3 = u3 * g3 * fsigmoid(1.702f * g3);
                    unsigned w8 = 0u; w8 = __builtin_amdgcn_cvt_pk_fp8_f32(r0, r1, w8, false); w8 = __builtin_amdgcn_cvt_pk_fp8_f32(r2, r3, w8, true);
                    *(unsigned*)(ob + (size_t)(ai * 128 + m * 16) * 1024 + bj * 64) = w8; } }
    }
};
constexpr float YSC = 32.f;
struct EpiDN {
    static constexpr bool PERM = true; const float* bias; const float* roww; bf16_t* YS;
    __device__ __forceinline__ void operator()(const f32x4 (&acc)[2][2][4][2], const pg8::Unit& u, int wr, int wc, int fr, int fq) const {
        const float* bp = bias + (size_t)u.e * 1024 + u.pn * 256 + wc * 32 + 8 * fq; const int row0 = u.pm * 256 + wr * 64 + fr;
        unsigned char* ob = (unsigned char*)YS + (size_t)row0 * 1024 + u.pn * 256 + wc * 32 + 8 * fq;
        float rw[2][4];
#pragma unroll
        for (int ai = 0; ai < 2; ++ai)
#pragma unroll
            for (int m = 0; m < 4; ++m) rw[ai][m] = roww[row0 + ai * 128 + m * 16] * YSC;
#pragma unroll
        for (int bj = 0; bj < 2; ++bj) { const f32x4 b0 = *(const f32x4*)(bp + bj * 128), b1 = *(const f32x4*)(bp + bj * 128 + 4);
#pragma unroll
            for (int ai = 0; ai < 2; ++ai)
#pragma unroll
                for (int m = 0; m < 4; ++m) { const float w = rw[ai][m]; const f32x4 p = (acc[ai][bj][m][0] * GUSC + b0) * w, q = (acc[ai][bj][m][1] * GUSC + b1) * w;
#define YCL(x) __builtin_amdgcn_fmed3f((x), -440.f, 440.f)
                    u32x2 o; o.x = 0u; o.y = 0u;
                    o.x = __builtin_amdgcn_cvt_pk_fp8_f32(YCL(p[0]), YCL(p[1]), o.x, false); o.x = __builtin_amdgcn_cvt_pk_fp8_f32(YCL(p[2]), YCL(p[3]), o.x, true);
                    o.y = __builtin_amdgcn_cvt_pk_fp8_f32(YCL(q[0]), YCL(q[1]), o.y, false); o.y = __builtin_amdgcn_cvt_pk_fp8_f32(YCL(q[2]), YCL(q[3]), o.y, true);
#undef YCL
                    *(u32x2*)(ob + (size_t)(ai * 128 + m * 16) * 1024 + bj * 128) = o; } }
    }
};
__device__ __forceinline__ f32x4 ld4f8(const unsigned char* p) { const unsigned w = *(const unsigned*)p;
    return (f32x4){__builtin_amdgcn_cvt_f32_fp8(w, 0), __builtin_amdgcn_cvt_f32_fp8(w, 1), __builtin_amdgcn_cvt_f32_fp8(w, 2), __builtin_amdgcn_cvt_f32_fp8(w, 3)}; }

__device__ __forceinline__ void transpose_item(const float* W, int N, bf16_t* WT, int ldk, int koff, int row_off, LAS float* scr, int kb, int nb, int lane) {
    const int k0 = 64 * kb, n0 = 32 * nb;
#pragma unroll 8
    for (int i = 0; i < 32; ++i) { const int kk = 2 * i + (lane >> 5); scr[kk * 33 + (lane & 31)] = W[(size_t)(k0 + kk) * N + n0 + (lane & 31)]; }
    asm volatile("s_waitcnt lgkmcnt(0)" ::: "memory");
    const int c = lane & 7;
#pragma unroll
    for (int j = 0; j < 4; ++j) { const int n = (lane >> 3) + 8 * j; const LAS float* s = scr + (8 * c) * 33 + n;
        u32x4 o; o.x = cvt_pk_bf16(s[0 * 33], s[1 * 33]); o.y = cvt_pk_bf16(s[2 * 33], s[3 * 33]); o.z = cvt_pk_bf16(s[4 * 33], s[5 * 33]); o.w = cvt_pk_bf16(s[6 * 33], s[7 * 33]);
        *(u32x4*)(WT + (size_t)(row_off + n0 + n) * ldk + koff + k0 + 8 * c) = o; }
    asm volatile("s_waitcnt lgkmcnt(0)" ::: "memory");
}
__device__ __forceinline__ void transpose_item8(const float* W, int N, unsigned char* WT, int ldkb, float scale, LAS float* scr, int kb, int nb, int lane) {
    const int k0 = 64 * kb, n0 = 32 * nb;
#pragma unroll 8
    for (int i = 0; i < 32; ++i) { const int kk = 2 * i + (lane >> 5); scr[kk * 33 + (lane & 31)] = W[(size_t)(k0 + kk) * N + n0 + (lane & 31)]; }
    asm volatile("s_waitcnt lgkmcnt(0)" ::: "memory");
    const int c = lane & 7;
#pragma unroll
    for (int j = 0; j < 4; ++j) { const int n = (lane >> 3) + 8 * j; const LAS float* s = scr + (8 * c) * 33 + n;
        unsigned w0 = 0u, w1 = 0u;
        w0 = __builtin_amdgcn_cvt_pk_fp8_f32(s[0 * 33] * scale, s[1 * 33] * scale, w0, false); w0 = __builtin_amdgcn_cvt_pk_fp8_f32(s[2 * 33] * scale, s[3 * 33] * scale, w0, true);
        w1 = __builtin_amdgcn_cvt_pk_fp8_f32(s[4 * 33] * scale, s[5 * 33] * scale, w1, false); w1 = __builtin_amdgcn_cvt_pk_fp8_f32(s[6 * 33] * scale, s[7 * 33] * scale, w1, true);
        *(u32x2*)(WT + (size_t)(n0 + n) * ldkb + k0 + 8 * c) = (u32x2){w0, w1}; }
    asm volatile("s_waitcnt lgkmcnt(0)" ::: "memory");
}
__device__ __forceinline__ void transpose_item8w(const float* W, int N, unsigned char* WT, int ldkb, float scale, LAS float* scr, int kb, int nb, int lane) {
    const int k0 = 64 * kb, n0 = 64 * nb; const int kr = lane >> 4, nc = 4 * (lane & 15);
    f32x4 v[16];
#pragma unroll
    for (int i = 0; i < 16; ++i) v[i] = *(const f32x4*)(W + (size_t)(k0 + 4 * i + kr) * N + n0 + nc);
#pragma unroll
    for (int i = 0; i < 16; ++i) { LAS float* d = scr + (4 * i + kr) * 65 + nc; d[0] = v[i][0]; d[1] = v[i][1]; d[2] = v[i][2]; d[3] = v[i][3]; }
    asm volatile("s_waitcnt lgkmcnt(0)" ::: "memory");
    unsigned char* o = WT + (size_t)(n0 + lane) * ldkb + k0;
#pragma unroll
    for (int q = 0; q < 4; ++q) { u32x4 w;
#pragma unroll
        for (int d = 0; d < 4; ++d) { const LAS float* s = scr + (16 * q + 4 * d) * 65 + lane; unsigned x = 0u;
            x = __builtin_amdgcn_cvt_pk_fp8_f32(s[0] * scale, s[65] * scale, x, false); x = __builtin_amdgcn_cvt_pk_fp8_f32(s[130] * scale, s[195] * scale, x, true); w[d] = x; }
        *(u32x4*)(o + 16 * q) = w; }
    asm volatile("s_waitcnt lgkmcnt(0)" ::: "memory");
}
struct CvtRegs { f32x16 a, b, c, d; };
__device__ __forceinline__ void convert_load8r(CvtRegs& R, const float* W, int N, int kb, int nb, int lane) {
    const float* src = W + (size_t)(64 * kb) * N + 64 * nb + lane;
#pragma unroll
    for (int k = 0; k < 16; ++k) { R.a[k] = src[(size_t)k * N]; R.b[k] = src[(size_t)(16 + k) * N]; R.c[k] = src[(size_t)(32 + k) * N]; R.d[k] = src[(size_t)(48 + k) * N]; }
}
__device__ __forceinline__ u32x4 convert_pack16(const f32x16& v, float scale) { u32x4 w;
#pragma unroll
    for (int d = 0; d < 4; ++d) { unsigned x = 0u; x = __builtin_amdgcn_cvt_pk_fp8_f32(v[4 * d] * scale, v[4 * d + 1] * scale, x, false); x = __builtin_amdgcn_cvt_pk_fp8_f32(v[4 * d + 2] * scale, v[4 * d + 3] * scale, x, true); w[d] = x; }
    return w; }
__device__ __forceinline__ void convert_store8r(const CvtRegs& R, unsigned char* WT, int ldkb, float scale, int kb, int nb, int lane) {
    unsigned char* o = WT + (size_t)(64 * nb + lane) * ldkb + 64 * kb;
    *(u32x4*)(o) = convert_pack16(R.a, scale); *(u32x4*)(o + 16) = convert_pack16(R.b, scale); *(u32x4*)(o + 32) = convert_pack16(R.c, scale); *(u32x4*)(o + 48) = convert_pack16(R.d, scale);
}
struct CvtHalf { f32x16 a; };
__device__ __forceinline__ void convert_load8h(CvtHalf& R, const float* W, int N, int kb, int nb, int qtr, int lane) {
    const float* src = W + (size_t)(64 * kb + 16 * qtr) * N + 64 * nb + lane;
#pragma unroll
    for (int k = 0; k < 16; ++k) R.a[k] = src[(size_t)k * N];
}
__device__ __forceinline__ void convert_store8h(const CvtHalf& R, unsigned char* WT, int ldkb, float scale, int kb, int nb, int qtr, int lane) {
    unsigned char* o = WT + (size_t)(64 * nb + lane) * ldkb + 64 * kb + 16 * qtr;
    *(u32x4*)(o) = convert_pack16(R.a, scale);
}
__device__ __forceinline__ void convert_item8r(const float* W, int N, unsigned char* WT, int ldkb, float scale, int kb, int nb, int lane) {
    CvtRegs R; convert_load8r(R, W, N, kb, nb, lane); convert_store8r(R, WT, ldkb, scale, kb, nb, lane);
}
__device__ __forceinline__ bool tr_try(int& r, const float* W, int K, int N, bf16_t* WT, int ldk, int koff, int row_off, LAS float* scr, int lane) {
    const int nblk = N / 32, items = (K / 64) * nblk;
    if (r < items) { transpose_item(W, N, WT, ldk, koff, row_off, scr, r / nblk, r % nblk, lane); return true; }
    r -= items; return false;
}
__device__ __forceinline__ void zero_block(bf16_t* WT, int ldk, int r0, int nr, int k0, int k1, int gthread, int nthreads) {
    const int per = (k1 - k0) / 8; const int total = nr * per;
    for (int i = gthread; i < total; i += nthreads) { const int r = i / per, c = i % per; *(u32x4*)(WT + (size_t)(r0 + r) * ldk + k0 + 8 * c) = (u32x4){0u, 0u, 0u, 0u}; }
}

__device__ __forceinline__ int crow(int r, int hi) { return (r & 3) + 8 * (r >> 2) + 4 * hi; }
constexpr int AT_KB = 12288, AT_VB = 8192, AT_BUF = AT_KB + AT_VB;
constexpr int AT_WSF = 2 * AT_BUF, AT_OST = AT_WSF + NWAVES * 256, AT_LDS = AT_OST + NWAVES * 4096;
__device__ __forceinline__ void attn_stage(LAS unsigned char* lds, int buf, const bf16_t* Kt, const bf16_t* Vt, int wid, int lane) {
    LAS unsigned char* kb = lds + buf * AT_BUF; LAS unsigned char* vb = kb + AT_KB;
    __builtin_amdgcn_global_load_lds((const unsigned*)((const char*)Kt + wid * 1024 + lane * 16), (LAS unsigned*)(kb + wid * 1024), 16, 0, 0);
    if (wid < 4) __builtin_amdgcn_global_load_lds((const unsigned*)((const char*)Kt + (8 + wid) * 1024 + lane * 16), (LAS unsigned*)(kb + (8 + wid) * 1024), 16, 0, 0);
    __builtin_amdgcn_global_load_lds((const unsigned*)((const char*)Vt + wid * 1024 + lane * 16), (LAS unsigned*)(vb + wid * 1024), 16, 0, 0);
}
__device__ __forceinline__ void attn_unit(LAS unsigned char* lds, int bh, int qb, const bf16_t* Q, const bf16_t* Kg, const bf16_t* Vg, bf16_t* OA) {
    const int tid = threadIdx.x, lane = tid & 63, r32 = lane & 31, hi = lane >> 5; const int wid = __builtin_amdgcn_readfirstlane(tid >> 6);
    const int b = bh >> 3, h = bh & 7; const int q0 = qb * 256;
    const bf16_t* Qw = Q + ((size_t)bh * SEQ + q0 + wid * 32) * 96;
    const bf16_t* Kt = Kg + (size_t)bh * 64 * 6144; const bf16_t* Vt = Vg + (size_t)bh * 64 * 4096;
    LAS float* wsf = (LAS float*)(lds + AT_WSF) + wid * 64;
    const int NT = 4 * (qb + 1);
    __syncthreads();
    attn_stage(lds, 0, Kt, Vt, wid, lane);
    bf16x8 qr[6];
#pragma unroll
    for (int d0 = 0; d0 < 6; ++d0) qr[d0] = *(const bf16x8*)(Qw + (size_t)r32 * 96 + d0 * 16 + hi * 8);
    float mrun = 0.f, lrun = 0.f; f32x16 o0 = {}, o1 = {};
    const bf16x8 aext = __builtin_bit_cast(bf16x8, (u32x4){hi == 0 ? 0x3F80u : 0u, 0u, 0u, 0u});
    bf16x8 qext = __builtin_bit_cast(bf16x8, (u32x4){0u, 0u, 0u, 0u});
    const int qrel = wid * 32 + r32;
    for (int t = 0; t < NT; ++t) {
        asm volatile("s_waitcnt vmcnt(0)" ::: "memory"); __syncthreads();
        if (t + 1 < NT) attn_stage(lds, (t + 1) & 1, Kt + (size_t)(t + 1) * 6144, Vt + (size_t)(t + 1) * 4096, wid, lane);
        const LAS unsigned char* kb = lds + (t & 1) * AT_BUF + hi * 1024 + r32 * 16; const LAS unsigned char* vbase = lds + (t & 1) * AT_BUF + AT_KB;
        f32x16 p0 = {}, p1 = {};
        p0 = __builtin_amdgcn_mfma_f32_32x32x16_bf16(aext, qext, p0, 0, 0, 0); p1 = __builtin_amdgcn_mfma_f32_32x32x16_bf16(aext, qext, p1, 0, 0, 0);
#pragma unroll
        for (int d0 = 0; d0 < 6; ++d0) { const bf16x8 a0 = *(const LAS bf16x8*)(kb + d0 * 2048), a1 = *(const LAS bf16x8*)(kb + d0 * 2048 + 512);
            p0 = __builtin_amdgcn_mfma_f32_32x32x16_bf16(a0, qr[d0], p0, 0, 0, 0); p1 = __builtin_amdgcn_mfma_f32_32x32x16_bf16(a1, qr[d0], p1, 0, 0, 0); }
        const int jb = t - (NT - 4);
        if (jb >= 0) { const int kbase = 64 * jb + 4 * hi;
#pragma unroll
            for (int r = 0; r < 16; ++r) { const int kv = kbase + (r & 3) + 8 * (r >> 2); if (kv > qrel) p0[r] = -INFINITY; if (kv + 32 > qrel) p1[r] = -INFINITY; } }
        float rm = p0[0];
#pragma unroll
        for (int r = 1; r < 16; ++r) rm = fmaxf(rm, p0[r]);
#pragma unroll
        for (int r = 0; r < 16; ++r) rm = fmaxf(rm, p1[r]);
        rm = fmaxf(rm, __shfl_xor(rm, 32));
        const bool need = (t == 0) || (rm > 6.f);
        if (__any(need)) {
            const float mnew = need ? __builtin_bit_cast(float, cvt_pk_bf16(mrun + rm, 0.f) << 16) : mrun; const float delta = mnew - mrun; mrun = mnew;
            qext = __builtin_bit_cast(bf16x8, (u32x4){hi == 0 ? (cvt_pk_bf16(-mnew, 0.f) & 0xffffu) : 0u, 0u, 0u, 0u});
            const float alpha = __builtin_amdgcn_exp2f(-delta);
            f32x2 ps2 = {0.f, 0.f};
#pragma unroll
            for (int r = 0; r < 16; r += 2) { p0[r] = __builtin_amdgcn_exp2f(p0[r] - delta); p0[r + 1] = __builtin_amdgcn_exp2f(p0[r + 1] - delta); p1[r] = __builtin_amdgcn_exp2f(p1[r] - delta); p1[r + 1] = __builtin_amdgcn_exp2f(p1[r + 1] - delta);
                ps2 += (f32x2){p0[r], p0[r + 1]}; ps2 += (f32x2){p1[r], p1[r + 1]}; }
            lrun = lrun * alpha + (ps2[0] + ps2[1]);
            if (hi == 0) wsf[r32] = alpha;
            asm volatile("s_waitcnt lgkmcnt(0)" ::: "memory");
#pragma unroll
            for (int r = 0; r < 16; ++r) { const float f = wsf[crow(r, hi)]; o0[r] *= f; o1[r] *= f; }
        } else {
            f32x2 ps2 = {0.f, 0.f};
#pragma unroll
            for (int r = 0; r < 16; r += 2) { p0[r] = __builtin_amdgcn_exp2f(p0[r]); p0[r + 1] = __builtin_amdgcn_exp2f(p0[r + 1]); p1[r] = __builtin_amdgcn_exp2f(p1[r]); p1[r + 1] = __builtin_amdgcn_exp2f(p1[r + 1]);
                ps2 += (f32x2){p0[r], p0[r + 1]}; ps2 += (f32x2){p1[r], p1[r + 1]}; }
            lrun += ps2[0] + ps2[1];
        }
        bf16x8 pa[4];
#pragma unroll
        for (int s = 0; s < 2; ++s) { u32x4 w0, w1;
            w0.x = cvt_pk_bf16(p0[8 * s + 0], p0[8 * s + 1]); w0.y = cvt_pk_bf16(p0[8 * s + 2], p0[8 * s + 3]); w0.z = cvt_pk_bf16(p0[8 * s + 4], p0[8 * s + 5]); w0.w = cvt_pk_bf16(p0[8 * s + 6], p0[8 * s + 7]);
            w1.x = cvt_pk_bf16(p1[8 * s + 0], p1[8 * s + 1]); w1.y = cvt_pk_bf16(p1[8 * s + 2], p1[8 * s + 3]); w1.z = cvt_pk_bf16(p1[8 * s + 4], p1[8 * s + 5]); w1.w = cvt_pk_bf16(p1[8 * s + 6], p1[8 * s + 7]);
            pa[s] = __builtin_bit_cast(bf16x8, w0); pa[2 + s] = __builtin_bit_cast(bf16x8, w1); }
        const LAS unsigned char* vp = vbase + ((lane >> 4) & 1) * 32 + (lane & 3) * 8 + (4 * hi + ((lane & 15) >> 2)) * 64;
#pragma unroll
        for (int d0 = 0; d0 < 2; ++d0)
#pragma unroll
            for (int ks = 0; ks < 4; ++ks) {
                const s16x4 lo = __builtin_bit_cast(s16x4, __builtin_amdgcn_ds_read_tr16_b64_v4i16((LAS s16x4*)(vp + d0 * 4096 + ks * 1024)));
                const s16x4 hh = __builtin_bit_cast(s16x4, __builtin_amdgcn_ds_read_tr16_b64_v4i16((LAS s16x4*)(vp + d0 * 4096 + ks * 1024 + 512)));
                const bf16x8 vf = (bf16x8){lo[0], lo[1], lo[2], lo[3], hh[0], hh[1], hh[2], hh[3]};
                if (d0 == 0) o0 = __builtin_amdgcn_mfma_f32_32x32x16_bf16(pa[ks], vf, o0, 0, 0, 0); else o1 = __builtin_amdgcn_mfma_f32_32x32x16_bf16(pa[ks], vf, o1, 0, 0, 0);
            }
    }
    lrun += __shfl_xor(lrun, 32);
    if (hi == 0) wsf[32 + r32] = 1.f / lrun;
    asm volatile("s_waitcnt lgkmcnt(0)" ::: "memory");
    LAS bf16_t* stg = (LAS bf16_t*)(lds + AT_OST) + wid * 2048;
#pragma unroll
    for (int r = 0; r < 16; ++r) { const int orow = crow(r, hi); const float il = wsf[32 + orow];
        stg[orow * 64 + r32] = (bf16_t)(cvt_pk_bf16(o0[r] * il, 0.f) & 0xffffu); stg[orow * 64 + 32 + r32] = (bf16_t)(cvt_pk_bf16(o1[r] * il, 0.f) & 0xffffu); }
    asm volatile("s_waitcnt lgkmcnt(0)" ::: "memory");
    bf16_t* Ow = OA + ((size_t)b * SEQ + q0 + wid * 32) * 512 + h * 64;
#pragma unroll
    for (int i = 0; i < 4; ++i) { const int row = i * 8 + (lane >> 3), ch = lane & 7; const u32x4 v = *(const LAS u32x4*)(stg + row * 64 + ch * 8); *(u32x4*)(Ow + (size_t)row * 512 + ch * 8) = v; }
}

constexpr int SC_CH = 32;
constexpr int SC_BUF = SC_CH * 384 * 4;
constexpr int SC_Y = 2 * SC_BUF;
__device__ __forceinline__ void scan_unit(LAS unsigned char* lds, int bh, const bf16_t* SIN, float* Y) {
    const int tid = threadIdx.x, v = tid >> 3, kq = tid & 7; const int b = bh >> 3, h = bh & 7;
    const bf16_t* src = SIN + (size_t)bh * SEQ * 384;
    float S[8];
#pragma unroll
    for (int i = 0; i < 8; ++i) S[i] = 0.f;
    u32x4 st[3];
    auto load_chunk = [&](int c) {
#pragma unroll
        for (int j = 0; j < 3; ++j) st[j] = *(const u32x4*)((const char*)src + (size_t)c * (SC_CH * 768) + (size_t)(j * 512 + tid) * 16); };
    auto write_chunk = [&](int buf) { LAS float* dst = (LAS float*)(lds + buf * SC_BUF);
#pragma unroll
        for (int j = 0; j < 3; ++j) { const int e0 = (j * 512 + tid) * 8; f32x4 a, bq; unpack8(st[j], a, bq); *(LAS f32x4*)(dst + e0) = a; *(LAS f32x4*)(dst + e0 + 4) = bq; } };
    __syncthreads();
    load_chunk(0); write_chunk(0);
    const int NCH = SEQ / SC_CH;
    LAS float* yb = (LAS float*)(lds + SC_Y);
    for (int c = 0; c < NCH; ++c) {
        __syncthreads();
        if (c + 1 < NCH) load_chunk(c + 1);
        const LAS float* in = (const LAS float*)(lds + (c & 1) * SC_BUF);
#pragma unroll 2
        for (int t = 0; t < SC_CH; ++t) {
            const LAS float* p = in + t * 384 + 8 * kq;
            const f32x4 r0 = *(const LAS f32x4*)(p), r1 = *(const LAS f32x4*)(p + 4);
            const f32x4 x0 = *(const LAS f32x4*)(p + 64), x1 = *(const LAS f32x4*)(p + 68);
            const f32x4 k0 = *(const LAS f32x4*)(p + 128), k1 = *(const LAS f32x4*)(p + 132);
            const f32x4 n0 = *(const LAS f32x4*)(p + 256), n1 = *(const LAS f32x4*)(p + 260);
            const f32x4 b0 = *(const LAS f32x4*)(p + 320), b1 = *(const LAS f32x4*)(p + 324);
            const float vv = in[t * 384 + 192 + v];
            float sa = (S[0] * n0[0] + S[1] * n0[1]) + (S[2] * n0[2] + S[3] * n0[3]) + (S[4] * n1[0] + S[5] * n1[1]) + (S[6] * n1[2] + S[7] * n1[3]);
            sa = -sum8(sa);
            float yy = 0.f;
#pragma unroll
            for (int i = 0; i < 4; ++i) { S[i] = S[i] - S[i] * x0[i] + sa * b0[i] + vv * k0[i]; S[4 + i] = S[4 + i] - S[4 + i] * x1[i] + sa * b1[i] + vv * k1[i]; }
            yy = (S[0] * r0[0] + S[1] * r0[1]) + (S[2] * r0[2] + S[3] * r0[3]) + (S[4] * r1[0] + S[5] * r1[1]) + (S[6] * r1[2] + S[7] * r1[3]);
            yy = sum8(yy);
            if (kq == 0) yb[t * 64 + v] = yy;
        }
        __syncthreads();
        { const int e0 = tid * 4; const int t = e0 >> 6, vv0 = e0 & 63; const f32x4 yv = *(const LAS f32x4*)(yb + e0);
          *(f32x4*)(Y + ((size_t)b * SEQ + (size_t)c * SC_CH + t) * 512 + h * 64 + vv0) = yv; }
        if (c + 1 < NCH) write_chunk((c + 1) & 1);
    }
}
__device__ __forceinline__ f32x4 ld4bf(const bf16_t* p) { const u32x2 w = *(const u32x2*)p; return (f32x4){bf_lo(w.x), bf_hi(w.x), bf_lo(w.y), bf_hi(w.y)}; }
__device__ __forceinline__ void st4bf(bf16_t* p, f32x4 v) { u32x2 w; w.x = cvt_pk_bf16(v[0], v[1]); w.y = cvt_pk_bf16(v[2], v[3]); *(u32x2*)p = w; }
__device__ __forceinline__ void ld8bf(const bf16_t* p, float (&v)[8]) { const u32x4 w = *(const u32x4*)p; v[0] = bf_lo(w.x); v[1] = bf_hi(w.x); v[2] = bf_lo(w.y); v[3] = bf_hi(w.y); v[4] = bf_lo(w.z); v[5] = bf_hi(w.z); v[6] = bf_lo(w.w); v[7] = bf_hi(w.w); }
__device__ __forceinline__ void st8bf(bf16_t* p, const float (&v)[8]) { u32x4 w; w.x = cvt_pk_bf16(v[0], v[1]); w.y = cvt_pk_bf16(v[2], v[3]); w.z = cvt_pk_bf16(v[4], v[5]); w.w = cvt_pk_bf16(v[6], v[7]); *(u32x4*)p = w; }
__device__ __forceinline__ void ld8f(const float* p, float (&v)[8]) { const f32x4 a = *(const f32x4*)p, b = *(const f32x4*)(p + 4); v[0] = a[0]; v[1] = a[1]; v[2] = a[2]; v[3] = a[3]; v[4] = b[0]; v[5] = b[1]; v[6] = b[2]; v[7] = b[3]; }
__device__ __forceinline__ void up8(u32x4 w, float (&v)[8]) { v[0] = bf_lo(w.x); v[1] = bf_hi(w.x); v[2] = bf_lo(w.y); v[3] = bf_hi(w.y); v[4] = bf_lo(w.z); v[5] = bf_hi(w.z); v[6] = bf_lo(w.w); v[7] = bf_hi(w.w); }
}

namespace fk {
constexpr size_t WS_WM = 684 * MiB;
constexpr size_t WS_WN = 236 * MiB;
constexpr size_t WS_WQ1 = 748 * MiB;
constexpr size_t WS_WQ2 = 844 * MiB;
constexpr size_t WS_WSB = 876 * MiB;
constexpr size_t WS_WBS = 908 * MiB;
constexpr size_t WS_WVL = 652 * MiB;
static_assert(WS_WBS + (size_t)T * 8 * 4 <= WS_END, "wkv buffers");

constexpr int IMG = 8192;
enum { I_AT = 0, I_RT = 1, I_BT = 2, I_KT = 3, I_VTR = 4, I_ATR = 5, I_BH = 6, I_KH = 7, I_AAK = 8, I_ARB = 9, I_ARK = 10, I_G0 = 11  , I_G1 = 12  ,
       I_AO16 = 14, I_AO32 = 15, I_DTA = 16, I_ZTR = I_BT, I_W1TR = I_KT, I_W2TR = I_AT, I_XTR = I_KT, I_DTB = I_AT };
constexpr int WA_TOT = 17 * IMG;
constexpr int WA_PL = WA_TOT + 2048;
static_assert(WA_PL + 256 <= LDS_BYTES - 512, "wkv lds");

struct WLane { int r32, hi, trb; };
__device__ __forceinline__ WLane wlane(int lane) { WLane L; L.r32 = lane & 31; L.hi = lane >> 5; L.trb = (8 * L.hi + ((lane & 15) >> 2)) * 64 + ((lane >> 4) & 1) * 32 + (lane & 3) * 8; return L; }
__device__ __forceinline__ bf16x8 frag_cm(const LAS unsigned char* img, int blk, int d0, const WLane& L) { return *(const LAS bf16x8*)(img + (((2 * d0 + L.hi) * 64 + 32 * blk + L.r32) * 16)); }
__device__ __forceinline__ bf16x8 frag_tr(const LAS unsigned char* img, int blk, int d0, const WLane& L) {
    const LAS unsigned char* p = img + (blk * 4 + d0) * 1024 + L.trb;
    const s16x4 lo = __builtin_bit_cast(s16x4, __builtin_amdgcn_ds_read_tr16_b64_v4i16((LAS s16x4*)p));
    const s16x4 hh = __builtin_bit_cast(s16x4, __builtin_amdgcn_ds_read_tr16_b64_v4i16((LAS s16x4*)(p + 256)));
    return (bf16x8){lo[0], lo[1], lo[2], lo[3], hh[0], hh[1], hh[2], hh[3]};
}
template <bool ATR, bool BTR, int D0 = 0, int D1 = 4> __device__ __forceinline__ f32x16 tile_mm(f32x16 acc, const LAS unsigned char* ia, int ba, const LAS unsigned char* ib, int bb, const WLane& L) {
    bf16x8 a[D1 - D0], b[D1 - D0];
#pragma unroll
    for (int d0 = D0; d0 < D1; ++d0) { a[d0 - D0] = ATR ? frag_tr(ia, ba, d0, L) : frag_cm(ia, ba, d0, L); b[d0 - D0] = BTR ? frag_tr(ib, bb, d0, L) : frag_cm(ib, bb, d0, L); }
#pragma unroll
    for (int d0 = D0; d0 < D1; ++d0) acc = __builtin_amdgcn_mfma_f32_32x32x16_bf16(a[d0 - D0], b[d0 - D0], acc, 0, 0, 0);
    return acc;
}
__device__ __forceinline__ void st_cm(LAS unsigned char* img, const f32x16& v, int ba, int bb, const WLane& L) {
#pragma unroll
    for (int g = 0; g < 4; ++g) { u32x2 w; w.x = cvt_pk_bf16(v[4 * g], v[4 * g + 1]); w.y = cvt_pk_bf16(v[4 * g + 2], v[4 * g + 3]);
        *(LAS u32x2*)(img + (((4 * ba + g) * 64 + 32 * bb + L.r32) * 16 + 8 * L.hi)) = w; }
}
__device__ __forceinline__ void st_tr(LAS unsigned char* img, const f32x16& v, int ba, int bb, const WLane& L) {
    const int J = 32 * bb + L.r32;
#pragma unroll
    for (int g = 0; g < 4; ++g) { u32x2 w; w.x = cvt_pk_bf16(v[4 * g], v[4 * g + 1]); w.y = cvt_pk_bf16(v[4 * g + 2], v[4 * g + 3]);
        *(LAS u32x2*)(img + ((ba * 4 + (J >> 4)) * 1024 + (J & 15) * 64 + (8 * g + 4 * L.hi) * 2)) = w; }
}
#ifndef WREPID
#define WREPID -1
#endif
#define WREP(id) for (int _w = 0; _w < ((WREPID == (id)) ? 3 : 1); ++_w)
#define WBAR() do { asm volatile("s_waitcnt lgkmcnt(0)" ::: "memory"); __builtin_amdgcn_s_barrier(); asm volatile("" ::: "memory"); } while (0)


template <int R> __device__ __forceinline__ void subst16(const LAS float* af, LAS unsigned char* dcm, LAS unsigned char* dtr, int blk, int j, f32x16& tc) {
    float acc = (R == j) ? 1.f : 0.f;
    constexpr int NQ = (R + 3) / 4;
#pragma unroll
    for (int q = 0; q < NQ; ++q) { const f32x4 av = *(const LAS f32x4*)(af + R * 64 + 4 * q);
#pragma unroll
        for (int e = 0; e < 4; ++e) { const int sI = 4 * q + e; if (sI < R) acc += av[e] * tc[sI]; } }
    tc[R] = acc;
    const int t = 16 * blk + R, sg = 16 * blk + j; const unsigned short hv = (unsigned short)(cvt_pk_bf16(acc, 0.f) & 0xffffu);
    *(LAS unsigned short*)(dcm + (((sg >> 3) * 64 + t) * 16 + (sg & 7) * 2)) = hv;
    *(LAS unsigned short*)(dtr + (((sg >> 5) * 4 + (t >> 4)) * 1024 + (t & 15) * 64 + (sg & 31) * 2)) = hv;
    if constexpr (R + 1 < 16) subst16<R + 1>(af, dcm, dtr, blk, j, tc);
}
constexpr int WCV_IG = 16 * 32, WCV_ID = 16 * 16, WCV_NIT = 32 * (WCV_IG + WCV_ID), WCV_A = 7168;
__device__ __forceinline__ void wcv_load(CvtRegs& R, const Args& a, int it, int lane) {
    if (it < 32 * WCV_IG) { const int e = it / WCV_IG, rr = it % WCV_IG; convert_load8r(R, a.in[30] + (size_t)e * 1024 * 2048, 2048, rr / 32, rr % 32, lane); }
    else { const int qq = it - 32 * WCV_IG; const int e = qq / WCV_ID, rr = qq % WCV_ID; convert_load8r(R, a.in[32] + (size_t)e * 1024 * 1024, 1024, rr / 16, rr % 16, lane); }
}
constexpr int WA_CVB = 143360;
static_assert(WA_CVB >= WA_PL + 256 && WA_CVB + 16384 <= LDS_BYTES - 512, "wkv cvt lds");
__device__ __forceinline__ void wcv_q_src(const Args& a, int hit, const float*& W, int& N, unsigned char*& WT, int& kb, int& nb) { const int it = hit >> 2;
    if (it < 32 * WCV_IG) { const int e = it / WCV_IG, rr = it % WCV_IG; W = a.in[30] + (size_t)e * 1024 * 2048; N = 2048; WT = a.ws + WS_WGU + (size_t)e * 2048 * 1024; kb = rr / 32; nb = rr % 32; }
    else { const int qq = it - 32 * WCV_IG; const int e = qq / WCV_ID, rr = qq % WCV_ID; W = a.in[32] + (size_t)e * 1024 * 1024; N = 1024; WT = a.ws + WS_WDN + (size_t)e * 1024 * 1024; kb = rr / 16; nb = rr % 16; }
}
__device__ __forceinline__ void wcv_issue_q(LAS unsigned char* buf, const Args& a, int hit, int lane) {
    const float* W; int N, kb, nb; unsigned char* WT; wcv_q_src(a, hit, W, N, WT, kb, nb);
    const float* src = W + (size_t)(64 * kb + 16 * (hit & 3) + (lane >> 4)) * N + 64 * nb + (lane & 15) * 4;
#pragma unroll
    for (int i = 0; i < 4; ++i) __builtin_amdgcn_global_load_lds((const unsigned*)(src + (size_t)(4 * i) * N), (LAS unsigned*)(buf + i * 1024), 16, 0, 0);
}
__device__ __forceinline__ void wcv_finish_q(const LAS unsigned char* buf, const Args& a, int hit, int lane) {
    const float* W; int N, kb, nb; unsigned char* WT; wcv_q_src(a, hit, W, N, WT, kb, nb);
    asm volatile("s_waitcnt vmcnt(0)" ::: "memory");
    f32x16 v;
#pragma unroll
    for (int k = 0; k < 16; ++k) v[k] = *(const LAS float*)(buf + k * 256 + lane * 4);
    *(u32x4*)(WT + (size_t)(64 * nb + lane) * 1024 + 64 * kb + 16 * (hit & 3)) = convert_pack16(v, 64.f);
}
__device__ __forceinline__ void wcv_store(const CvtRegs& R, const Args& a, int it, int lane) {
    unsigned char* WGU = a.ws + WS_WGU; unsigned char* WDN = a.ws + WS_WDN;
    if (it < 32 * WCV_IG) { const int e = it / WCV_IG, rr = it % WCV_IG; convert_store8r(R, WGU + (size_t)e * 2048 * 1024, 1024, 64.f, rr / 32, rr % 32, lane); }
    else { const int qq = it - 32 * WCV_IG; const int e = qq / WCV_ID, rr = qq % WCV_ID; convert_store8r(R, WDN + (size_t)e * 1024 * 1024, 1024, 64.f, rr / 16, rr % 16, lane); }
}
__device__ __forceinline__ void wkv_phase_a(const Frame& F, const Args& a) {
    unsigned char* ws = a.ws; const bf16_t* PS = (const bf16_t*)(ws + WS_PS); const bf16_t* DEC = (const bf16_t*)(ws + WS_DEC); const bf16_t* AA = (const bf16_t*)(ws + WS_AA); bf16_t* WVL = (bf16_t*)(ws + WS_WVL);
    const float* mu = a.in[15]; const float* w0p = a.in[16]; const float* a0p = a.in[18]; const float* k_k = a.in[21]; const float* k_a = a.in[22]; const float* r_k = a.in[23];
    float* WM = (float*)(ws + WS_WM); float* WN = (float*)(ws + WS_WN); bf16_t* WQ1 = (bf16_t*)(ws + WS_WQ1); bf16_t* WQ2 = (bf16_t*)(ws + WS_WQ2); float* WBS = (float*)(ws + WS_WBS);
    LAS unsigned char* lds = F.lds; const int tid = F.tid, lane = F.lane, wave = F.wave; const WLane L = wlane(lane);
    LAS float* tot = (LAS float*)(lds + WA_TOT); LAS float* PLs = (LAS float*)(lds + WA_PL);
#define IMGP(i) (lds + (i) * IMG)
    for (int ck = F.vcu; ck < 4096; ck += F.G) {
        const int bh = ck >> 6, ch = ck & 63, h = bh & 7;
        WREP(0) { const int t = tid >> 3, j = tid & 7; const int c0 = h * 64 + 8 * j; const int sq = ch * 64 + t; const size_t tg = (size_t)(bh >> 3) * SEQ + sq;
          const bf16_t* ps = PS + tg * NPS + 512;
          float r[8], kp[8], v[8], kk[8], bb[8], G[8], lw[8], dw[8], aa[8];
          { float k[8], pr[8], pk[8], pv[8]; ld8bf(ps + c0, r); ld8bf(ps + 512 + c0, k); ld8bf(ps + 1024 + c0, v);
            if (sq != 0) { ld8bf(ps - NPS + c0, pr); ld8bf(ps - NPS + 512 + c0, pk); ld8bf(ps - NPS + 1024 + c0, pv); }
            else {
#pragma unroll
                for (int i = 0; i < 8; ++i) { pr[i] = 0.f; pk[i] = 0.f; pv[i] = 0.f; } }
            ld8bf(DEC + tg * 512 + c0, dw); ld8bf(AA + tg * 512 + c0, aa);
            float mur[8], muk[8], muv[8], kkc[8], kac[8], w0c[8], a0c[8];
            ld8f(mu + c0, mur); ld8f(mu + 512 + c0, muk); ld8f(mu + 1024 + c0, muv); ld8f(k_k + c0, kkc); ld8f(k_a + c0, kac); ld8f(w0p + c0, w0c); ld8f(a0p + c0, a0c);
            float ss = 0.f;
#pragma unroll
            for (int i = 0; i < 8; ++i) { r[i] += (pr[i] - r[i]) * mur[i]; k[i] += (pk[i] - k[i]) * muk[i]; v[i] += (pv[i] - v[i]) * muv[i]; kk[i] = k[i] * kkc[i]; ss += kk[i] * kk[i];
                const float z = -(w0c[i] + dw[i]); const float sp = z > 20.f ? z : __logf(1.f + __expf(z)); lw[i] = -__expf(-sp - 0.5f);
                aa[i] = fsigmoid(a0c[i] + aa[i]); }
            const float inv = 1.f / fmaxf(sqrtf(sum8(ss)), 1e-12f);
#pragma unroll
            for (int i = 0; i < 8; ++i) { kk[i] *= inv; kp[i] = k[i] * (1.f + (aa[i] - 1.f) * kac[i]); bb[i] = kk[i] * aa[i]; } }
          u32x4 vraw; vraw.x = cvt_pk_bf16(v[0], v[1]); vraw.y = cvt_pk_bf16(v[2], v[3]); vraw.z = cvt_pk_bf16(v[4], v[5]); vraw.w = cvt_pk_bf16(v[6], v[7]);
          *(u32x4*)(WVL + tg * 512 + c0) = vraw;
          float rkc[8]; ld8f(r_k + h * 64 + 8 * j, rkc); float bs = 0.f;
#pragma unroll
          for (int i = 0; i < 8; ++i) { G[i] = lw[i]; bs += r[i] * kp[i] * rkc[i]; }
          bs = sum8(bs); if (j == 0) WBS[((size_t)(bh >> 3) * SEQ + ch * 64 + t) * 8 + h] = bs;
#pragma unroll
          for (int off = 8; off < 64; off <<= 1) {
#pragma unroll
              for (int i = 0; i < 8; ++i) { const float o = __shfl_up(G[i], off); if (lane >= off) G[i] += o; } }
          if (lane >= 56) { *(LAS f32x4*)(tot + wave * 64 + 8 * j) = (f32x4){G[0], G[1], G[2], G[3]}; *(LAS f32x4*)(tot + wave * 64 + 8 * j + 4) = (f32x4){G[4], G[5], G[6], G[7]}; }
          WBAR();
          float GL[8];
#pragma unroll
          for (int i = 0; i < 8; ++i) GL[i] = 0.f;
#pragma unroll
          for (int w = 0; w < 8; ++w) { const f32x4 t0 = *(const LAS f32x4*)(tot + w * 64 + 8 * j), t1 = *(const LAS f32x4*)(tot + w * 64 + 8 * j + 4);
#pragma unroll
              for (int i = 0; i < 4; ++i) { GL[i] += t0[i]; GL[4 + i] += t1[i]; if (w < wave) { G[i] += t0[i]; G[4 + i] += t1[i]; } } }
          float At[8], Rt[8], Bt[8], Kt[8], Bh[8], Kh[8];
#pragma unroll
          for (int i = 0; i < 8; ++i) { const float P = __expf(G[i]), Pi = __expf(-G[i]), Pex = __expf(G[i] - lw[i]), Pl = __expf(GL[i] - G[i]);
              At[i] = -kk[i] * Pex; Rt[i] = r[i] * P; Bt[i] = bb[i] * Pi; Kt[i] = kp[i] * Pi; Bh[i] = bb[i] * Pl; Kh[i] = kp[i] * Pl; }
          if (t == 0) { *(LAS f32x4*)(PLs + 8 * j) = (f32x4){__expf(GL[0]), __expf(GL[1]), __expf(GL[2]), __expf(GL[3])}; *(LAS f32x4*)(PLs + 8 * j + 4) = (f32x4){__expf(GL[4]), __expf(GL[5]), __expf(GL[6]), __expf(GL[7])}; }
          const int cmo = (j * 64 + t) * 16; const int tro = ((j >> 2) * 4 + (t >> 4)) * 1024 + (t & 15) * 64 + (j & 3) * 16;
          u32x4 w;
#define PK8(A) (w.x = cvt_pk_bf16(A[0], A[1]), w.y = cvt_pk_bf16(A[2], A[3]), w.z = cvt_pk_bf16(A[4], A[5]), w.w = cvt_pk_bf16(A[6], A[7]), w)
          { const u32x4 p = PK8(At); *(LAS u32x4*)(IMGP(I_AT) + cmo) = p; *(LAS u32x4*)(IMGP(I_ATR) + tro) = p; }
          *(LAS u32x4*)(IMGP(I_RT) + cmo) = PK8(Rt); *(LAS u32x4*)(IMGP(I_BT) + cmo) = PK8(Bt); *(LAS u32x4*)(IMGP(I_KT) + cmo) = PK8(Kt);
          *(LAS u32x4*)(IMGP(I_BH) + tro) = PK8(Bh); *(LAS u32x4*)(IMGP(I_KH) + tro) = PK8(Kh); *(LAS u32x4*)(IMGP(I_VTR) + tro) = vraw;
#undef PK8
        WBAR(); }
        const int cvj = 16384 + ((ck / F.G) * F.G + F.vcu) * 3 + (wave - 1); const bool cvon2 = (wave >= 1) && (wave <= 3); LAS unsigned char* cvb2 = lds + WA_CVB + wave * 4096;
        if (cvon2) wcv_issue_q(cvb2, a, cvj, lane);
        WREP(1) { const int p = wave >> 1, fb = wave & 1; const LAS unsigned char* Lop = (p < 2) ? IMGP(I_AT) : IMGP(I_RT); const LAS unsigned char* Rop = (p & 1) ? IMGP(I_KT) : IMGP(I_BT);
          f32x16 x0 = {}, x1 = {}; x0 = tile_mm<false, false>(x0, Rop, 0, Lop, fb, L); x1 = tile_mm<false, false>(x1, Rop, 1, Lop, fb, L);
          const int tt = 32 * fb + L.r32; const bool incl = p >= 2;
#pragma unroll
          for (int rg = 0; rg < 16; ++rg) { const int s0 = crow(rg, L.hi); const bool k0 = incl ? (s0 <= tt) : (s0 < tt); const bool k1 = incl ? (s0 + 32 <= tt) : (s0 + 32 < tt); x0[rg] = k0 ? x0[rg] : 0.f; x1[rg] = k1 ? x1[rg] : 0.f; }
          if (p == 0) {
              LAS float* af = (LAS float*)IMGP(I_G1) + (32 * fb + L.r32) * 64;
#pragma unroll
              for (int g = 0; g < 4; ++g) { *(LAS f32x4*)(af + 8 * g + 4 * L.hi) = (f32x4){x0[4 * g], x0[4 * g + 1], x0[4 * g + 2], x0[4 * g + 3]};
                  *(LAS f32x4*)(af + 32 + 8 * g + 4 * L.hi) = (f32x4){x1[4 * g], x1[4 * g + 1], x1[4 * g + 2], x1[4 * g + 3]}; }
              f32x16 m0, m1;
#pragma unroll
              for (int rg = 0; rg < 16; ++rg) { const int s0 = crow(rg, L.hi); const bool todd = ((tt >> 4) & 1) != 0; const bool sev = ((s0 >> 4) & 1) == 0;
                  m0[rg] = (fb == 0 && todd && sev) ? x0[rg] : 0.f; m1[rg] = (fb == 1 && todd && sev) ? x1[rg] : 0.f; }
              st_cm(IMGP(I_AO16), m0, 0, fb, L); st_cm(IMGP(I_AO16), m1, 1, fb, L);
#pragma unroll
              for (int rg = 0; rg < 16; ++rg) { m0[rg] = (fb == 1) ? x0[rg] : 0.f; m1[rg] = 0.f; }
              st_cm(IMGP(I_AO32), m0, 0, fb, L); st_cm(IMGP(I_AO32), m1, 1, fb, L); }
          else { LAS unsigned char* dst = (p == 1) ? IMGP(I_AAK) : (p == 2) ? IMGP(I_ARB) : IMGP(I_ARK); st_cm(dst, x0, 0, fb, L); st_cm(dst, x1, 1, fb, L);
              if (p == 3) { LAS unsigned char* zi = fb ? IMGP(I_DTA) : IMGP(I_G0);
#pragma unroll
                  for (int i = 0; i < 8; ++i) *(LAS u32x4*)(zi + (i * 64 + lane) * 16) = (u32x4){0u, 0u, 0u, 0u}; } }
        WBAR(); }
        WREP(2) {
        if (wave == 0) { const int blk = lane >> 4, jj = lane & 15; f32x16 tc = {}; subst16<0>((const LAS float*)IMGP(I_G1) + blk * (16 * 64 + 16), IMGP(I_G0), IMGP(I_DTA), blk, jj, tc); }
        else if (wave >= 4) { const int fb = (wave >> 1) & 1, sb = wave & 1; f32x16 z = {}; z = tile_mm<true, false>(z, IMGP(I_VTR), sb, IMGP(I_AAK), fb, L); st_tr(IMGP(I_ZTR), z, sb, fb, L); }
        else wcv_finish_q(cvb2, a, cvj, lane);
        WBAR(); }
#define WDIAG1(V, SB, FB) do { if ((SB) == (FB)) { const int tt_ = 32 * (FB) + L.r32; _Pragma("unroll") for (int rg = 0; rg < 16; ++rg) if (32 * (SB) + crow(rg, L.hi) == tt_) V[rg] += 1.f; } } while (0)
        const int cvi = ((ck / F.G) * F.G + F.vcu) * 4 + (wave - 4); const bool cvon = (wave >= 4) && (cvi < 4 * WCV_A); LAS unsigned char* cvb = lds + WA_CVB + (wave & 3) * 4096;
        WREP(3) {
        if (wave < 4) { const int sb = wave & 1, fb = wave >> 1; f32x16 xx = {}; xx = tile_mm<true, false>(xx, IMGP(I_DTA), sb, IMGP(I_AO16), fb, L); WDIAG1(xx, sb, fb); st_tr(IMGP(I_XTR), xx, sb, fb, L); }
        else if (cvon) wcv_issue_q(cvb, a, cvi, lane);
        WBAR();
        if (wave < 4) { const int sb = wave & 1, fb = wave >> 1; f32x16 dd = {}; dd = tile_mm<true, false>(dd, IMGP(I_XTR), sb, IMGP(I_G0), fb, L); st_cm(IMGP(I_G1), dd, sb, fb, L); st_tr(IMGP(I_DTB), dd, sb, fb, L); }
        WBAR();
        if (wave < 4) { const int sb = wave & 1, fb = wave >> 1; f32x16 xx = {}; xx = tile_mm<true, false>(xx, IMGP(I_DTB), sb, IMGP(I_AO32), fb, L); WDIAG1(xx, sb, fb); st_tr(IMGP(I_XTR), xx, sb, fb, L); }
        WBAR();
        if (wave < 4) { const int sb = wave & 1, fb = wave >> 1; f32x16 dd = {}; dd = tile_mm<true, false>(dd, IMGP(I_XTR), sb, IMGP(I_G1), fb, L); st_cm(IMGP(I_G0), dd, sb, fb, L); }
        else if (cvon) wcv_finish_q(cvb, a, cvi, lane);
        WBAR();
        }
#undef WDIAG1
        WREP(4) { const int fb = (wave >> 1) & 1, sb = wave & 1; f32x16 wv = {};
          if (wave < 4) { wv = tile_mm<true, false>(wv, IMGP(I_ATR), sb, IMGP(I_G0), fb, L); st_tr(IMGP(I_W1TR), wv, sb, fb, L); }
          else { wv = tile_mm<true, false>(wv, IMGP(I_ZTR), sb, IMGP(I_G0), fb, L); st_tr(IMGP(I_W2TR), wv, sb, fb, L); }
        WBAR(); }
        WREP(5) { const int fb = (wave >> 1) & 1, sb = wave & 1; const int J = 32 * fb + L.r32;
          LAS unsigned char* SQ1 = IMGP(11); LAS unsigned char* SQ2 = IMGP(12); LAS unsigned char* SM = IMGP(13); LAS unsigned char* SN = IMGP(15);
          if (wave < 4) {
              f32x16 q = {}; q = tile_mm<true, false>(q, IMGP(I_W1TR), sb, IMGP(I_ARB), fb, L);
#pragma unroll
              for (int g = 0; g < 4; ++g) { const int c0 = 32 * sb + 8 * g + 4 * L.hi; const u32x2 rr = *(const LAS u32x2*)(IMGP(I_RT) + (((c0 >> 3) * 64 + J) * 16 + (c0 & 7) * 2));
                  u32x2 w; w.x = cvt_pk_bf16(q[4 * g] + bf_lo(rr.x), q[4 * g + 1] + bf_hi(rr.x)); w.y = cvt_pk_bf16(q[4 * g + 2] + bf_lo(rr.y), q[4 * g + 3] + bf_hi(rr.y));
                  *(LAS u32x2*)(SQ1 + J * 128 + (((c0 >> 3) ^ (J & 7)) * 16) + L.hi * 8) = w; }
              f32x16 q2 = {}; q2 = tile_mm<true, false>(q2, IMGP(I_W2TR), sb, IMGP(I_ARB), fb, L); q2 = tile_mm<true, false>(q2, IMGP(I_VTR), sb, IMGP(I_ARK), fb, L);
#pragma unroll
              for (int g = 0; g < 4; ++g) { const int c0 = 32 * sb + 8 * g + 4 * L.hi; u32x2 w; w.x = cvt_pk_bf16(q2[4 * g], q2[4 * g + 1]); w.y = cvt_pk_bf16(q2[4 * g + 2], q2[4 * g + 3]);
                  *(LAS u32x2*)(SQ2 + J * 128 + (((c0 >> 3) ^ (J & 7)) * 16) + L.hi * 8) = w; }
          } else {
              f32x16 m = {}; m = tile_mm<true, true>(m, IMGP(I_W1TR), sb, IMGP(I_BH), fb, L);
              const float pl = PLs[J];
#pragma unroll
              for (int g = 0; g < 4; ++g) { const int c0 = 32 * sb + 8 * g + 4 * L.hi; f32x4 o = (f32x4){m[4 * g], m[4 * g + 1], m[4 * g + 2], m[4 * g + 3]};
#pragma unroll
                  for (int jj = 0; jj < 4; ++jj) if (c0 + jj == J) o[jj] += pl;
                  *(LAS f32x4*)(SM + J * 256 + (((c0 >> 2) ^ (J & 15)) * 16)) = o; }
              f32x16 n = {}; n = tile_mm<true, true>(n, IMGP(I_W2TR), sb, IMGP(I_BH), fb, L); n = tile_mm<true, true>(n, IMGP(I_VTR), sb, IMGP(I_KH), fb, L);
#pragma unroll
              for (int g = 0; g < 4; ++g) { const int c0 = 32 * sb + 8 * g + 4 * L.hi; *(LAS f32x4*)(SN + J * 256 + (((c0 >> 2) ^ (J & 15)) * 16)) = (f32x4){n[4 * g], n[4 * g + 1], n[4 * g + 2], n[4 * g + 3]}; }
          }
          WBAR();
          { const int row = tid >> 3, qq = tid & 7; const int so = row * 128 + ((qq ^ (row & 7)) * 16); const size_t go = (size_t)ck * 4096 + (size_t)row * 64 + qq * 8;
            *(u32x4*)(WQ1 + go) = *(const LAS u32x4*)(SQ1 + so); *(u32x4*)(WQ2 + go) = *(const LAS u32x4*)(SQ2 + so); }
#pragma unroll
          for (int i = 0; i < 2; ++i) { const int idx = tid + 512 * i, row = idx >> 4, qq = idx & 15; const int so = row * 256 + ((qq ^ (row & 15)) * 16); const size_t go = (size_t)ck * 4096 + (size_t)row * 64 + qq * 4;
            *(f32x4*)(WM + go) = *(const LAS f32x4*)(SM + so); *(f32x4*)(WN + go) = *(const LAS f32x4*)(SN + so); }
        }
    }
#undef IMGP
}

constexpr int WB_S = 0;
constexpr int WB_CNT = 2 * 4352;
struct WBStage { f32x4 m0, m1, m2, m3, n; };
__device__ __forceinline__ void wb_load(WBStage& st, const float* WM, const float* WN, int ck, int wave, int j, int kk, int vq) {
    const float* mp = WM + (size_t)ck * 4096 + (size_t)(16 * wave + j) * 64 + 16 * kk;
    st.m0 = *(const f32x4*)(mp); st.m1 = *(const f32x4*)(mp + 4); st.m2 = *(const f32x4*)(mp + 8); st.m3 = *(const f32x4*)(mp + 12);
    st.n = *(const f32x4*)(WN + (size_t)ck * 4096 + (size_t)(16 * wave + j) * 64 + 16 * vq + 4 * kk);
}
__device__ __forceinline__ void wb_step(const WBStage& st, LAS float* Sl, LAS unsigned* cnt, bf16_t* WSB, int ck, int vq, int t256, int wave, int j, int kk, int step, bool pub) {
    const LAS float* Sin = Sl + (step & 1) * 1088; LAS float* Sout = Sl + ((step + 1) & 1) * 1088;
    if (pub) { const int v = t256 >> 4, c4 = (t256 & 15) * 4; const f32x4 sv = *(const LAS f32x4*)(Sin + v * 68 + c4); u32x2 w; w.x = cvt_pk_bf16(sv[0], sv[1]); w.y = cvt_pk_bf16(sv[2], sv[3]);
      *(u32x2*)(WSB + (size_t)ck * 4096 + (size_t)(16 * vq + v) * 64 + c4) = w; }
    f32x4 acc0 = st.n, acc1 = (f32x4){0.f, 0.f, 0.f, 0.f}; f32x4 sv[4];
#pragma unroll
    for (int q = 0; q < 4; ++q) sv[q] = *(const LAS f32x4*)(Sin + j * 68 + 16 * kk + 4 * q);
#define WB_2(SV, MV) acc0 = __builtin_amdgcn_mfma_f32_16x16x4f32(SV[0], MV[0], acc0, 0, 0, 0); acc1 = __builtin_amdgcn_mfma_f32_16x16x4f32(SV[1], MV[1], acc1, 0, 0, 0); \
                     acc0 = __builtin_amdgcn_mfma_f32_16x16x4f32(SV[2], MV[2], acc0, 0, 0, 0); acc1 = __builtin_amdgcn_mfma_f32_16x16x4f32(SV[3], MV[3], acc1, 0, 0, 0)
    WB_2(sv[0], st.m0); WB_2(sv[1], st.m1); WB_2(sv[2], st.m2); WB_2(sv[3], st.m3);
#undef WB_2
    acc0 = acc0 + acc1;
#pragma unroll
    for (int rg = 0; rg < 4; ++rg) Sout[(4 * kk + rg) * 68 + 16 * wave + j] = acc0[rg];
    asm volatile("s_waitcnt lgkmcnt(0)" ::: "memory");
    if ((t256 & 63) == 0) __hip_atomic_fetch_add(cnt, 1u, __ATOMIC_RELAXED, __HIP_MEMORY_SCOPE_WORKGROUP);
    const unsigned want = 4u * (unsigned)(step + 1);
    while (__hip_atomic_load(cnt, __ATOMIC_RELAXED, __HIP_MEMORY_SCOPE_WORKGROUP) < want) { }
    asm volatile("" ::: "memory");
}
__device__ __forceinline__ void wkv_phase_b(const Frame& F, const Args& a) {
    unsigned char* ws = a.ws; const float* WM = (const float*)(ws + WS_WM); const float* WN = (const float*)(ws + WS_WN); bf16_t* WSB = (bf16_t*)(ws + WS_WSB);
    LAS float* Sl = (LAS float*)(F.lds + WB_S); LAS unsigned* cnt = (LAS unsigned*)(F.lds + WB_CNT); const int lane = F.lane, wave = F.wave, tid = F.tid;
    __syncthreads();
    for (int i = tid; i < 2 * 1088; i += NTHR) Sl[i] = 0.f;
    if (tid == 0) *cnt = 0u;
    __syncthreads();
#ifndef WBREC_N
#define WBREC_N 1
#endif
#ifndef WBCONV_N
#define WBCONV_N 1
#endif
    if (wave < 4) {
        const int item = F.vcu; if (item < 256) {
        const int bh = item >> 2, vq = item & 3; const int j = lane & 15, kk = lane >> 4; const int ck0 = bh * 64;
        WBStage sA, sB, sC, sD;
        wb_load(sA, WM, WN, ck0 + 0, wave, j, kk, vq); wb_load(sB, WM, WN, ck0 + 1, wave, j, kk, vq); wb_load(sC, WM, WN, ck0 + 2, wave, j, kk, vq); wb_load(sD, WM, WN, ck0 + 3, wave, j, kk, vq);
#pragma unroll 1
        for (int ch = 0; ch < 64 * WBREC_N; ch += 4) {
#if WBREC_N > 1
            const int nx = (ch + 4) & 63, cc = ch & 63; const bool pub = ch < 64;
#else
            const int nx = (ch + 4 < 64) ? ch + 4 : 60, cc = ch; constexpr bool pub = true;
#endif
            { const WBStage cur = sA; wb_load(sA, WM, WN, ck0 + nx + 0, wave, j, kk, vq); wb_step(cur, Sl, cnt, WSB, ck0 + cc + 0, vq, tid, wave, j, kk, ch + 0, pub); }
            { const WBStage cur = sB; wb_load(sB, WM, WN, ck0 + nx + 1, wave, j, kk, vq); wb_step(cur, Sl, cnt, WSB, ck0 + cc + 1, vq, tid, wave, j, kk, ch + 1, pub); }
            { const WBStage cur = sC; wb_load(sC, WM, WN, ck0 + nx + 2, wave, j, kk, vq); wb_step(cur, Sl, cnt, WSB, ck0 + cc + 2, vq, tid, wave, j, kk, ch + 2, pub); }
            { const WBStage cur = sD; wb_load(sD, WM, WN, ck0 + nx + 3, wave, j, kk, vq); wb_step(cur, Sl, cnt, WSB, ck0 + cc + 3, vq, tid, wave, j, kk, ch + 3, pub); }
        } }
    } else {
        const int gwc = F.vcu * 4 + (wave - 4), NGWC = F.G * 4;
        unsigned char* WGU = ws + WS_WGU; unsigned char* WDN = ws + WS_WDN;
#pragma unroll 1
        for (int itx = WCV_A + gwc; itx < WCV_A + (WCV_NIT - WCV_A) * WBCONV_N; itx += NGWC) { const int it = WCV_A + (itx - WCV_A) % (WCV_NIT - WCV_A);
            CvtRegs R; wcv_load(R, a, it, lane); wcv_store(R, a, it, lane); }
    }
}

__device__ __forceinline__ void wkv_phase_c(const Frame& F, const Args& a) {
    unsigned char* ws = a.ws; const bf16_t* WQ1 = (const bf16_t*)(ws + WS_WQ1); const bf16_t* WQ2 = (const bf16_t*)(ws + WS_WQ2); const bf16_t* WSB = (const bf16_t*)(ws + WS_WSB); const float* WBS = (const float*)(ws + WS_WBS);
    const bf16_t* WVL = (const bf16_t*)(ws + WS_WVL); const bf16_t* GG = (const bf16_t*)(ws + WS_GG); bf16_t* OB = (bf16_t*)(ws + WS_OBIN); const float* ln_w = a.in[24]; const float* ln_b = a.in[25];
    const int gw = F.vcu * NWAVES + F.wave, NGW = F.G * NWAVES, lane = F.lane, r32 = lane & 31, hi = lane >> 5;
    __syncthreads();
    for (int u = gw; u < 8192; u += NGW) {
        const int ck = u >> 1, tb = u & 1, bh = ck >> 6, ch = ck & 63, b = bh >> 3, h = bh & 7; const int tl = 32 * tb + r32; const size_t tg = (size_t)b * SEQ + ch * 64 + tl;
        const bf16_t* sp = WSB + (size_t)ck * 4096; const bf16_t* qp = WQ1 + (size_t)ck * 4096 + (size_t)tl * 64; f32x16 y0 = {}, y1 = {};
#pragma unroll
        for (int d0 = 0; d0 < 4; ++d0) { const bf16x8 bq = *(const bf16x8*)(qp + 16 * d0 + 8 * hi); const bf16x8 a0 = *(const bf16x8*)(sp + (size_t)r32 * 64 + 16 * d0 + 8 * hi), a1 = *(const bf16x8*)(sp + (size_t)(32 + r32) * 64 + 16 * d0 + 8 * hi);
            y0 = __builtin_amdgcn_mfma_f32_32x32x16_bf16(a0, bq, y0, 0, 0, 0); y1 = __builtin_amdgcn_mfma_f32_32x32x16_bf16(a1, bq, y1, 0, 0, 0); }
        LAS unsigned char* stg = F.lds + F.wave * 8192;
#pragma unroll
        for (int g = 0; g < 4; ++g) { const int c16 = 2 * g + hi;
            *(LAS f32x4*)(stg + r32 * 256 + ((c16 ^ (r32 & 15)) * 16)) = (f32x4){y0[4 * g], y0[4 * g + 1], y0[4 * g + 2], y0[4 * g + 3]};
            *(LAS f32x4*)(stg + r32 * 256 + (((8 + c16) ^ (r32 & 15)) * 16)) = (f32x4){y1[4 * g], y1[4 * g + 1], y1[4 * g + 2], y1[4 * g + 3]}; }
        asm volatile("s_waitcnt lgkmcnt(0)" ::: "memory");
        const int c8 = lane & 7; float lw[8], lb[8]; ld8f(ln_w + h * 64 + 8 * c8, lw); ld8f(ln_b + h * 64 + 8 * c8, lb);
        const size_t tg0 = (size_t)b * SEQ + ch * 64 + 32 * tb;
        u32x4 q2r[4], vvr[4], ggr[4]; float bsr[4];
#pragma unroll
        for (int i = 0; i < 4; ++i) { const int tok = (lane >> 3) + 8 * i; const size_t tg = tg0 + tok;
            q2r[i] = *(const u32x4*)(WQ2 + (size_t)ck * 4096 + (size_t)(32 * tb + tok) * 64 + 8 * c8);
            vvr[i] = *(const u32x4*)(WVL + tg * 512 + h * 64 + 8 * c8); ggr[i] = *(const u32x4*)(GG + tg * 512 + h * 64 + 8 * c8); bsr[i] = WBS[tg * 8 + h]; }
#pragma unroll
        for (int i = 0; i < 4; ++i) { const int tok = (lane >> 3) + 8 * i; const size_t tg = tg0 + tok;
            const f32x4 ya = *(const LAS f32x4*)(stg + tok * 256 + (((2 * c8) ^ (tok & 15)) * 16)), yb = *(const LAS f32x4*)(stg + tok * 256 + (((2 * c8 + 1) ^ (tok & 15)) * 16));
            float y[8], q2[8], vv[8], gg[8]; up8(q2r[i], q2); up8(vvr[i], vv); up8(ggr[i], gg);
#pragma unroll
            for (int k = 0; k < 4; ++k) { y[k] = ya[k] + q2[k]; y[4 + k] = yb[k] + q2[4 + k]; }
            float sm = 0.f;
#pragma unroll
            for (int k = 0; k < 8; ++k) sm += y[k];
            const float mean = sum8(sm) * (1.f / 64.f); float vs = 0.f;
#pragma unroll
            for (int k = 0; k < 8; ++k) { y[k] -= mean; vs += y[k] * y[k]; }
            const float rstd = rsqrtf(sum8(vs) * (1.f / 64.f) + 64e-5f); float o[8];
#pragma unroll
            for (int k = 0; k < 8; ++k) o[k] = (y[k] * rstd * lw[k] + lb[k] + bsr[i] * vv[k]) * gg[k];
            st8bf(OB + tg * 512 + h * 64 + 8 * c8, o); }
        asm volatile("s_waitcnt lgkmcnt(0)" ::: "memory");
    }
}
}

#ifndef REPMASK
#define REPMASK 0
#endif
#ifndef REPN
#define REPN 1
#endif
namespace fk {
#define LDSW() asm volatile("s_waitcnt lgkmcnt(0)" ::: "memory")

__device__ __forceinline__ void phase_p0b(const Frame& F, const Args& a) {
    unsigned char* ws = a.ws;
    LAS float* scr = (LAS float*)(F.lds + F.wave * 16384);
    const int gw = F.vcu * NWAVES + F.wave, NGW = F.G * NWAVES;
    const int gthread = gw * 64 + F.lane, nthreads = NGW * 64;
    bf16_t* WinT = (bf16_t*)(ws + WS_WIN); bf16_t* WqT = (bf16_t*)(ws + WS_WQ); bf16_t* WkvT = (bf16_t*)(ws + WS_WKV); bf16_t* WloT = (bf16_t*)(ws + WS_WLORA);
    bf16_t* WoaT = (bf16_t*)(ws + WS_WOA); bf16_t* WobT = (bf16_t*)(ws + WS_WOB); bf16_t* WoutT = (bf16_t*)(ws + WS_WOUT);
    constexpr int I_IN = 16 * 133;
    constexpr int NITEMS = I_IN + 96 + 64 + 16 + 16 + 32 + 256 + 256 + 512;
    for (int it = gw; it < NITEMS; it += NGW) {
        int r = it;
        if (r < I_IN) { const int kb = r / 133, nb = r % 133; transpose_item(a.in[7], 4256, WinT, 1024, 0, (nb >= 13) ? 96 : 0, scr, kb, nb, F.lane); continue; } r -= I_IN;
        if (tr_try(r, a.in[9], 256, 768, WqT, 256, 0, 0, scr, F.lane)) continue;
        if (tr_try(r, a.in[11], 128, 1024, WkvT, 256, 0, 0, scr, F.lane)) continue;
        if (tr_try(r, a.in[17], 64, 512, WloT, 256, 0, 0, scr, F.lane)) continue;
        if (tr_try(r, a.in[19], 64, 512, WloT, 256, 64, 512, scr, F.lane)) continue;
        if (tr_try(r, a.in[20], 128, 512, WloT, 256, 128, 1024, scr, F.lane)) continue;
        if (tr_try(r, a.in[14], 512, 1024, WoaT, 512, 0, 0, scr, F.lane)) continue;
        if (tr_try(r, a.in[26], 512, 1024, WobT, 512, 0, 0, scr, F.lane)) continue;
        tr_try(r, a.in[27], 1024, 1024, WoutT, 1024, 0, 0, scr, F.lane);
    }
    zero_block(WinT, 1024, 416, 96, 0, 1024, gthread, nthreads);
    zero_block(WkvT, 256, 0, 1024, 128, 256, gthread, nthreads);
    zero_block(WloT, 256, 0, 512, 64, 256, gthread, nthreads);
    zero_block(WloT, 256, 512, 512, 0, 64, gthread, nthreads);
    zero_block(WloT, 256, 512, 512, 128, 256, gthread, nthreads);
    zero_block(WloT, 256, 1024, 512, 0, 128, gthread, nthreads);
    const int* pos = (const int*)a.in[2]; float* ROPE = (float*)(ws + WS_ROPE);
    for (int i = gthread; i < T * 16; i += nthreads) { const int t = i >> 4, j = i & 15; const float inv = powf(10000.f, -(float)j / 16.f); const float ang = (float)pos[t] * inv;
        ROPE[(size_t)t * 32 + j] = cosf(ang); ROPE[(size_t)t * 32 + 16 + j] = sinf(ang); }
}

__device__ __forceinline__ void phase_p0(const Frame& F, const Args& a) {
    unsigned char* ws = a.ws; const float* c = a.in[1]; const float* ada_w = a.in[3]; float* MODP = (float*)(ws + WS_MODP);
    const int gw = F.vcu * NWAVES + F.wave, NGW = F.G * NWAVES;
    LAS float* SC = (LAS float*)F.lds;
    for (int i = F.tid; i < 8 * 1024; i += NTHR) { const float cv = c[i]; SC[i] = cv * fsigmoid(cv); }
    __syncthreads();
    for (int it = gw; it < 96 * 16; it += NGW) {
        const int cg = it % 96, ks = it / 96; const int n = cg * 64 + F.lane;
        float acc[8];
#pragma unroll
        for (int b = 0; b < 8; ++b) acc[b] = 0.f;
#pragma unroll 1
        for (int k0 = ks * 64; k0 < ks * 64 + 64; k0 += 16) { float w[16];
#pragma unroll
            for (int i = 0; i < 16; ++i) w[i] = ada_w[(size_t)(k0 + i) * 6144 + n];
#pragma unroll
            for (int i = 0; i < 16; ++i)
#pragma unroll
                for (int b = 0; b < 8; ++b) acc[b] += SC[b * 1024 + k0 + i] * w[i]; }
#pragma unroll
        for (int b = 0; b < 8; ++b) MODP[((size_t)ks * 8 + b) * 6144 + n] = acc[b];
    }
}

__device__ __forceinline__ void load_row16(const float* xr, int lane, f32x4 (&v)[4]) {
#pragma unroll
    for (int j = 0; j < 4; ++j) v[j] = *(const f32x4*)(xr + 4 * lane + 256 * j);
}
__device__ __forceinline__ void phase_p1(const Frame& F, const Args& a) {
    unsigned char* ws = a.ws; const float* MODP = (const float*)(ws + WS_MODP); float* MOD = (float*)(ws + WS_MOD); const float* ada_b = a.in[4];
    const int wg = F.vcu;
    if (F.tid < 192) { const int i = wg * 192 + F.tid; const int b = i / 6144, n = i % 6144; float s = ada_b[n];
#pragma unroll
        for (int ks = 0; ks < 16; ++ks) s += MODP[((size_t)ks * 8 + b) * 6144 + n];
        MOD[i] = s; }
    const int b = (wg * 128) >> 12; LAS float* LA = (LAS float*)F.lds; LAS float* LB = LA + 1024; const float* nw = a.in[5];
    for (int i = F.tid; i < 1024; i += NTHR) { float sh = ada_b[i], sc = ada_b[1024 + i];
#pragma unroll
        for (int ks = 0; ks < 16; ++ks) { sh += MODP[((size_t)ks * 8 + b) * 6144 + i]; sc += MODP[((size_t)ks * 8 + b) * 6144 + 1024 + i]; }
        LA[i] = nw[i] * (1.f + sc); LB[i] = sh; }
    __syncthreads();
    const float* x = a.in[0]; bf16_t* H = (bf16_t*)(ws + WS_H);
    for (int rr = 0; rr < 16; rr += 4) { const int row = wg * 128 + F.wave * 16 + rr; f32x4 v[4][4];
#pragma unroll
        for (int q = 0; q < 4; ++q) load_row16(x + (size_t)(row + q) * 1024, F.lane, v[q]);
#pragma unroll
        for (int q = 0; q < 4; ++q) { float ss = 0.f;
#pragma unroll
            for (int j = 0; j < 4; ++j) ss += (v[q][j][0] * v[q][j][0] + v[q][j][1] * v[q][j][1]) + (v[q][j][2] * v[q][j][2] + v[q][j][3] * v[q][j][3]);
            const float rstd = rsqrtf(wave_sum(ss) * (1.f / 1024.f) + 1e-6f);
#pragma unroll
            for (int j = 0; j < 4; ++j) { const f32x4 A = *(const LAS f32x4*)(LA + 4 * F.lane + 256 * j), B = *(const LAS f32x4*)(LB + 4 * F.lane + 256 * j); const f32x4 o = v[q][j] * rstd * A + B;
                u32x2 w; w.x = cvt_pk_bf16(o[0], o[1]); w.y = cvt_pk_bf16(o[2], o[3]); *(u32x2*)(H + (size_t)(row + q) * 1024 + 4 * F.lane + 256 * j) = w; } } }
    __syncthreads();
    phase_p0b(F, a);
}

__device__ __forceinline__ void phase_p3(const Frame& F, const Args& a) {
    unsigned char* ws = a.ws; const bf16_t* PS = (const bf16_t*)(ws + WS_PS); bf16_t* AQ = (bf16_t*)(ws + WS_AQ); bf16_t* AKV = (bf16_t*)(ws + WS_AKV); bf16_t* AL = (bf16_t*)(ws + WS_ALORA);
    const float* qaw = a.in[8]; const float* kvaw = a.in[10]; const float* mu = a.in[15];
    const int gw = F.vcu * NWAVES + F.wave, NGW = F.G * NWAVES, l = F.lane;
    const f32x4 wq = *(const f32x4*)(qaw + 4 * l); const f32x4 wkv = (l < 32) ? *(const f32x4*)(kvaw + 4 * l) : (f32x4){0.f, 0.f, 0.f, 0.f}; const f32x4 mul = *(const f32x4*)(mu + 1536 + 4 * l);
    for (int t0 = gw; t0 < T; t0 += 2 * NGW) {
        f32x4 cq[2], ck[2], cur[2], prv[2];
#pragma unroll
        for (int u = 0; u < 2; ++u) { const int t = t0 + u * NGW; const bf16_t* ps = PS + (size_t)t * NPS;
            cq[u] = ld4bf(ps + 4 * l); ck[u] = (l < 32) ? ld4bf(ps + 256 + 4 * l) : (f32x4){0.f, 0.f, 0.f, 0.f};
            cur[u] = ld4bf(ps + 2048 + 4 * l); prv[u] = ((t & (SEQ - 1)) != 0) ? ld4bf(ps - NPS + 2048 + 4 * l) : (f32x4){0.f, 0.f, 0.f, 0.f}; }
#pragma unroll
        for (int u = 0; u < 2; ++u) { const int t = t0 + u * NGW;
            const float sq = wave_sum((cq[u][0] * cq[u][0] + cq[u][1] * cq[u][1]) + (cq[u][2] * cq[u][2] + cq[u][3] * cq[u][3]));
            const float sk = wave_sum((ck[u][0] * ck[u][0] + ck[u][1] * ck[u][1]) + (ck[u][2] * ck[u][2] + ck[u][3] * ck[u][3]));
            const float rq = rsqrtf(sq * (1.f / 256.f) + 1e-6f), rk = rsqrtf(sk * (1.f / 128.f) + 1e-6f);
            st4bf(AQ + (size_t)t * 256 + 4 * l, cq[u] * rq * wq); st4bf(AKV + (size_t)t * 256 + 4 * l, ck[u] * rk * wkv);
            f32x4 p = cur[u] + (prv[u] - cur[u]) * mul;
            if (l < 16) { const f32x4 s2 = sig4(p * 2.f); p = s2 * 2.f - 1.f; } else if (l >= 32) { p = sig4(p); }
            st4bf(AL + (size_t)t * 256 + 4 * l, p); }
    }
}

struct P5Raw { u32x4 q8, k8, v8; unsigned qa, qb, ka, kb; float cs0, cs1, sn0, sn1; };
__device__ __forceinline__ void p5_load(P5Raw& R, int t, int h, int j, const bf16_t* QRAW, const bf16_t* KVRAW, const bf16_t* PS, const float* ROPE) {
    R.q8 = *(const u32x4*)(QRAW + (size_t)t * 768 + h * 96 + 8 * j); R.qa = *(const unsigned*)(QRAW + (size_t)t * 768 + h * 96 + 64 + 2 * j); R.qb = *(const unsigned*)(QRAW + (size_t)t * 768 + h * 96 + 80 + 2 * j);
    R.k8 = *(const u32x4*)(KVRAW + (size_t)t * 1024 + h * 128 + 8 * j); R.ka = *(const unsigned*)(PS + (size_t)t * NPS + 384 + 2 * j); R.kb = *(const unsigned*)(PS + (size_t)t * NPS + 400 + 2 * j);
    R.v8 = *(const u32x4*)(KVRAW + (size_t)t * 1024 + h * 128 + 64 + 8 * j);
    const f32x2 cc = *(const f32x2*)(ROPE + (size_t)t * 32 + 2 * j), sn = *(const f32x2*)(ROPE + (size_t)t * 32 + 16 + 2 * j); R.cs0 = cc[0]; R.cs1 = cc[1]; R.sn0 = sn[0]; R.sn1 = sn[1];
}
__device__ __forceinline__ void p5_norm_rope(u32x4 raw8, unsigned ra, unsigned rb, const float (&w8)[8], float wr0, float wr1, float wr2, float wr3, float scale, const P5Raw& R, float (&x)[8], unsigned& o1, unsigned& o2) {
    up8(raw8, x); float x10 = bf_lo(ra), x11 = bf_hi(ra), x20 = bf_lo(rb), x21 = bf_hi(rb); float ss = x10 * x10 + x11 * x11 + x20 * x20 + x21 * x21;
#pragma unroll
    for (int i = 0; i < 8; ++i) ss += x[i] * x[i];
    const float rr = rsqrtf(sum8(ss) * (1.f / 96.f) + 1e-6f) * scale;
#pragma unroll
    for (int i = 0; i < 8; ++i) x[i] = x[i] * rr * w8[i];
    x10 *= rr * wr0; x11 *= rr * wr1; x20 *= rr * wr2; x21 *= rr * wr3;
    o1 = cvt_pk_bf16(x10 * R.cs0 - x20 * R.sn0, x11 * R.cs1 - x21 * R.sn1); o2 = cvt_pk_bf16(x20 * R.cs0 + x10 * R.sn0, x21 * R.cs1 + x11 * R.sn1);
}
__device__ __forceinline__ void phase_p5(const Frame& F, const Args& a) {
    unsigned char* ws = a.ws; const bf16_t* PS = (const bf16_t*)(ws + WS_PS); const bf16_t* QRAW = (const bf16_t*)(ws + WS_QRAW); const bf16_t* KVRAW = (const bf16_t*)(ws + WS_KVRAW); const float* ROPE = (const float*)(ws + WS_ROPE);
    bf16_t* Qo = (bf16_t*)(ws + WS_Q); bf16_t* Ko = (bf16_t*)(ws + WS_K); bf16_t* Vo = (bf16_t*)(ws + WS_V);
    const float* qnw = a.in[12]; const float* knw = a.in[13];
    const int gw = F.vcu * NWAVES + F.wave, NGW = F.G * NWAVES, l = F.lane, kl = l >> 3, j = l & 7;
    float qw[8], kw[8]; ld8f(qnw + 8 * j, qw); ld8f(knw + 8 * j, kw);
    const float qwr0 = qnw[64 + 2 * j], qwr1 = qnw[65 + 2 * j], qwr2 = qnw[80 + 2 * j], qwr3 = qnw[81 + 2 * j];
    const float kwr0 = knw[64 + 2 * j], kwr1 = knw[65 + 2 * j], kwr2 = knw[80 + 2 * j], kwr3 = knw[81 + 2 * j];
    for (int i0 = gw; i0 < T; i0 += 2 * NGW) {
        P5Raw R[2];
#pragma unroll
        for (int u = 0; u < 2; ++u) { const int it = i0 + u * NGW; p5_load(R[u], (it >> 3) * 8 + kl, it & 7, j, QRAW, KVRAW, PS, ROPE); }
#pragma unroll
        for (int u = 0; u < 2; ++u) { const int it = i0 + u * NGW; const int t = (it >> 3) * 8 + kl, h = it & 7; const int b = t >> 12, s = t & (SEQ - 1), bh = b * 8 + h, key = s & 63, tile = s >> 6;
            float x[8]; unsigned o1, o2;
            p5_norm_rope(R[u].q8, R[u].qa, R[u].qb, qw, qwr0, qwr1, qwr2, qwr3, QSCALE, R[u], x, o1, o2);
            bf16_t* qo = Qo + ((size_t)bh * SEQ + s) * 96; st8bf(qo + 8 * j, x); *(unsigned*)(qo + 64 + 2 * j) = o1; *(unsigned*)(qo + 80 + 2 * j) = o2;
            p5_norm_rope(R[u].k8, R[u].ka, R[u].kb, kw, kwr0, kwr1, kwr2, kwr3, 1.f, R[u], x, o1, o2);
            bf16_t* kt = Ko + ((size_t)bh * 64 + tile) * 6144; st8bf(kt + j * 512 + key * 8, x);
            *(unsigned*)(kt + (8 + (j >> 2)) * 512 + key * 8 + ((2 * j) & 7)) = o1; *(unsigned*)(kt + (10 + (j >> 2)) * 512 + key * 8 + ((2 * j) & 7)) = o2;
            *(u32x4*)(Vo + ((size_t)bh * 64 + tile) * 4096 + ((j >> 2) * 4 + (key >> 4)) * 512 + (key & 15) * 32 + 8 * (j & 3)) = R[u].v8; }
    }
}

__device__ __forceinline__ void phase_p6b(const Frame& F, const Args& a) {
    unsigned char* ws = a.ws; const float* Y = (const float*)(ws + WS_Y); const bf16_t* SIN = (const bf16_t*)(ws + WS_SCANIN); const bf16_t* GG = (const bf16_t*)(ws + WS_GG); bf16_t* OB = (bf16_t*)(ws + WS_OBIN);
    const float* r_k = a.in[23]; const float* ln_w = a.in[24]; const float* ln_b = a.in[25];
    const int gw = F.vcu * NWAVES + F.wave, NGW = F.G * NWAVES, l = F.lane, h = l >> 3, j = l & 7, c0 = h * 64 + 8 * j;
    float rkc[8], lw[8], lb[8]; ld8f(r_k + c0, rkc); ld8f(ln_w + c0, lw); ld8f(ln_b + c0, lb);
    for (int t = gw; t < T; t += NGW) {
        const int b = t >> 12, s = t & (SEQ - 1), bh = b * 8 + h;
        float y[8], r[8], kp[8], v[8], g[8]; ld8f(Y + (size_t)t * 512 + c0, y);
        const bf16_t* si = SIN + ((size_t)bh * SEQ + s) * 384 + 8 * j; ld8bf(si, r); ld8bf(si + 128, kp); ld8bf(si + 192, v); ld8bf(GG + (size_t)t * 512 + c0, g);
        float sm = 0.f, bs = 0.f;
#pragma unroll
        for (int i = 0; i < 8; ++i) { sm += y[i]; bs += r[i] * kp[i] * rkc[i]; }
        const float mean = sum8(sm) * (1.f / 64.f); bs = sum8(bs); float vs = 0.f;
#pragma unroll
        for (int i = 0; i < 8; ++i) { y[i] -= mean; vs += y[i] * y[i]; }
        const float rstd = rsqrtf(sum8(vs) * (1.f / 64.f) + 64e-5f); float o[8];
#pragma unroll
        for (int i = 0; i < 8; ++i) o[i] = (y[i] * rstd * lw[i] + lb[i] + bs * v[i]) * g[i];
        st8bf(OB + (size_t)t * 512 + c0, o);
    }
}

constexpr int P9_A = 0;
constexpr int P9_B = 8 * 4352;
constexpr int P9_LG = P9_B + 2 * 8448;
constexpr int P9_AB = P9_LG + 8 * 2112;
constexpr int P9_H = P9_AB + 8192;
__device__ __forceinline__ void phase_p9(const Frame& F, const Args& a) {
    unsigned char* ws = a.ws; const float* MOD = (const float*)(ws + WS_MOD); const bf16_t* x1 = (const bf16_t*)(ws + WS_X1B); unsigned char* H8 = ws + WS_H;
    int* TOPE = (int*)(ws + WS_TOPE); float* TOPW = (float*)(ws + WS_TOPW); int* HIST = (int*)(ws + WS_HIST);
    const float* nw = a.in[6]; const float* wr = a.in[28]; const float* br = a.in[29];
    const int wg = F.vcu, b = (wg * 128) >> 12, l = F.lane, wave = F.wave, tid = F.tid;
    LAS float* LAt = (LAS float*)(F.lds + P9_A) + wave * 1088; LAS float* LBt = (LAS float*)(F.lds + P9_B); LAS float* LG = (LAS float*)(F.lds + P9_LG) + wave * 528;
    LAS float* LA = (LAS float*)(F.lds + P9_AB); LAS float* LB = LA + 1024; LAS int* LH = (LAS int*)(F.lds + P9_H);
    for (int i = tid; i < 1024; i += NTHR) { LA[i] = nw[i] * (1.f + MOD[(size_t)b * 6144 + 4 * 1024 + i]); LB[i] = MOD[(size_t)b * 6144 + 3 * 1024 + i]; }
    if (tid < 32) LH[tid] = 0;
    const int bk = tid >> 3, be = (tid & 7) * 4;
    { const f32x4 w = *(const f32x4*)(wr + (size_t)bk * 32 + be); LAS float* d = LBt + bk * 33 + be; d[0] = w[0]; d[1] = w[1]; d[2] = w[2]; d[3] = w[3]; }
    const int r = l >> 2, q = l & 3; const int row0 = wg * 128 + wave * 16; const bf16_t* xr = x1 + (size_t)(row0 + r) * 1024;
    {
#pragma unroll 4
        for (int rr = 0; rr < 16; ++rr) { const bf16_t* xp = x1 + (size_t)(row0 + rr) * 1024 + 8 * l; float va[8], vb[8]; ld8bf(xp, va); ld8bf(xp + 512, vb); float s = 0.f;
#pragma unroll
            for (int i = 0; i < 8; ++i) s += va[i] * va[i] + vb[i] * vb[i];
            LAt[rr * 64 + l] = s; }
        asm volatile("s_waitcnt lgkmcnt(0)" ::: "memory");
    }
    float ss = 0.f;
#pragma unroll
    for (int i = 0; i < 4; ++i) { const f32x4 p = *(const LAS f32x4*)(LAt + r * 64 + 16 * q + 4 * i); ss += (p[0] + p[1]) + (p[2] + p[3]); }
    ss += __shfl_xor(ss, 1); ss += __shfl_xor(ss, 2);
    const float rstd = rsqrtf(ss * (1.f / 1024.f) + 1e-6f);
    __syncthreads();
    f32x4 acc0 = {0.f, 0.f, 0.f, 0.f}, acc1 = {0.f, 0.f, 0.f, 0.f};
    const int mi = l & 15, mk = l >> 4;
    u32x4 xv[2];
#pragma unroll
    for (int i = 0; i < 2; ++i) xv[i] = *(const u32x4*)(xr + 16 * q + 8 * i);
    for (int sl = 0; sl < 16; ++sl) {
        f32x4 wn; u32x4 xn[2]; if (sl + 1 < 16) { wn = *(const f32x4*)(wr + (size_t)((sl + 1) * 64 + bk) * 32 + be);
#pragma unroll
            for (int i = 0; i < 2; ++i) xn[i] = *(const u32x4*)(xr + 64 * (sl + 1) + 16 * q + 8 * i); }
        { const int kb0 = 64 * sl + 16 * q; unsigned char* ho = H8 + (size_t)(row0 + r) * 1024 + kb0; u32x4 pk;
#pragma unroll
          for (int i = 0; i < 4; ++i) { const unsigned w0_ = xv[i >> 1][2 * (i & 1)], w1_ = xv[i >> 1][2 * (i & 1) + 1]; const f32x4 v = (f32x4){bf_lo(w0_), bf_hi(w0_), bf_lo(w1_), bf_hi(w1_)}; const f32x4 A = *(const LAS f32x4*)(LA + kb0 + 4 * i), B = *(const LAS f32x4*)(LB + kb0 + 4 * i); const f32x4 hv = v * rstd * A + B;
              *(LAS f32x4*)(LAt + r * 68 + 16 * q + 4 * i) = hv;
              unsigned w8 = 0u; w8 = __builtin_amdgcn_cvt_pk_fp8_f32(hv[0], hv[1], w8, false); w8 = __builtin_amdgcn_cvt_pk_fp8_f32(hv[2], hv[3], w8, true); pk[i] = w8; }
          *(u32x4*)ho = pk; }
        asm volatile("s_waitcnt lgkmcnt(0)" ::: "memory");
        const LAS float* bb = LBt + (sl & 1) * 2112;
#pragma unroll
        for (int g = 0; g < 4; ++g) { const f32x4 av = *(const LAS f32x4*)(LAt + mi * 68 + 16 * mk + 4 * g);
#pragma unroll
            for (int e = 0; e < 4; ++e) { const int s = 4 * g + e; const float b0 = bb[(16 * mk + s) * 33 + mi], b1 = bb[(16 * mk + s) * 33 + 16 + mi];
                acc0 = __builtin_amdgcn_mfma_f32_16x16x4f32(av[e], b0, acc0, 0, 0, 0); acc1 = __builtin_amdgcn_mfma_f32_16x16x4f32(av[e], b1, acc1, 0, 0, 0); } }
        if (sl + 1 < 16) { LAS float* d = LBt + ((sl + 1) & 1) * 2112 + bk * 33 + be; d[0] = wn[0]; d[1] = wn[1]; d[2] = wn[2]; d[3] = wn[3];
#pragma unroll
            for (int i = 0; i < 2; ++i) xv[i] = xn[i]; }
        WBAR();
    }
#pragma unroll
    for (int rg = 0; rg < 4; ++rg) { LG[(4 * mk + rg) * 33 + mi] = acc0[rg] + br[mi]; LG[(4 * mk + rg) * 33 + 16 + mi] = acc1[rg] + br[16 + mi]; }
    asm volatile("s_waitcnt lgkmcnt(0)" ::: "memory");
    if (l < 16) { const int row = row0 + l; float lg[32];
#pragma unroll
        for (int e = 0; e < 32; ++e) lg[e] = LG[l * 33 + e];
        unsigned taken = 0u; int ie0 = 0, ie1 = 0, ie2 = 0, ie3 = 0; float ve0 = 0.f, ve1 = 0.f, ve2 = 0.f, ve3 = 0.f;
#pragma unroll
        for (int k = 0; k < 4; ++k) { int bi = 0; float bv = -INFINITY;
#pragma unroll
            for (int e = 0; e < 32; ++e) { const bool ok = !((taken >> e) & 1u) && (lg[e] > bv); bv = ok ? lg[e] : bv; bi = ok ? e : bi; }
            taken |= 1u << bi;
            if (k == 0) { ie0 = bi; ve0 = bv; } else if (k == 1) { ie1 = bi; ve1 = bv; } else if (k == 2) { ie2 = bi; ve2 = bv; } else { ie3 = bi; ve3 = bv; } }
        const float p1 = __expf(ve1 - ve0), p2 = __expf(ve2 - ve0), p3 = __expf(ve3 - ve0); const float inv = 1.f / (1.f + p1 + p2 + p3);
        *(int4*)(TOPE + (size_t)row * 4) = make_int4(ie0, ie1, ie2, ie3); *(float4*)(TOPW + (size_t)row * 4) = make_float4(inv, p1 * inv, p2 * inv, p3 * inv);
        __hip_atomic_fetch_add(&LH[ie0], 1, __ATOMIC_RELAXED, __HIP_MEMORY_SCOPE_WORKGROUP); __hip_atomic_fetch_add(&LH[ie1], 1, __ATOMIC_RELAXED, __HIP_MEMORY_SCOPE_WORKGROUP);
        __hip_atomic_fetch_add(&LH[ie2], 1, __ATOMIC_RELAXED, __HIP_MEMORY_SCOPE_WORKGROUP); __hip_atomic_fetch_add(&LH[ie3], 1, __ATOMIC_RELAXED, __HIP_MEMORY_SCOPE_WORKGROUP); }
    __syncthreads();
    if (tid < 32) HIST[wg * 32 + tid] = LH[tid];
}

__device__ __forceinline__ void phase_p10(const Frame& F, const Args& a) {
    unsigned char* ws = a.ws; const int* HIST = (const int*)(ws + WS_HIST); const int* TOPE = (const int*)(ws + WS_TOPE); const float* TOPW = (const float*)(ws + WS_TOPW);
    int* TOKSLOT = (int*)(ws + WS_TOKSLOT); int* ROWTOK = (int*)(ws + WS_ROWTOK); float* ROWW = (float*)(ws + WS_ROWW); int* TPRE = (int*)(ws + WS_TPRE);
    LAS int* Lcnt = (LAS int*)F.lds; LAS int* Lbase = Lcnt + 32; LAS int* Lpad = Lbase + 32; LAS int* Lrun = Lpad + 33; LAS int* Lred = Lrun + 32;
    const int wg = F.vcu;
    { const int e = F.tid & 31, w0 = F.tid >> 5; int tot = 0, bas = 0;
      for (int w = w0; w < F.G; w += 16) { const int c = HIST[w * 32 + e]; tot += c; bas += (w < wg) ? c : 0; }
      Lred[w0 * 64 + e] = tot; Lred[w0 * 64 + 32 + e] = bas; }
    __syncthreads();
    if (F.tid < 32) { int tot = 0, bas = 0;
#pragma unroll
        for (int w = 0; w < 16; ++w) { tot += Lred[w * 64 + F.tid]; bas += Lred[w * 64 + 32 + F.tid]; }
        Lcnt[F.tid] = tot; Lbase[F.tid] = bas; Lrun[F.tid] = 0; }
    __syncthreads();
    if (F.tid == 0) { int acc = 0; for (int e = 0; e < 32; ++e) { Lpad[e] = acc; acc += (Lcnt[e] + 255) >> 8; } Lpad[32] = acc; }
    __syncthreads();
    if (wg == 0 && F.tid < 33) TPRE[F.tid] = Lpad[F.tid];
    { const int row = wg * 128 + (F.tid >> 2), k = F.tid & 3; const int e = TOPE[(size_t)row * 4 + k]; const float w = TOPW[(size_t)row * 4 + k];
      const int rank = __hip_atomic_fetch_add(&Lrun[e], 1, __ATOMIC_RELAXED, __HIP_MEMORY_SCOPE_WORKGROUP); const int slot = Lpad[e] * 256 + Lbase[e] + rank;
      ROWTOK[slot] = row; ROWW[slot] = w; TOKSLOT[(size_t)row * 4 + k] = slot; }
    if (wg == 0) { for (int e = 0; e < 32; ++e) { const int s0 = Lpad[e] * 256 + Lcnt[e], s1 = Lpad[e + 1] * 256; for (int s = s0 + F.tid; s < s1; s += NTHR) { ROWTOK[s] = 0; ROWW[s] = 0.f; } } }
}

__device__ __forceinline__ void phase_p13(const Frame& F, const Args& a) {
    unsigned char* ws = a.ws; const float* MOD = (const float*)(ws + WS_MOD); const unsigned char* YS = ws + WS_YS; const int* TOKSLOT = (const int*)(ws + WS_TOKSLOT); float* out = a.out; const bf16_t* X1 = (const bf16_t*)(ws + WS_X1B);
    const int gw = F.vcu * NWAVES + F.wave, NGW = F.G * NWAVES, l = F.lane;
    int4 sln = *(const int4*)(TOKSLOT + (size_t)gw * 4), smn = *(const int4*)(TOKSLOT + (size_t)(gw + NGW) * 4);
    for (int t = gw; t < T; t += 2 * NGW) { const int t2 = t + NGW; const int b = t >> 12, b2 = t2 >> 12; const int4 sl = sln, sm = smn;
        if (t + 2 * NGW < T) { sln = *(const int4*)(TOKSLOT + (size_t)(t + 2 * NGW) * 4); smn = *(const int4*)(TOKSLOT + (size_t)(t2 + 2 * NGW) * 4); }
        f32x4 ya[4], yb[4];
#pragma unroll
        for (int j = 0; j < 4; ++j) { const int c = 4 * l + 256 * j;
            ya[j] = (ld4f8(YS + (size_t)sl.x * 1024 + c) + ld4f8(YS + (size_t)sl.y * 1024 + c)) + (ld4f8(YS + (size_t)sl.z * 1024 + c) + ld4f8(YS + (size_t)sl.w * 1024 + c));
            yb[j] = (ld4f8(YS + (size_t)sm.x * 1024 + c) + ld4f8(YS + (size_t)sm.y * 1024 + c)) + (ld4f8(YS + (size_t)sm.z * 1024 + c) + ld4f8(YS + (size_t)sm.w * 1024 + c)); }
#pragma unroll
        for (int j = 0; j < 4; ++j) { const int c = 4 * l + 256 * j; const f32x4 g2 = *(const f32x4*)(MOD + (size_t)b * 6144 + 5 * 1024 + c) * (1.f / YSC), h2 = *(const f32x4*)(MOD + (size_t)b2 * 6144 + 5 * 1024 + c) * (1.f / YSC);
            const f32x4 xv = ld4bf(X1 + (size_t)t * 1024 + c), xw = ld4bf(X1 + (size_t)t2 * 1024 + c);
            *(f32x4*)(out + (size_t)t * 1024 + c) = xv + g2 * ya[j]; *(f32x4*)(out + (size_t)t2 * 1024 + c) = xw + h2 * yb[j]; } }
}

__global__ void __launch_bounds__(NTHR, 2) mega(Args args) {
    extern __shared__ __attribute__((aligned(16))) unsigned char lds_raw[];
    Frame F; F.lds = (LAS unsigned char*)lds_raw; F.tid = threadIdx.x; F.lane = F.tid & 63; F.wave = __builtin_amdgcn_readfirstlane(F.tid >> 6);
    F.G = gridDim.x; { const int bx = blockIdx.x; F.vcu = (F.G % 8 == 0) ? (bx % 8) * (F.G / 8) + bx / 8 : bx; }
    volatile LAS unsigned* MISC = (volatile LAS unsigned*)(F.lds + MISC_OFF);
    unsigned char* ws = args.ws;
    for (int u = F.tid; u < 64; u += NTHR) MISC[u] = 0u;
    __syncthreads();
    const int lo = args.ph_lo, hi = args.ph_hi;
    XcdBarrier bar; bar.bar = (unsigned*)(ws + WS_CTL) + CW_BAR + args.bar_region * XCD_BAR_WORDS; bar.x = 0; bar.st = nullptr;
    if (hi - lo > 1) bar = xcd_barrier_post((unsigned*)(ws + WS_CTL) + CW_BAR + args.bar_region * XCD_BAR_WORDS, MISC + 8);
#ifndef ONLY
#define ONLY -1
#endif
#define IN(k) (lo <= (k) && (k) < hi && (ONLY < 0 || ONLY == (k)))
#ifndef REPMASK
#define REPMASK 0
#endif
#ifndef REPN
#define REPN 1
#endif
#define RP(k) for (int _rp = 0; _rp < (((REPMASK >> (k)) & 1) ? REPN : 1); ++_rp)
#if defined(TS_A) || defined(TSPIN)
#define TSREC(k) do { if (blockIdx.x == 0 && F.tid == 0) ((unsigned long long*)(ws + 768 * 1024))[(k)] = __builtin_amdgcn_s_memrealtime(); } while (0)
#else
#define TSREC(k) do {} while (0)
#endif
#define SEAM(k) do { if (IN(k) && IN((k) + 1)) xcd_barrier(bar); TSREC((k) + 1); } while (0)
    bf16_t* Gt = (bf16_t*)args.out;
    TSREC(0);
    if (IN(0)) RP(0) { phase_p0(F, args); } SEAM(0);
    if (IN(1)) RP(1) { phase_p1(F, args); } SEAM(1);
    if (IN(2)) RP(2) { pg8::Gemm g{(const bf16_t*)(ws + WS_H), (const bf16_t*)(ws + WS_WIN), T, NIN, 1024, 0}; pg8::StaticOrder S; S.init(T, NIN, F.G, (int)blockIdx.x);
        EpiP E{(bf16_t*)(ws + WS_PS), Gt}; pg8::gemm_phase<EpiP, pg8::StaticOrder>(F.lds, g, S, E); } SEAM(2);
    if (IN(3)) RP(3) { phase_p3(F, args); } SEAM(3);
    if (IN(4)) RP(4) {
        { pg8::Gemm g{(const bf16_t*)(ws + WS_AQ), (const bf16_t*)(ws + WS_WQ), T, 768, 256, 0}; pg8::StaticOrder S; S.init(T, 768, F.G, (int)blockIdx.x);
          EpiPlain E{(bf16_t*)(ws + WS_QRAW), 768}; pg8::gemm_phase<EpiPlain, pg8::StaticOrder>(F.lds, g, S, E); }
        { pg8::Gemm g{(const bf16_t*)(ws + WS_AKV), (const bf16_t*)(ws + WS_WKV), T, 1024, 256, 0}; pg8::StaticOrder S; S.init(T, 1024, F.G, (int)blockIdx.x);
          EpiPlain E{(bf16_t*)(ws + WS_KVRAW), 1024}; pg8::gemm_phase<EpiPlain, pg8::StaticOrder>(F.lds, g, S, E); }
        { pg8::Gemm g{(const bf16_t*)(ws + WS_ALORA), (const bf16_t*)(ws + WS_WLORA), T, 1536, 256, 0}; pg8::StaticOrder S; S.init(T, 1536, F.G, (int)blockIdx.x);
          EpiLora E{(bf16_t*)(ws + WS_DEC), (bf16_t*)(ws + WS_AA), (bf16_t*)(ws + WS_GG)}; pg8::gemm_phase<EpiLora, pg8::StaticOrder>(F.lds, g, S, E); }
    } SEAM(4);
    if (IN(5)) RP(5) { phase_p5(F, args); } SEAM(5);
    if (IN(6)) RP(6) { wkv_phase_a(F, args); } SEAM(6);
    if (IN(7)) RP(7) { wkv_phase_b(F, args); } SEAM(7);
    if (IN(8)) RP(8) {
        const int c = F.vcu;
#ifndef ATTN_N
#define ATTN_N 1
#endif
#ifndef WC_N
#define WC_N 1
#endif
#pragma unroll 1
        for (int r = 0; r < 4 * ATTN_N; ++r) { const int pos = (r & 1) ? (F.G - 1 - c) : c; const int uidx = (r & 3) * F.G + pos; if (uidx >= 1024) continue;
            const int qb = 15 - (uidx >> 6), bh = uidx & 63;
            attn_unit(F.lds, bh, qb, (const bf16_t*)(ws + WS_Q), (const bf16_t*)(ws + WS_K), (const bf16_t*)(ws + WS_V), (bf16_t*)(ws + WS_OA)); }
#pragma unroll 1
        for (int wcr = 0; wcr < WC_N; ++wcr) wkv_phase_c(F, args);
    } SEAM(8);
    if (IN(9)) RP(9) {
        { pg8::Gemm g{(const bf16_t*)(ws + WS_OA), (const bf16_t*)(ws + WS_WOA), T, 1024, 512, 0}; pg8::StaticOrder S; S.init(T, 1024, F.G, (int)blockIdx.x);
          EpiOA E{Gt, (bf16_t*)(ws + WS_M1)}; pg8::gemm_phase<EpiOA, pg8::StaticOrder>(F.lds, g, S, E); }
        { pg8::Gemm g{(const bf16_t*)(ws + WS_OBIN), (const bf16_t*)(ws + WS_WOB), T, 1024, 512, 0}; pg8::StaticOrder S; S.init(T, 1024, F.G, (int)blockIdx.x);
          EpiOB E{Gt, (const bf16_t*)(ws + WS_M1), (bf16_t*)(ws + WS_MERGED)}; pg8::gemm_phase<EpiOB, pg8::StaticOrder>(F.lds, g, S, E); }
    } SEAM(9);
    if (IN(10)) RP(10) { pg8::Gemm g{(const bf16_t*)(ws + WS_MERGED), (const bf16_t*)(ws + WS_WOUT), T, 1024, 1024, 0}; pg8::StaticOrder S; S.init(T, 1024, F.G, (int)blockIdx.x);
        EpiOut E{args.in[0], (const float*)(ws + WS_MOD), (bf16_t*)(ws + WS_X1B)}; pg8::gemm_phase<EpiOut, pg8::StaticOrder>(F.lds, g, S, E); } SEAM(10);
    if (IN(11)) RP(11) { phase_p9(F, args); } SEAM(11);
    if (IN(12)) RP(12) { phase_p10(F, args); } SEAM(12);
    if (IN(13) || IN(14)) {
        LAS int* tpre = (LAS int*)(F.lds + XTRA_OFF); LAS int* rowtab = tpre + 64;
        const int* TPRE = (const int*)(ws + WS_TPRE); const int* ROWTOK = (const int*)(ws + WS_ROWTOK);
        if (F.tid < 33) tpre[F.tid] = TPRE[F.tid];
        __syncthreads();
        if (IN(13)) RP(13) {
            pg8::MoeOrder<8, true> S; S.tpre = tpre; S.rowtab = rowtab; S.G = F.G; S.c = F.vcu;
            { pg8::Unit u; for (int i = 0; S.next(i, u); ++i) { if (F.tid < 256) rowtab[i * 256 + F.tid] = ROWTOK[u.pm * 256 + F.tid]; } }
            __syncthreads();
            pg8::Gemm g{(const bf16_t*)(ws + WS_H), (const bf16_t*)(ws + WS_WGU), MAXSLOT, 2048, 512, (size_t)2048 * 1024};
            EpiGU E{args.in[31], (bf16_t*)(ws + WS_ACT)}; pg8::gemm_phase<EpiGU, pg8::MoeOrder<8, true>, true, true>(F.lds, g, S, E);
        }
        SEAM(13);
        if (IN(14)) RP(14) {
#ifdef STG14
            { const unsigned long long t0 = __builtin_amdgcn_s_memrealtime(); const unsigned long long dt = (unsigned long long)(((F.vcu >> 3) & 7) * STG14); while (__builtin_amdgcn_s_memrealtime() - t0 < dt) __builtin_amdgcn_s_sleep(4); }
#endif
            pg8::MoeOrder<4, false> S; S.tpre = tpre; S.rowtab = rowtab; S.G = F.G; S.c = F.vcu;
            pg8::Gemm g{(const bf16_t*)(ws + WS_ACT), (const bf16_t*)(ws + WS_WDN), MAXSLOT, 1024, 512, (size_t)1024 * 1024};
            EpiDN E{args.in[33], (const float*)(ws + WS_ROWW), (bf16_t*)(ws + WS_YS)}; pg8::gemm_phase<EpiDN, pg8::MoeOrder<4, false>, true, true>(F.lds, g, S, E);
        }
    }
    SEAM(14);
    if (IN(15)) { phase_p13(F, args); }
#ifdef XBARS
#pragma unroll 1
    for (int _x = 0; _x < XBARS; ++_x) xcd_barrier(bar);
#endif
#ifdef TSPIN
    TSREC(16);
    if (blockIdx.x == 0 && F.tid == 0) { const unsigned long long* ts = (const unsigned long long*)(ws + 768 * 1024); const unsigned long long dt = (ts[TSPIN + 1] - ts[TSPIN]) * 4ull; const unsigned long long t0 = __builtin_amdgcn_s_memrealtime();
        while (__builtin_amdgcn_s_memrealtime() - t0 < dt) __builtin_amdgcn_s_sleep(8); }
#endif
#ifdef TS_A
    xcd_barrier(bar); TSREC(16); xcd_barrier(bar);
    { const unsigned long long* ts = (const unsigned long long*)(ws + 768 * 1024); const float c1 = (float)(ts[TS_A + 1] - ts[TS_A]) * 1e-3f, c2 = (float)(ts[TS_B + 1] - ts[TS_B]) * 1e-2f;
      const size_t gt = (size_t)blockIdx.x * NTHR + F.tid; for (size_t i = gt; i < (size_t)T * 1024; i += (size_t)F.G * NTHR) args.out[i] = (i == 0) ? c2 : c1; }
#endif
#undef IN
#undef SEAM
}

static int g_grid = 0;
inline bool host_init(size_t ws_size) {
    if (g_grid) return g_grid > 0;
    int dev = 0, cus = 0;
    if (hipGetDevice(&dev) != hipSuccess || hipDeviceGetAttribute(&cus, hipDeviceAttributeMultiprocessorCount, dev) != hipSuccess) { g_grid = -1; return false; }
    if (hipFuncSetAttribute((const void*)mega, hipFuncAttributeMaxDynamicSharedMemorySize, LDS_BYTES) != hipSuccess) { fprintf(stderr, "hipFuncSetAttribute failed\n"); g_grid = -1; return false; }
    if (ws_size < WS_END) { fprintf(stderr, "workspace too small: %zu < %zu\n", ws_size, (size_t)WS_END); g_grid = -1; return false; }
    (void)hipGetLastError();
    g_grid = cus;
    if (g_grid != 256) fprintf(stderr, "note: %d CUs (kernel tuned for 256)\n", g_grid);
    return true;
}
inline void fill_args(Args& a, void* const* d_in, void* d_out, void* d_ws) { memset(&a, 0, sizeof(a)); for (int i = 0; i < 34; ++i) a.in[i] = (const float*)d_in[i]; a.out = (float*)d_out; a.ws = (unsigned char*)d_ws; }
inline void launch_range(hipStream_t st, Args a, int lo, int hi, int region) { a.ph_lo = lo; a.ph_hi = hi; a.bar_region = region; hipLaunchKernelGGL(mega, dim3(g_grid), dim3(NTHR), LDS_BYTES, st, a); }
}

#if MODE == 2
namespace orc {
constexpr int D = 1024, SEQ = 4096, NB = 8;
constexpr int DIN = 4256, SLAB = 1792;
constexpr int OFF_CQ = 0, OFF_CKV = 256, OFF_KR = 384, OFF_SLAB = 416, OFF_GA = 2208, OFF_GB = 3232;

__device__ __forceinline__ float sigmoidf_(float x) { return 1.f / (1.f + expf(-x)); }
__device__ __forceinline__ float softplusf_(float x) { return x > 20.f ? x : log1pf(expf(x)); }

__global__ void k_mod(const float* c, const float* ada_w, const float* ada_b, float* mod, int b) {
    int n = blockIdx.x * blockDim.x + threadIdx.x; if (n >= 6 * D) return;
    float acc = 0.f;
    for (int k = 0; k < D; ++k) { float cv = c[b * D + k]; float s = cv / (1.f + expf(-cv)); acc += s * ada_w[(size_t)k * 6 * D + n]; }
    mod[n] = acc + ada_b[n];
}
__global__ void k_adaln(const float* x, const float* w, const float* shift, const float* scale, float* h) {
    __shared__ float red[256];
    const float* xr = x + (size_t)blockIdx.x * D; float ss = 0.f;
    for (int i = threadIdx.x; i < D; i += 256) ss += xr[i] * xr[i];
    red[threadIdx.x] = ss; __syncthreads();
    for (int o = 128; o > 0; o >>= 1) { if (threadIdx.x < o) red[threadIdx.x] += red[threadIdx.x + o]; __syncthreads(); }
    float r = rsqrtf(red[0] / D + 1e-6f);
    for (int i = threadIdx.x; i < D; i += 256) h[(size_t)blockIdx.x * D + i] = xr[i] * r * w[i] * (1.f + scale[i]) + shift[i];
}
__global__ void k_rmsrows(const float* in, int ld, int off, int n, const float* w, float* out, int rows) {
    int row = blockIdx.x * (blockDim.x / 64) + (threadIdx.x >> 6), lane = threadIdx.x & 63; if (row >= rows) return;
    const float* p = in + (size_t)row * ld + off; float ss = 0.f;
    for (int i = lane; i < n; i += 64) ss += p[i] * p[i];
    for (int o = 32; o > 0; o >>= 1) ss += __shfl_xor(ss, o);
    float r = rsqrtf(ss / n + 1e-6f);
    for (int i = lane; i < n; i += 64) out[(size_t)row * n + i] = p[i] * r * w[i];
}
struct GA { const float* A; const int* aidx; const float* W; size_t wstride; float* C; const float* bias; const int* goff; const int* gcnt; int lda, ldw, ldc, bstride, M, N, K, pad; };
__global__ __launch_bounds__(256) void k_gemm(GA g) {
    __shared__ float As[16][64 + 4], Ws[16][64 + 4];
    const int z = blockIdx.z; const int rowbase = g.goff ? g.goff[z] : 0; const int M = g.gcnt ? g.gcnt[z] : g.M;
    const int m0 = blockIdx.y * 64, n0 = blockIdx.x * 64; if (m0 >= M) return;
    const float* W = g.W + (size_t)z * g.wstride; const float* bias = g.bias ? g.bias + (size_t)z * g.bstride : nullptr;
    const int tx = threadIdx.x & 15, ty = threadIdx.x >> 4;
    float acc[4][4] = {};
    const int ar = threadIdx.x >> 2, ak = (threadIdx.x & 3) * 4;
    const int wk = threadIdx.x >> 4, wn = (threadIdx.x & 15) * 4;
    long arow = -1; if (m0 + ar < M) { int rr = rowbase + m0 + ar; arow = g.aidx ? g.aidx[rr] : rr; }
    for (int k0 = 0; k0 < g.K; k0 += 16) {
        float4 av = make_float4(0, 0, 0, 0);
        if (arow >= 0) av = *(const float4*)(g.A + (size_t)arow * g.lda + k0 + ak);
        As[ak + 0][ar] = av.x; As[ak + 1][ar] = av.y; As[ak + 2][ar] = av.z; As[ak + 3][ar] = av.w;
#pragma unroll
        for (int j = 0; j < 4; ++j) { int n = n0 + wn + j; Ws[wk][wn + j] = (n < g.N) ? W[(size_t)(k0 + wk) * g.ldw + n] : 0.f; }
        __syncthreads();
#pragma unroll
        for (int kk = 0; kk < 16; ++kk) {
            float a[4], w[4];
#pragma unroll
            for (int i = 0; i < 4; ++i) { a[i] = As[kk][ty * 4 + i]; w[i] = Ws[kk][tx * 4 + i]; }
#pragma unroll
            for (int i = 0; i < 4; ++i)
#pragma unroll
                for (int j = 0; j < 4; ++j) acc[i][j] += a[i] * w[j];
        }
        __syncthreads();
    }
#pragma unroll
    for (int i = 0; i < 4; ++i) { int m = m0 + ty * 4 + i; if (m >= M) continue;
#pragma unroll
        for (int j = 0; j < 4; ++j) { int n = n0 + tx * 4 + j; if (n >= g.N) continue;
            g.C[(size_t)(rowbase + m) * g.ldc + n] = acc[i][j] + (bias ? bias[n] : 0.f); } }
}
__global__ void k_qkfin(const float* q, const float* kv, const float* P, const int* positions, int b, const float* q_norm_w, const float* k_norm_w,
                        float* qf, float* kf, float* vf, int So) {
    int idx = blockIdx.x * (blockDim.x / 64) + (threadIdx.x >> 6), lane = threadIdx.x & 63; if (idx >= So * 8) return;
    int s = idx >> 3, h = idx & 7;
    float pos = (float)positions[b * SEQ + s];
    float q0 = q[(size_t)s * 768 + h * 96 + lane], q1 = lane < 32 ? q[(size_t)s * 768 + h * 96 + 64 + lane] : 0.f;
    float k0 = kv[(size_t)s * 1024 + h * 128 + lane], k1 = lane < 32 ? P[(size_t)s * DIN + OFF_KR + lane] : 0.f;
    float sq = q0 * q0 + q1 * q1, sk = k0 * k0 + k1 * k1;
    for (int o = 32; o > 0; o >>= 1) { sq += __shfl_xor(sq, o); sk += __shfl_xor(sk, o); }
    float rq = rsqrtf(sq / 96.f + 1e-6f), rk = rsqrtf(sk / 96.f + 1e-6f);
    q0 = q0 * rq * q_norm_w[lane]; k0 = k0 * rk * k_norm_w[lane];
    if (lane < 32) { q1 = q1 * rq * q_norm_w[64 + lane]; k1 = k1 * rk * k_norm_w[64 + lane]; }
    int i = lane & 15; float inv = powf(10000.f, -(float)i / 16.f); float ang = pos * inv; float cs = cosf(ang), sn = sinf(ang);
    float qo = __shfl(q1, lane ^ 16), ko = __shfl(k1, lane ^ 16);
    float q1r, k1r;
    if (lane < 16) { q1r = q1 * cs - qo * sn; k1r = k1 * cs - ko * sn; } else { q1r = q1 * cs + qo * sn; k1r = k1 * cs + ko * sn; }
    qf[((size_t)s * 8 + h) * 96 + lane] = q0; kf[((size_t)s * 8 + h) * 96 + lane] = k0;
    if (lane < 32) { qf[((size_t)s * 8 + h) * 96 + 64 + lane] = q1r; kf[((size_t)s * 8 + h) * 96 + 64 + lane] = k1r; }
    vf[((size_t)s * 8 + h) * 64 + lane] = kv[(size_t)s * 1024 + h * 128 + 64 + lane];
}
__global__ __launch_bounds__(64) void k_attn(const float* qf, const float* kf, const float* vf, float* oa) {
    __shared__ float Ks[64][96], Vs[64][64];
    const int qb = blockIdx.x, h = blockIdx.y, lane = threadIdx.x; const int sq = qb * 64 + lane;
    float q[96], o[64];
#pragma unroll
    for (int d = 0; d < 96; ++d) q[d] = qf[((size_t)sq * 8 + h) * 96 + d] * 0.10206207261596577f;
#pragma unroll
    for (int d = 0; d < 64; ++d) o[d] = 0.f;
    float m = -INFINITY, l = 0.f;
    for (int t = 0; t <= qb; ++t) {
        __syncthreads();
        for (int i = lane; i < 64 * 96; i += 64) { int r = i / 96, d = i % 96; Ks[r][d] = kf[((size_t)(t * 64 + r) * 8 + h) * 96 + d]; }
        for (int i = lane; i < 64 * 64; i += 64) { int r = i / 64, d = i % 64; Vs[r][d] = vf[((size_t)(t * 64 + r) * 8 + h) * 64 + d]; }
        __syncthreads();
        for (int j = 0; j < 64; ++j) {
            int sk = t * 64 + j; if (sk > sq) break;
            float s = 0.f;
#pragma unroll
            for (int d = 0; d < 96; ++d) s += q[d] * Ks[j][d];
            float mn = fmaxf(m, s), f = expf(m - mn), p = expf(s - mn);
            l = l * f + p;
#pragma unroll
            for (int d = 0; d < 64; ++d) o[d] = o[d] * f + p * Vs[j][d];
            m = mn;
        }
    }
    float il = 1.f / l;
#pragma unroll
    for (int d = 0; d < 64; ++d) oa[(size_t)sq * 512 + h * 64 + d] = o[d] * il;
}
__global__ void k_rwkv_prep1(const float* P, const float* mu, float* r, float* k, float* v, float* tw, float* al, float* sg, int So) {
    int s = blockIdx.x;
    for (int i = threadIdx.x; i < SLAB; i += blockDim.x) {
        float cur = P[(size_t)s * DIN + OFF_SLAB + i]; float prev = s > 0 ? P[(size_t)(s - 1) * DIN + OFF_SLAB + i] : 0.f;
        float p = cur + (prev - cur) * mu[i];
        if (i < 512) r[(size_t)s * 512 + i] = p; else if (i < 1024) k[(size_t)s * 512 + i - 512] = p; else if (i < 1536) v[(size_t)s * 512 + i - 1024] = p;
        else if (i < 1600) tw[(size_t)s * 64 + i - 1536] = tanhf(p); else if (i < 1664) al[(size_t)s * 64 + i - 1600] = p; else sg[(size_t)s * 128 + i - 1664] = sigmoidf_(p);
    }
}
__global__ void k_rwkv_prep2(const float* r, const float* k, const float* v, const float* dw, const float* da, const float* w0, const float* a0,
                             const float* k_k, const float* k_a, const float* r_k, float* scan_in, float* bonus, int So) {
    int idx = blockIdx.x * (blockDim.x / 64) + (threadIdx.x >> 6), lane = threadIdx.x & 63; if (idx >= So * 8) return;
    int s = idx >> 3, h = idx & 7, c = h * 64 + lane;
    float rv = r[(size_t)s * 512 + c], kv_ = k[(size_t)s * 512 + c], vv = v[(size_t)s * 512 + c];
    float lw = -softplusf_(-(w0[c] + dw[(size_t)s * 512 + c])) - 0.5f; float dec = expf(-expf(lw));
    float a = sigmoidf_(a0[c] + da[(size_t)s * 512 + c]);
    float kk = kv_ * k_k[c]; float ss = kk * kk; for (int o = 32; o > 0; o >>= 1) ss += __shfl_xor(ss, o);
    kk = kk / fmaxf(sqrtf(ss), 1e-12f);
    float kp = kv_ * (1.f + (a - 1.f) * k_a[c]);
    float bs = rv * kp * r_k[c]; for (int o = 32; o > 0; o >>= 1) bs += __shfl_xor(bs, o);
    float* si = scan_in + ((size_t)h * So + s) * 6 * 64;
    si[0 * 64 + lane] = rv; si[1 * 64 + lane] = dec; si[2 * 64 + lane] = kp; si[3 * 64 + lane] = vv; si[4 * 64 + lane] = kk; si[5 * 64 + lane] = kk * a;
    bonus[(size_t)s * 512 + c] = bs * vv;
}
__global__ __launch_bounds__(256) void k_scan(const float* scan_in, float* y, int So, float* sdump) {
    __shared__ float buf[32][6][64];
    const int h = blockIdx.x, tid = threadIdx.x, vrow = tid >> 2, kq = tid & 3;
    float S[16];
#pragma unroll
    for (int i = 0; i < 16; ++i) S[i] = 0.f;
    for (int s0 = 0; s0 < So; s0 += 32) {
        if (sdump && (s0 & 63) == 0) {
#pragma unroll
            for (int i = 0; i < 16; ++i) sdump[(((size_t)h * (So / 64) + (s0 >> 6)) * 64 + vrow) * 64 + kq * 16 + i] = S[i]; }
        __syncthreads();
        const float* src = scan_in + ((size_t)h * So + s0) * 384;
        for (int i = tid; i < 32 * 384; i += 256) (&buf[0][0][0])[i] = src[i];
        __syncthreads();
        for (int t = 0; t < 32; ++t) {
            const float* rr = &buf[t][0][kq * 16]; const float* ww = &buf[t][1][kq * 16]; const float* kp = &buf[t][2][kq * 16];
            const float* kk = &buf[t][4][kq * 16]; const float* bb = &buf[t][5][kq * 16]; const float vv = buf[t][3][vrow];
            float sa = 0.f;
#pragma unroll
            for (int i = 0; i < 16; ++i) sa += S[i] * kk[i];
            sa += __shfl_xor(sa, 1); sa += __shfl_xor(sa, 2); sa = -sa;
            float yy = 0.f;
#pragma unroll
            for (int i = 0; i < 16; ++i) { S[i] = S[i] * ww[i] + sa * bb[i] + vv * kp[i]; yy += S[i] * rr[i]; }
            yy += __shfl_xor(yy, 1); yy += __shfl_xor(yy, 2);
            if (kq == 0) y[(size_t)(s0 + t) * 512 + h * 64 + vrow] = yy;
        }
    }
}
__global__ void k_rwkv_post(const float* y, const float* bonus, const float* g, const float* ln_w, const float* ln_b, float* yb, int So) {
    int idx = blockIdx.x * (blockDim.x / 64) + (threadIdx.x >> 6), lane = threadIdx.x & 63; if (idx >= So * 8) return;
    int s = idx >> 3, h = idx & 7, c = h * 64 + lane;
    float yv = y[(size_t)s * 512 + c]; float sm = yv; for (int o = 32; o > 0; o >>= 1) sm += __shfl_xor(sm, o);
    float mu = sm / 64.f; float d = yv - mu; float vs = d * d; for (int o = 32; o > 0; o >>= 1) vs += __shfl_xor(vs, o);
    float yn = d * rsqrtf(vs / 64.f + 64e-5f) * ln_w[c] + ln_b[c];
    yb[(size_t)s * 512 + c] = (yn + bonus[(size_t)s * 512 + c]) * g[(size_t)s * 512 + c];
}
__global__ void k_merge(const float* P, const float* oa, const float* ob, float* merged, int So) {
    size_t i = (size_t)blockIdx.x * blockDim.x + threadIdx.x; if (i >= (size_t)So * D) return; size_t s = i / D; int n = i % D;
    merged[i] = sigmoidf_(P[s * DIN + OFF_GA + n]) * oa[i] + sigmoidf_(P[s * DIN + OFF_GB + n]) * ob[i];
}
__global__ void k_resid(const float* x, const float* gate, const float* mix, float* out, int So) {
    size_t i = (size_t)blockIdx.x * blockDim.x + threadIdx.x; if (i >= (size_t)So * D) return; int n = i % D;
    out[i] = x[i] + gate[n] * mix[i];
}
__global__ void k_topk(const float* logits, int* top_e, float* top_w, int So) {
    int s = blockIdx.x * blockDim.x + threadIdx.x; if (s >= So) return;
    float l[32];
#pragma unroll
    for (int e = 0; e < 32; ++e) l[e] = logits[(size_t)s * 32 + e];
    unsigned taken = 0u; int ie0 = 0, ie1 = 0, ie2 = 0, ie3 = 0; float ve0 = 0, ve1 = 0, ve2 = 0, ve3 = 0;
#pragma unroll
    for (int k = 0; k < 4; ++k) { int bi = 0; float bv = -INFINITY;
#pragma unroll
        for (int e = 0; e < 32; ++e) { bool ok = !((taken >> e) & 1u) && (l[e] > bv); bv = ok ? l[e] : bv; bi = ok ? e : bi; }
        taken |= 1u << bi;
        if (k == 0) { ie0 = bi; ve0 = bv; } else if (k == 1) { ie1 = bi; ve1 = bv; } else if (k == 2) { ie2 = bi; ve2 = bv; } else { ie3 = bi; ve3 = bv; } }
    float p0 = 1.f, p1 = expf(ve1 - ve0), p2 = expf(ve2 - ve0), p3 = expf(ve3 - ve0); float inv = 1.f / (p0 + p1 + p2 + p3);
    top_e[s * 4 + 0] = ie0; top_e[s * 4 + 1] = ie1; top_e[s * 4 + 2] = ie2; top_e[s * 4 + 3] = ie3;
    top_w[s * 4 + 0] = p0 * inv; top_w[s * 4 + 1] = p1 * inv; top_w[s * 4 + 2] = p2 * inv; top_w[s * 4 + 3] = p3 * inv;
}
__global__ __launch_bounds__(1024) void k_dispatch(const int* top_e, int* cnt, int* off, int* slot_tok, int* tok_slot, int So) {
    __shared__ int c[32], o[32], run[32];
    if (threadIdx.x < 32) { c[threadIdx.x] = 0; run[threadIdx.x] = 0; } __syncthreads();
    for (int i = threadIdx.x; i < So * 4; i += 1024) atomicAdd(&c[top_e[i]], 1);
    __syncthreads();
    if (threadIdx.x == 0) { int a = 0; for (int e = 0; e < 32; ++e) { o[e] = a; a += c[e]; } }
    __syncthreads();
    if (threadIdx.x < 32) { cnt[threadIdx.x] = c[threadIdx.x]; off[threadIdx.x] = o[threadIdx.x]; }
    for (int i = threadIdx.x; i < So * 4; i += 1024) { int e = top_e[i]; int sl = o[e] + atomicAdd(&run[e], 1); slot_tok[sl] = i >> 2; tok_slot[i] = sl; }
}
__global__ void k_swiglu(const float* gu, float* act, int rows) {
    size_t i = (size_t)blockIdx.x * blockDim.x + threadIdx.x; if (i >= (size_t)rows * 1024) return; size_t r = i / 1024; int j = i % 1024;
    float gte = fminf(gu[r * 2048 + 2 * j], 7.f), up = fminf(fmaxf(gu[r * 2048 + 2 * j + 1], -7.f), 7.f);
    act[i] = (up + 1.f) * gte * sigmoidf_(1.702f * gte);
}
__global__ void k_combine(const float* x1, const float* gate2, const float* ye, const int* tok_slot, const float* top_w, float* out, int So) {
    size_t i = (size_t)blockIdx.x * blockDim.x + threadIdx.x; if (i >= (size_t)So * D) return; size_t s = i / D; int n = i % D;
    float acc = 0.f; for (int k = 0; k < 4; ++k) acc += top_w[s * 4 + k] * ye[(size_t)tok_slot[s * 4 + k] * D + n];
    out[i] = x1[i] + gate2[n] * acc;
}

struct Buf {
    float *sdump, *mod, *h, *P, *cqn, *ckvn, *q, *kv, *qf, *kf, *vf, *oa, *o_a, *r, *k, *v, *tw, *al, *sg, *dw, *da, *g, *scan_in, *bonus, *y, *yb, *o_b, *merged, *mix, *x1, *h2, *logits, *top_w, *gu, *act, *ye;
    int *top_e, *cnt, *off, *slot_tok, *tok_slot;
    size_t bytes;
};
inline Buf carve(char* base, int So) {
    Buf B; size_t o = 0; auto F = [&](size_t n) { float* p = (float*)(base + o); o += ((n * 4 + 255) / 256) * 256; return p; };
    size_t S = So;
    B.sdump = F(8 * (S / 64) * 4096); B.mod = F(6 * D); B.h = F(S * D); B.P = F(S * DIN); B.cqn = F(S * 256); B.ckvn = F(S * 128); B.q = F(S * 768); B.kv = F(S * 1024);
    B.qf = F(S * 768); B.kf = F(S * 768); B.vf = F(S * 512); B.oa = F(S * 512); B.o_a = F(S * D);
    B.r = F(S * 512); B.k = F(S * 512); B.v = F(S * 512); B.tw = F(S * 64); B.al = F(S * 64); B.sg = F(S * 128); B.dw = F(S * 512); B.da = F(S * 512); B.g = F(S * 512);
    B.scan_in = F(S * 8 * 384); B.bonus = F(S * 512); B.y = F(S * 512); B.yb = F(S * 512); B.o_b = F(S * D); B.merged = F(S * D); B.mix = F(S * D); B.x1 = F(S * D); B.h2 = F(S * D);
    B.logits = F(S * 32); B.top_w = F(S * 4); B.top_e = (int*)F(S * 4); B.cnt = (int*)F(64); B.off = (int*)F(64); B.slot_tok = (int*)F(S * 4); B.tok_slot = (int*)F(S * 4);
    B.gu = F(S * 4 * 2048); B.act = F(S * 4 * 1024); B.ye = F(S * 4 * 1024);
    B.bytes = o; return B;
}
inline void gemm(hipStream_t st, const float* A, int lda, const float* W, int ldw, float* C, int ldc, const float* bias, int M, int N, int K) {
    GA g; memset(&g, 0, sizeof(g)); g.A = A; g.lda = lda; g.W = W; g.ldw = ldw; g.C = C; g.ldc = ldc; g.bias = bias; g.M = M; g.N = N; g.K = K;
    hipLaunchKernelGGL(k_gemm, dim3((N + 63) / 64, (M + 63) / 64, 1), dim3(256), 0, st, g);
}
inline void run(hipStream_t st, void* const* d_in, int b, int So, const Buf& B, float* out_rows) {
    const float* x = (const float*)d_in[0] + (size_t)b * SEQ * D; const float* c = (const float*)d_in[1]; const int* positions = (const int*)d_in[2];
    const float *ada_w = (const float*)d_in[3], *ada_b = (const float*)d_in[4], *norm_mix_w = (const float*)d_in[5], *norm_ffn_w = (const float*)d_in[6], *w_in = (const float*)d_in[7];
    const float *q_a_norm_w = (const float*)d_in[8], *w_q_up = (const float*)d_in[9], *kv_a_norm_w = (const float*)d_in[10], *w_kv_up = (const float*)d_in[11];
    const float *q_norm_w = (const float*)d_in[12], *k_norm_w = (const float*)d_in[13], *w_o_mla = (const float*)d_in[14];
    const float *mu = (const float*)d_in[15], *w0 = (const float*)d_in[16], *w2 = (const float*)d_in[17], *a0 = (const float*)d_in[18], *a2 = (const float*)d_in[19], *g2 = (const float*)d_in[20];
    const float *k_k = (const float*)d_in[21], *k_a = (const float*)d_in[22], *r_k = (const float*)d_in[23], *ln_w = (const float*)d_in[24], *ln_b = (const float*)d_in[25], *rw_o = (const float*)d_in[26];
    const float *w_out = (const float*)d_in[27], *w_router = (const float*)d_in[28], *b_router = (const float*)d_in[29], *w_gu = (const float*)d_in[30], *b_gu = (const float*)d_in[31], *w_dn = (const float*)d_in[32], *b_dn = (const float*)d_in[33];
    const int nW = (So * 8 + 3) / 4;
    hipLaunchKernelGGL(k_mod, dim3(24), dim3(256), 0, st, c, ada_w, ada_b, B.mod, b);
    hipLaunchKernelGGL(k_adaln, dim3(So), dim3(256), 0, st, x, norm_mix_w, B.mod + 0 * D, B.mod + 1 * D, B.h);
    gemm(st, B.h, D, w_in, DIN, B.P, DIN, nullptr, So, DIN, D);
    hipLaunchKernelGGL(k_rmsrows, dim3((So + 3) / 4), dim3(256), 0, st, B.P, DIN, OFF_CQ, 256, q_a_norm_w, B.cqn, So);
    hipLaunchKernelGGL(k_rmsrows, dim3((So + 3) / 4), dim3(256), 0, st, B.P, DIN, OFF_CKV, 128, kv_a_norm_w, B.ckvn, So);
    gemm(st, B.cqn, 256, w_q_up, 768, B.q, 768, nullptr, So, 768, 256);
    gemm(st, B.ckvn, 128, w_kv_up, 1024, B.kv, 1024, nullptr, So, 1024, 128);
    hipLaunchKernelGGL(k_qkfin, dim3(nW), dim3(256), 0, st, B.q, B.kv, B.P, positions, b, q_norm_w, k_norm_w, B.qf, B.kf, B.vf, So);
    hipLaunchKernelGGL(k_attn, dim3(So / 64, 8), dim3(64), 0, st, B.qf, B.kf, B.vf, B.oa);
    gemm(st, B.oa, 512, w_o_mla, D, B.o_a, D, nullptr, So, D, 512);
    hipLaunchKernelGGL(k_rwkv_prep1, dim3(So), dim3(256), 0, st, B.P, mu, B.r, B.k, B.v, B.tw, B.al, B.sg, So);
    gemm(st, B.tw, 64, w2, 512, B.dw, 512, nullptr, So, 512, 64);
    gemm(st, B.al, 64, a2, 512, B.da, 512, nullptr, So, 512, 64);
    gemm(st, B.sg, 128, g2, 512, B.g, 512, nullptr, So, 512, 128);
    hipLaunchKernelGGL(k_rwkv_prep2, dim3(nW), dim3(256), 0, st, B.r, B.k, B.v, B.dw, B.da, w0, a0, k_k, k_a, r_k, B.scan_in, B.bonus, So);
    hipLaunchKernelGGL(k_scan, dim3(8), dim3(256), 0, st, B.scan_in, B.y, So, B.sdump);
    hipLaunchKernelGGL(k_rwkv_post, dim3(nW), dim3(256), 0, st, B.y, B.bonus, B.g, ln_w, ln_b, B.yb, So);
    gemm(st, B.yb, 512, rw_o, D, B.o_b, D, nullptr, So, D, 512);
    hipLaunchKernelGGL(k_merge, dim3((So * D + 255) / 256), dim3(256), 0, st, B.P, B.o_a, B.o_b, B.merged, So);
    gemm(st, B.merged, D, w_out, D, B.mix, D, nullptr, So, D, D);
    hipLaunchKernelGGL(k_resid, dim3((So * D + 255) / 256), dim3(256), 0, st, x, B.mod + 2 * D, B.mix, B.x1, So);
    hipLaunchKernelGGL(k_adaln, dim3(So), dim3(256), 0, st, B.x1, norm_ffn_w, B.mod + 3 * D, B.mod + 4 * D, B.h2);
    gemm(st, B.h2, D, w_router, 32, B.logits, 32, b_router, So, 32, D);
    hipLaunchKernelGGL(k_topk, dim3((So + 255) / 256), dim3(256), 0, st, B.logits, B.top_e, B.top_w, So);
    hipLaunchKernelGGL(k_dispatch, dim3(1), dim3(1024), 0, st, B.top_e, B.cnt, B.off, B.slot_tok, B.tok_slot, So);
    { GA g; memset(&g, 0, sizeof(g)); g.A = B.h2; g.lda = D; g.aidx = B.slot_tok; g.W = w_gu; g.ldw = 2048; g.wstride = (size_t)D * 2048; g.C = B.gu; g.ldc = 2048; g.bias = b_gu; g.bstride = 2048;
      g.M = So; g.N = 2048; g.K = D; g.goff = B.off; g.gcnt = B.cnt;
      hipLaunchKernelGGL(k_gemm, dim3(2048 / 64, (So + 63) / 64, 32), dim3(256), 0, st, g); }
    hipLaunchKernelGGL(k_swiglu, dim3((So * 4 * 1024 + 255) / 256), dim3(256), 0, st, B.gu, B.act, So * 4);
    { GA g; memset(&g, 0, sizeof(g)); g.A = B.act; g.lda = D; g.W = w_dn; g.ldw = D; g.wstride = (size_t)D * D; g.C = B.ye; g.ldc = D; g.bias = b_dn; g.bstride = D;
      g.M = So; g.N = D; g.K = D; g.goff = B.off; g.gcnt = B.cnt;
      hipLaunchKernelGGL(k_gemm, dim3(D / 64, (So + 63) / 64, 32), dim3(256), 0, st, g); }
    hipLaunchKernelGGL(k_combine, dim3((So * D + 255) / 256), dim3(256), 0, st, B.x1, B.mod + 5 * D, B.ye, B.tok_slot, B.top_w, out_rows, So);
}
}

namespace dbg {
constexpr int OB = 5, SO = 512;
struct CmpArgs { const void* fast; const float* ref; float* res; int mode, rows, C, ldf, coff, ref_ld, ref_off, stage; };
__global__ void k_cmp(CmpArgs a) {
    const size_t n = (size_t)a.rows * a.C; float num = 0.f, den = 0.f, nanc = 0.f;
    for (size_t i = (size_t)blockIdx.x * blockDim.x + threadIdx.x; i < n; i += (size_t)gridDim.x * blockDim.x) {
        int s = (int)(i / a.C), c = (int)(i % a.C); const size_t t = (size_t)OB * 4096 + s; float fv, rv;
        if (a.mode == 13) { fv = ((const float*)a.fast)[i]; const int tt = (int)((i % 4096) / 64), ss = (int)(i % 64); const int quad = (tt >= 32 ? 2 : 0) + (ss >= 32 ? 1 : 0); fv = (quad == a.ldf && !(fabsf(fv) <= 10.f)) ? NAN : 0.f; rv = 0.f; }
        else if (a.mode == 12) { fv = ((const float*)a.fast)[i]; fv = (fabsf(fv) > (a.ldf > 0 ? a.ldf * 0.1f : 1e4f)) ? NAN : 0.f; rv = 0.f; }
        else if (a.mode == 11) { const float xv = __uint_as_float((unsigned)((const unsigned short*)a.fast)[i] << 16); const int arr = (int)((i / 64) % 6); fv = (arr == 1 && !(xv < 1.f && xv >= 0.f)) ? NAN : 0.f; rv = 0.f; }
        else if (a.mode == 9) { fv = ((const float*)a.fast)[i]; rv = 0.f; }
        else if (a.mode == 10) { fv = __uint_as_float((unsigned)((const unsigned short*)a.fast)[i] << 16); rv = 0.f; }
        else if (a.mode == 8) {
            const int per = (a.rows / 8) * 4096; const int h = (int)(i / per); const int rem = (int)(i % per); const int chk = rem / 4096, q = rem % 4096;
            rv = a.ref[i]; const unsigned short* f = (const unsigned short*)a.fast; fv = __uint_as_float((unsigned)f[((size_t)((OB * 8 + h) * 64 + chk)) * 4096 + q] << 16);
            if (a.ldf > 0 && chk != a.ldf) { fv = 0.f; rv = 0.f; }
        } else if (a.mode == 5) {
            const int h = (int)(i / ((size_t)a.rows / 8 * 384)); const size_t rem = i % ((size_t)a.rows / 8 * 384); s = (int)(rem / 384); const int q = (int)(rem % 384); const int arr = q / 64;
            rv = a.ref[i]; const unsigned short* f = (const unsigned short*)a.fast; fv = __uint_as_float((unsigned)f[(((size_t)(OB * 8 + h) * 4096 + s) * 384) + q] << 16); if (arr == 1) fv = 1.f - fv;
        } else {
            rv = a.ref[(size_t)s * a.ref_ld + a.ref_off + c];
            if (a.mode == 7) fv = ((const float*)a.fast)[c];
            else if (a.mode == 0) fv = ((const float*)a.fast)[t * a.ldf + a.coff + c];
            else { const unsigned short* f = (const unsigned short*)a.fast; size_t idx;
                if (a.mode == 1 || a.mode == 6) idx = t * a.ldf + a.coff + c;
                else if (a.mode == 2) { const int h = c / 96, d = c % 96; idx = ((size_t)(OB * 8 + h) * 4096 + s) * 96 + d; }
                else if (a.mode == 3) { const int h = c / 96, d = c % 96; idx = ((size_t)(OB * 8 + h) * 64 + (s >> 6)) * 6144 + (d >> 3) * 512 + (s & 63) * 8 + (d & 7); }
                else { const int h = c / 64, d = c % 64, key = s & 63; idx = ((size_t)(OB * 8 + h) * 64 + (s >> 6)) * 4096 + ((d >> 5) * 4 + (key >> 4)) * 512 + (key & 15) * 32 + (d & 31); }
                fv = __uint_as_float((unsigned)f[idx] << 16);
                if (a.mode == 2) fv *= (1.f / fk::QSCALE);
                if (a.mode == 6) rv = 1.f / (1.f + expf(-rv)); }
        }
        const float d = fv - rv; if (!(d == d) || fabsf(d) > 1e30f) { nanc += 1.f; } else { num += d * d; den += rv * rv; }
    }
    for (int o = 32; o > 0; o >>= 1) { num += __shfl_xor(num, o); den += __shfl_xor(den, o); nanc += __shfl_xor(nanc, o); }
    if ((threadIdx.x & 63) == 0) { atomicAdd(a.res + 2 * a.stage, num); atomicAdd(a.res + 2 * a.stage + 1, den); atomicAdd(a.res + 100 + a.stage, nanc); }
}
__global__ void k_cmp_topk(const int* fe, const int* re, float* res, int stage) {
    int s = blockIdx.x * blockDim.x + threadIdx.x; if (s >= SO) return; const size_t t = (size_t)OB * 4096 + s; int bad = 0;
    for (int k = 0; k < 4; ++k) bad |= (fe[t * 4 + k] != re[s * 4 + k]);
    atomicAdd(res + 2 * stage, (float)bad); atomicAdd(res + 2 * stage + 1, 1.f);
}
__global__ void k_verdict(const float* res, int nstage, float* out, size_t n) {
    int fail = 0;
#ifdef REPORT_STAGE
    { const float num = res[2 * REPORT_STAGE], den = res[2 * REPORT_STAGE + 1]; const float rel = sqrtf(num / fmaxf(den, 1e-30f)); float c = fminf(rel * 100.f, 2000.f); if (res[100 + REPORT_STAGE] > 0.f) { const float nn = res[100 + REPORT_STAGE]; c = nn < 100.f ? 100.f + nn : (nn < 1000.f ? 200.f + nn * 0.1f : 2500.f + fminf(nn * 0.01f, 400.f)); }
      for (size_t i = (size_t)blockIdx.x * blockDim.x + threadIdx.x; i < n; i += (size_t)gridDim.x * blockDim.x) out[i] = c; return; }
#endif
    for (int s = nstage - 1; s >= 0; --s) { const float num = res[2 * s], den = res[2 * s + 1]; const float rel = sqrtf(num / fmaxf(den, 1e-30f)); const float tol = (s == 0) ? 1e-3f : (s == 20 ? 0.2f : 4e-2f);
        if (!(rel <= tol) || res[100 + s] > 0.f) fail = s + 1; }
    if (fail == 0) return;
    for (size_t i = (size_t)blockIdx.x * blockDim.x + threadIdx.x; i < n; i += (size_t)gridDim.x * blockDim.x) out[i] = (float)fail;
}
inline void cmp(hipStream_t st, float* res, int stage, const void* fast, int mode, int ldf, int coff, const float* ref, int ref_ld, int ref_off, int rows, int C) {
    CmpArgs a; memset(&a, 0, sizeof(a)); a.fast = fast; a.ref = ref; a.res = res; a.mode = mode; a.rows = rows; a.C = C; a.ldf = ldf; a.coff = coff; a.ref_ld = ref_ld; a.ref_off = ref_off; a.stage = stage;
    hipLaunchKernelGGL(k_cmp, dim3(512), dim3(256), 0, st, a);
}
}
#endif
extern "C" void kernel_launch(void* const* d_in, const int* in_sizes, int n_in, void* d_out, int out_size, void* d_ws, size_t ws_size, hipStream_t stream) {
    using namespace fk;
    if (!host_init(ws_size)) return;
    Args a; fill_args(a, d_in, d_out, d_ws);
    hipMemsetAsync((char*)d_ws + WS_CTL, 0, CTL_ZERO_BYTES, stream);
#if MODE == 0
    launch_range(stream, a, 0, NPHASE, 0);
#elif MODE == 1
    for (int p = 0; p < NPHASE; ++p) launch_range(stream, a, p, p + 1, 0);
#else
    unsigned char* ws = (unsigned char*)d_ws;
    char* obase = (char*)d_ws + WS_END; orc::Buf B = orc::carve(obase, dbg::SO); float* oout = (float*)(obase + B.bytes);
    if (WS_END + B.bytes + (size_t)dbg::SO * 4096 + 4096 > ws_size) { fprintf(stderr, "debug: ws too small\n"); return; }
    float* res = (float*)(ws + 512 * 1024);
    orc::run(stream, d_in, dbg::OB, dbg::SO, B, oout);
    const int SO = dbg::SO; int st = 0;
    auto P = [&](int p) { launch_range(stream, a, p, p + 1, 0); };
    P(0); P(1);
    dbg::cmp(stream, res, 0, ws + WS_MOD + (size_t)dbg::OB * 6144 * 4, 7, 6144, 0, B.mod, 6144, 0, 1, 6144);
    P(2);
    dbg::cmp(stream, res, 1, ws + WS_PS, 1, NPS, 0, B.P, 4256, 0, SO, 416);
    dbg::cmp(stream, res, 2, ws + WS_PS, 1, NPS, 512, B.P, 4256, 416, SO, 1792);
    dbg::cmp(stream, res, 3, d_out, 6, 2048, 0, B.P, 4256, 2208, SO, 2048);
    P(3); P(4);
    dbg::cmp(stream, res, 4, ws + WS_QRAW, 1, 768, 0, B.q, 768, 0, SO, 768);
    dbg::cmp(stream, res, 5, ws + WS_KVRAW, 1, 1024, 0, B.kv, 1024, 0, SO, 1024);
    dbg::cmp(stream, res, 6, ws + WS_GG, 1, 512, 0, B.g, 512, 0, SO, 512);
    P(5);
    dbg::cmp(stream, res, 7, ws + WS_Q, 2, 0, 0, B.qf, 768, 0, SO, 768);
    dbg::cmp(stream, res, 8, ws + WS_K, 3, 0, 0, B.kf, 768, 0, SO, 768);
    dbg::cmp(stream, res, 9, ws + WS_V, 4, 0, 0, B.vf, 512, 0, SO, 512);
    P(6); P(7); P(8);
    dbg::cmp(stream, res, 11, ws + WS_OA, 1, 512, 0, B.oa, 512, 0, SO, 512);
    dbg::cmp(stream, res, 20, ws + WS_WM + (size_t)(dbg::OB * 8 * 64) * 16384, 9, 0, 0, B.sdump, 0, 0, 64, 4096);
    dbg::cmp(stream, res, 21, ws + WS_WN + (size_t)(dbg::OB * 8 * 64) * 16384, 9, 0, 0, B.sdump, 0, 0, 64, 4096);
    dbg::cmp(stream, res, 22, ws + WS_WQ1 + (size_t)(dbg::OB * 8 * 64) * 8192, 10, 0, 0, B.sdump, 0, 0, 64, 4096);
    dbg::cmp(stream, res, 23, ws + WS_WQ2 + (size_t)(dbg::OB * 8 * 64) * 8192, 10, 0, 0, B.sdump, 0, 0, 64, 4096);
    dbg::cmp(stream, res, 32, ws + WS_WM + (size_t)(dbg::OB * 8 * 64) * 16384, 13, 0, 0, B.sdump, 0, 0, 64, 4096);
    dbg::cmp(stream, res, 33, ws + WS_WM + (size_t)(dbg::OB * 8 * 64) * 16384, 13, 1, 0, B.sdump, 0, 0, 64, 4096);
    dbg::cmp(stream, res, 34, ws + WS_WM + (size_t)(dbg::OB * 8 * 64) * 16384, 13, 2, 0, B.sdump, 0, 0, 64, 4096);
    dbg::cmp(stream, res, 35, ws + WS_WM + (size_t)(dbg::OB * 8 * 64) * 16384, 13, 3, 0, B.sdump, 0, 0, 64, 4096);
    dbg::cmp(stream, res, 30, ws + WS_WM + (size_t)(dbg::OB * 8 * 64) * 16384, 12, 100, 0, B.sdump, 0, 0, 1, 4096);
    dbg::cmp(stream, res, 31, ws + WS_WM + (size_t)(dbg::OB * 8 * 64 + 1) * 16384, 12, 100, 0, B.sdump, 0, 0, 63, 4096);
    dbg::cmp(stream, res, 28, ws + WS_WM + (size_t)(dbg::OB * 8 * 64) * 16384, 12, 11, 0, B.sdump, 0, 0, 64, 4096);
    dbg::cmp(stream, res, 29, ws + WS_WM + (size_t)(dbg::OB * 8 * 64) * 16384, 12, 100, 0, B.sdump, 0, 0, 64, 4096);
    dbg::cmp(stream, res, 26, ws + WS_WM + (size_t)(dbg::OB * 8 * 64) * 16384, 12, 0, 0, B.sdump, 0, 0, 64, 4096);
    dbg::cmp(stream, res, 27, ws + WS_WBS + (size_t)dbg::OB * 4096 * 32, 9, 0, 0, B.sdump, 0, 0, 4096, 8);
    dbg::cmp(stream, res, 24, ws + WS_WM + (size_t)(dbg::OB * 8 * 64) * 16384, 9, 0, 0, B.sdump, 0, 0, 1, 4096);
    dbg::cmp(stream, res, 12, ws + WS_WSB, 8, 0, 0, B.sdump, 0, 0, 8 * (SO / 64), 4096);
    dbg::cmp(stream, res, 18, ws + WS_WSB, 8, 1, 0, B.sdump, 0, 0, 8 * (SO / 64), 4096);
    dbg::cmp(stream, res, 19, ws + WS_WSB, 8, 2, 0, B.sdump, 0, 0, 8 * (SO / 64), 4096);
    dbg::cmp(stream, res, 13, ws + WS_OBIN, 1, 512, 0, B.yb, 512, 0, SO, 512);
    P(9);
    dbg::cmp(stream, res, 14, ws + WS_MERGED, 1, 1024, 0, B.merged, 1024, 0, SO, 1024);
    P(10);
    dbg::cmp(stream, res, 15, d_out, 0, 1024, 0, B.x1, 1024, 0, SO, 1024);
    P(11);
    P(12); P(13); P(14); P(15);
    dbg::cmp(stream, res, 17, d_out, 0, 1024, 0, oout, 1024, 0, SO, 1024);
    hipLaunchKernelGGL(dbg::k_verdict, dim3(1024), dim3(256), 0, stream, res, 18, (float*)d_out, (size_t)T * 1024);
    (void)st;
#endif
}
```

```cpp
#include <hip/hip_runtime.h>
#include <cstdio>
#include <cstdint>
#include <cmath>
#include <cstring>
#include <type_traits>
#ifndef MODE
#define MODE 0
#endif
#define GAS __attribute__((address_space(1)))
#define LAS __attribute__((address_space(3)))
typedef unsigned short bf16_t;
typedef short bf16x8 __attribute__((ext_vector_type(8)));
typedef short s16x4 __attribute__((ext_vector_type(4)));
typedef float f32x4 __attribute__((ext_vector_type(4)));
typedef float f32x2 __attribute__((ext_vector_type(2)));
typedef float f32x16 __attribute__((ext_vector_type(16)));
typedef unsigned u32x4 __attribute__((ext_vector_type(4)));
typedef unsigned u32x2 __attribute__((ext_vector_type(2)));
typedef int v4i_t __attribute__((ext_vector_type(4)));
typedef int v8i_t __attribute__((ext_vector_type(8)));

typedef __bf16 bf16x2_t __attribute__((ext_vector_type(2)));
__device__ __forceinline__ unsigned cvt_pk_bf16(float lo, float hi) { f32x2 v = {lo, hi}; bf16x2_t b = __builtin_convertvector(v, bf16x2_t); return __builtin_bit_cast(unsigned, b); }
__device__ __forceinline__ float bf_lo(unsigned w) { return __uint_as_float(w << 16); }
__device__ __forceinline__ float bf_hi(unsigned w) { return __uint_as_float(w & 0xffff0000u); }
__device__ __forceinline__ float fsigmoid(float x) { return __builtin_amdgcn_rcpf(1.f + __builtin_amdgcn_exp2f(-1.4426950408889634f * x)); }
__device__ __forceinline__ float wave_sum(float v) {
#pragma unroll
    for (int o = 1; o < 64; o <<= 1) v += __shfl_xor(v, o);
    return v;
}
__device__ __forceinline__ float sum8(float v) { v += __shfl_xor(v, 1); v += __shfl_xor(v, 2); v += __shfl_xor(v, 4); return v; }

namespace pg8 {
constexpr int BM = 256, BK = 64, HALF = 128, HTB = HALF * BK * 2, STAGE_BYTES = 8 * HTB, NXCD = 8, WGM = 8;
__host__ __device__ __forceinline__ int lds_byte(int r, int c) { const int st = (r >> 4) * 2 + (c >> 5), rr = r & 15, cc = c & 31, ob = rr * 64 + cc * 2; return st * 1024 + (ob ^ (((ob >> 9) & 1) << 5)); }
__host__ __device__ __forceinline__ void stage_rc(int b, int& R, int& C) { const int st = b / 1024, sb = b % 1024, swz = sb ^ (((sb >> 9) & 1) << 5); R = (st >> 1) * 16 + swz / 64; C = (st & 1) * 32 + (swz % 64) / 2; }
__host__ __device__ __forceinline__ int perm32(int rho) { const int n = rho >> 4, i = rho & 15; return 8 * (i >> 2) + 4 * n + (i & 3); }

struct Unit { int pm, pn, e; };
struct Gemm { const bf16_t* A; const bf16_t* Bt; int M, N, K; size_t bgs; size_t ags = 0; };

struct StaticOrder {
    static constexpr bool GATHER = false;
    int nM, nN, nwg, G, c;
    __device__ void init(int M, int N, int G_, int c_) { nM = M / BM; nN = N / BM; nwg = nM * nN; G = G_; c = c_; }
    __device__ bool next(int i, Unit& u) const {
        const long L = (long)i * G + c; if (L >= nwg) return false;
        int wgid = (int)L; { const int q = nwg / NXCD, r = nwg % NXCD, xcd = wgid % NXCD, off = wgid / NXCD; wgid = (xcd < r ? xcd * (q + 1) : r * (q + 1) + (xcd - r) * q) + off; }
        const int nig = WGM * nN, gid = wgid / nig, fm = gid * WGM, gsz = (nM - fm) < WGM ? (nM - fm) : WGM;
        u.pm = fm + ((wgid % nig) % gsz); u.pn = (wgid % nig) / gsz; u.e = 0; return true;
    }
    __device__ __forceinline__ int arow(int, int) const { return 0; }
};
struct PairOrder {
    static constexpr bool GATHER = false;
    StaticOrder S;
    __device__ void init(int M, int N, int G_, int c_) { S.init(M, N, G_, c_); }
    __device__ bool next(int i, Unit& u) const { const bool ok = S.next(i >> 1, u); u.e = i & 1; return ok; }
    __device__ __forceinline__ int arow(int, int) const { return 0; }
};
template <class E, class = void> struct EpiChain { static constexpr bool v = false; };
template <class E> struct EpiChain<E, std::void_t<decltype(E::CHAIN)>> { static constexpr bool v = E::CHAIN; };
template <int NPN, bool GATH> struct MoeOrder {
    static constexpr bool GATHER = GATH;
    const LAS int* tpre; const LAS int* rowtab; int G, c;
    __device__ bool next(int i, Unit& u) const {
        const int L = i * G + c; const int total = tpre[32] * NPN; if (L >= total) return false;
        const int mt = L / NPN; u.pm = mt; u.pn = L % NPN; int e = -1;
#pragma unroll
        for (int q = 0; q < 8; ++q) { const v4i_t v = *(const LAS v4i_t*)(tpre + 4 * q); e += (v[0] <= mt ? 1 : 0) + (v[1] <= mt ? 1 : 0) + (v[2] <= mt ? 1 : 0) + (v[3] <= mt ? 1 : 0); }
        u.e = e; return true;
    }
    __device__ __forceinline__ int arow(int ui, int r) const { return rowtab[ui * 256 + r]; }
};

template <class Epi, class Sched, bool ALIGN_EPI = true, bool FP8 = false>
__device__ __forceinline__ void gemm_phase(LAS unsigned char* lds, const Gemm g, const Sched& S, const Epi& E) {
    const int tid = threadIdx.x, wid = __builtin_amdgcn_readfirstlane(tid >> 6), lane = tid & 63, wr = wid >> 2, wc = wid & 3, fr = lane & 15, fq = lane >> 4;
    const int K = g.K, nt = K / BK;
    unsigned voffA[2], voffB[2];
#pragma unroll
    for (int i = 0; i < 2; ++i) { int R, C; stage_rc(tid * 16 + i * 8192, R, C); const int Rb = Epi::PERM ? ((R & ~31) + perm32(R & 31)) : R;
        voffA[i] = (unsigned)(R * K + C) * 2u; voffB[i] = (unsigned)(Rb * K + C) * 2u; }
    const size_t kstep = (size_t)(BK * 2);
    const size_t hstep = (size_t)HALF * K * 2;
    const size_t tstep = 2 * hstep;
    const unsigned ldsw = (unsigned)wid * 1024u;
    const int aoff = lds_byte(wr * 64 + fr, fq * 8), boff = lds_byte(wc * 32 + fr, fq * 8);
#define PG8_SA(b, h) (((b) * 2 + (h)) * HTB)
#define PG8_SB(b, h) ((4 + (b) * 2 + (h)) * HTB)
#define PG8_STAGE(bufoff, gbase, voff) do { _Pragma("unroll") for (int _i = 0; _i < 2; ++_i) \
        __builtin_amdgcn_global_load_lds((const unsigned*)((const char*)(gbase) + (voff)[_i]), (LAS unsigned*)(lds + (bufoff) + ldsw + _i * 8192), 16, 0, 0); } while (0)
#define PG8_CAT(x, y) __builtin_shufflevector((x), (y), 0, 1, 2, 3, 4, 5, 6, 7)
#define PG8_LDA(dst, b, h) do { _Pragma("unroll") for (int m = 0; m < 4; ++m) { if constexpr (FP8) { dst##8[m] = PG8_CAT(*(const LAS v4i_t*)(lds + PG8_SA(b, h) + aoff + m * 2048), *(const LAS v4i_t*)(lds + PG8_SA(b, h) + aoff + m * 2048 + 1024)); } \
        else { _Pragma("unroll") for (int k = 0; k < 2; ++k) dst[m][k] = *(const LAS bf16x8*)(lds + PG8_SA(b, h) + aoff + m * 2048 + k * 1024); } } } while (0)
#define PG8_LDB(dst, b, h) do { _Pragma("unroll") for (int n = 0; n < 2; ++n) { if constexpr (FP8) { dst##8[n] = PG8_CAT(*(const LAS v4i_t*)(lds + PG8_SB(b, h) + boff + n * 2048), *(const LAS v4i_t*)(lds + PG8_SB(b, h) + boff + n * 2048 + 1024)); } \
        else { _Pragma("unroll") for (int k = 0; k < 2; ++k) dst[n][k] = *(const LAS bf16x8*)(lds + PG8_SB(b, h) + boff + n * 2048 + k * 1024); } } } while (0)
#define PG8_MMA(ai, bj, At, Bt) do { __builtin_amdgcn_s_setprio(1); _Pragma("unroll") for (int m = 0; m < 4; ++m) _Pragma("unroll") for (int n = 0; n < 2; ++n) { \
        if constexpr (FP8) { asm volatile("v_mfma_scale_f32_16x16x128_f8f6f4 %0, %1, %2, %0, %3, %3 op_sel_hi:[0,0,0]" : "+v"(acc[ai][bj][m][n]) : "v"(Bt##8[n]), "v"(At##8[m]), "v"(sc1)); } \
        else { _Pragma("unroll") for (int k = 0; k < 2; ++k) acc[ai][bj][m][n] = __builtin_amdgcn_mfma_f32_16x16x32_bf16(Bt[n][k], At[m][k], acc[ai][bj][m][n], 0, 0, 0); } } \
        __builtin_amdgcn_s_setprio(0); } while (0)
#define PG8_WAIT_V(n) asm volatile("s_waitcnt vmcnt(" #n ")" ::: "memory")
#define PG8_WAIT_L(n) asm volatile("s_waitcnt lgkmcnt(" #n ")" ::: "memory")
#define PG8_BAR __builtin_amdgcn_s_barrier()
#define PG8_SCHED __builtin_amdgcn_sched_barrier(0)
    Unit cur, nxt; int ui = 0;
    if (!S.next(0, cur)) return;
    f32x4 acc[2][2][4][2];
#pragma unroll
    for (int a = 0; a < 2; ++a)
#pragma unroll
        for (int b = 0; b < 2; ++b)
#pragma unroll
            for (int m = 0; m < 4; ++m)
#pragma unroll
                for (int n = 0; n < 2; ++n) acc[a][b][m][n] = (f32x4){0.f, 0.f, 0.f, 0.f};
    int sc1 = 0x7f7f7f7f; asm volatile("" : "+v"(sc1));
    bf16x8 At[4][2], B0[2][2], B1[2][2]; v8i_t At8[4], B08[2], B18[2];
    const char* cA; const char* cB = (const char*)g.Bt + (size_t)cur.e * g.bgs + (size_t)cur.pn * tstep;
    if constexpr (Sched::GATHER) cA = (const char*)g.A; else cA = (const char*)g.A + (size_t)cur.e * g.ags + (size_t)cur.pm * tstep;
    unsigned goffc[4] = {0u, 0u, 0u, 0u}, goffn[4] = {0u, 0u, 0u, 0u};
#define PG8_GOFF(dst, uidx) do { if constexpr (Sched::GATHER) { _Pragma("unroll") for (int _h = 0; _h < 2; ++_h) _Pragma("unroll") for (int _i = 0; _i < 2; ++_i) { int _R, _C; stage_rc(tid * 16 + _i * 8192, _R, _C); \
            dst[_h * 2 + _i] = (unsigned)S.arow((uidx), _h * HALF + _R) * (unsigned)(K * 2) + (unsigned)_C * 2u; } } } while (0)
#define PG8_STAGE_A(bufoff, kptr, h, uidx) do { if constexpr (Sched::GATHER) { _Pragma("unroll") for (int _i = 0; _i < 2; ++_i) { \
            const unsigned _o = ((uidx) == ui) ? goffc[(h) * 2 + _i] : goffn[(h) * 2 + _i]; \
            __builtin_amdgcn_global_load_lds((const unsigned*)((const char*)(kptr) + _o), (LAS unsigned*)(lds + (bufoff) + ldsw + _i * 8192), 16, 0, 0); } } \
        else { PG8_STAGE(bufoff, (kptr) + (h) * hstep, voffA); } } while (0)
    PG8_GOFF(goffc, 0);
    PG8_STAGE(PG8_SB(0, 0), cB, voffB); PG8_STAGE(PG8_SB(0, 1), cB + hstep, voffB); PG8_STAGE_A(PG8_SA(0, 0), cA, 0, 0); PG8_STAGE_A(PG8_SA(0, 1), cA, 1, 0);
    if (wr == 1) PG8_BAR;
    PG8_WAIT_V(2); PG8_BAR;
    PG8_STAGE(PG8_SB(1, 0), cB + kstep, voffB); PG8_STAGE_A(PG8_SA(1, 0), cA + kstep, 0, 0); PG8_STAGE(PG8_SB(1, 1), cB + hstep + kstep, voffB);
    PG8_WAIT_V(6); PG8_BAR;
#pragma unroll 1
    for (;;) {
        const bool has_next = S.next(ui + 1, nxt);
        if (has_next) PG8_GOFF(goffn, ui + 1);
        const char* nA; const char* nB;
        if constexpr (Sched::GATHER) nA = cA; else nA = has_next ? (const char*)g.A + (size_t)nxt.e * g.ags + (size_t)nxt.pm * tstep : cA;
        nB = has_next ? (const char*)g.Bt + (size_t)nxt.e * g.bgs + (size_t)nxt.pn * tstep : cB;
#pragma unroll 1
        for (int t = 0; t < nt; t += 2) {
            const bool last = (t == nt - 2);
            const char* a1 = cA + (size_t)(t + 1) * kstep;
            const char* a2 = last ? nA : cA + (size_t)(t + 2) * kstep; const char* b2 = last ? nB : cB + (size_t)(t + 2) * kstep;
            const char* a3 = a2 + kstep; const char* b3 = b2 + kstep;
            const int u2 = (last && has_next) ? ui + 1 : ui;
            PG8_LDB(B0, 0, 0); PG8_LDB(B1, 0, 1); PG8_SCHED; PG8_LDA(At, 0, 0); PG8_STAGE_A(PG8_SA(1, 1), a1, 1, ui);
            PG8_WAIT_V(8); PG8_WAIT_L(0); PG8_BAR; PG8_MMA(0, 0, At, B0); PG8_MMA(0, 1, At, B1); PG8_BAR; PG8_SCHED;
            PG8_LDA(At, 0, 1); PG8_STAGE(PG8_SB(0, 0), b2, voffB); PG8_STAGE(PG8_SB(0, 1), b2 + hstep, voffB); PG8_STAGE_A(PG8_SA(0, 0), a2, 0, u2);
            PG8_WAIT_V(8); PG8_WAIT_L(0); PG8_BAR; PG8_MMA(1, 0, At, B0); PG8_MMA(1, 1, At, B1); PG8_BAR; PG8_SCHED;
            PG8_LDB(B0, 1, 0); PG8_LDB(B1, 1, 1); PG8_SCHED; PG8_LDA(At, 1, 0); PG8_STAGE_A(PG8_SA(0, 1), a2, 1, u2);
            PG8_WAIT_V(8); PG8_WAIT_L(0); PG8_BAR; PG8_MMA(0, 0, At, B0); PG8_MMA(0, 1, At, B1); PG8_BAR; PG8_SCHED;
            PG8_LDA(At, 1, 1); PG8_STAGE(PG8_SB(1, 0), b3, voffB); PG8_STAGE(PG8_SB(1, 1), b3 + hstep, voffB); PG8_STAGE_A(PG8_SA(1, 0), a3, 0, u2);
            PG8_WAIT_V(8); PG8_WAIT_L(0); PG8_BAR; PG8_MMA(1, 0, At, B0); PG8_MMA(1, 1, At, B1); PG8_BAR; PG8_SCHED;
        }
        if constexpr (ALIGN_EPI) { if (wr == 0) PG8_BAR; }
        if constexpr (FP8) asm volatile("s_nop 15\n\ts_nop 7" ::: "memory");
        bool keep = false;
        if constexpr (EpiChain<Epi>::v) { if (cur.e == 0) { E.mid(acc, cur, wr, wc, fr, fq); keep = true; } else E(acc, cur, wr, wc, fr, fq); } else E(acc, cur, wr, wc, fr, fq);
#ifdef EPIREP
        if constexpr (FP8) { for (int _e = 0; _e < EPIREP; ++_e) { asm volatile("" ::: "memory"); E(acc, cur, wr, wc, fr, fq); } }
#endif
        if (!has_next) break;
        if (!keep) {
#pragma unroll
        for (int a = 0; a < 2; ++a)
#pragma unroll
            for (int b = 0; b < 2; ++b)
#pragma unroll
                for (int m = 0; m < 4; ++m)
#pragma unroll
                    for (int n = 0; n < 2; ++n) acc[a][b][m][n] = (f32x4){0.f, 0.f, 0.f, 0.f};
        }
        cur = nxt; cA = nA; cB = nB; ++ui;
#pragma unroll
        for (int _q = 0; _q < 4; ++_q) goffc[_q] = goffn[_q];
        if constexpr (ALIGN_EPI) { if (wr == 1) PG8_BAR; }
    }
    PG8_WAIT_V(0);
    if constexpr (!ALIGN_EPI) { if (wr == 0) PG8_BAR; }
    PG8_BAR;
#undef PG8_SA
#undef PG8_SB
#undef PG8_STAGE
#undef PG8_STAGE_A
#undef PG8_GOFF
#undef PG8_LDA
#undef PG8_LDB
#undef PG8_MMA
#undef PG8_CAT
#undef PG8_WAIT_V
#undef PG8_WAIT_L
#undef PG8_BAR
#undef PG8_SCHED
}
}

#define XB_TMO      128
#define XB_XCNT(j)  (256  + 64 * (j))
#define XB_XSUB(j)  (1280 + 64 * (j))
#define XB_XGEN(j)  (2304 + 64 * (j))
#define XB_TOP      3328
#define XB_TOPGEN   3392
#define XCD_BAR_WORDS 3456
#define XB_SPIN_CAP (1u << 25)
__device__ __forceinline__ unsigned xb_ld(unsigned* p)              { return __hip_atomic_load(p, __ATOMIC_RELAXED, __HIP_MEMORY_SCOPE_AGENT); }
__device__ __forceinline__ unsigned xb_add(unsigned* p, unsigned v) { return __hip_atomic_fetch_add(p, v, __ATOMIC_RELAXED, __HIP_MEMORY_SCOPE_AGENT); }
__device__ __forceinline__ unsigned xb_xcc_id() { return (unsigned)__builtin_amdgcn_s_getreg((3 << 11) | 20) & 0xFu; }
#define XB_SPIN(cond, bar) do { unsigned _sp = 0; while (cond) { __builtin_amdgcn_s_sleep(1); \
    if ((++_sp & 255u) == 0u) { if (xb_ld(&(bar)[XB_TMO])) break; if (_sp > XB_SPIN_CAP) { atomicAdd(&(bar)[XB_TMO], 1u); break; } } } } while (0)
struct XcdBarrier { unsigned* bar; unsigned x; volatile LAS unsigned* st; };
__device__ __forceinline__ XcdBarrier xcd_barrier_post(unsigned* bar, volatile LAS unsigned* st) {
    XcdBarrier b; b.bar = bar; b.x = xb_xcc_id(); b.st = st;
    if (threadIdx.x == 0) (void)xb_add(&bar[XB_XCNT(b.x)], 1u);
    return b;
}
__device__ __forceinline__ void xcd_barrier_complete(unsigned* bar, unsigned x, unsigned& nloc, unsigned& nx) {
    const unsigned G = gridDim.x * gridDim.y * gridDim.z;
    unsigned sum, cnt, mine, sp = 0u;
    for (;;) {
        sum = 0u; cnt = 0u; mine = 0u;
#pragma unroll
        for (unsigned j = 0; j < 16; ++j) { const unsigned c = xb_ld(&bar[XB_XCNT(j)]); sum += c; cnt += (c > 0u) ? 1u : 0u; mine = (j == x) ? c : mine; }
        if (sum == G) break;
        __builtin_amdgcn_s_sleep(1);
        if ((++sp & 255u) == 0u) { if (xb_ld(&bar[XB_TMO])) break; if (sp > XB_SPIN_CAP) { atomicAdd(&bar[XB_TMO], 1u); break; } }
    }
    nloc = mine > 0u ? mine : 1u; nx = cnt > 0u ? cnt : 1u;
}
__device__ __forceinline__ void xcd_barrier(const XcdBarrier& b) {
    asm volatile("s_waitcnt vmcnt(0)" ::: "memory");
    __syncthreads();
    if (threadIdx.x == 0) {
        unsigned* bar = b.bar;
        __builtin_amdgcn_s_waitcnt(0);
        unsigned nloc = b.st[0], nx = b.st[1];
        if (nloc == 0u) { xcd_barrier_complete(bar, b.x, nloc, nx); b.st[0] = nloc; b.st[1] = nx; }
        const unsigned old = xb_add(&bar[XB_XSUB(b.x)], 1u);
        const unsigned gen = old / nloc;
        if (old + 1u == (gen + 1u) * nloc) {
            __builtin_amdgcn_fence(__ATOMIC_RELEASE, "agent");
            asm volatile("s_waitcnt vmcnt(0)" ::: "memory");
            const unsigned og = xb_add(&bar[XB_TOP], 1u);
            const unsigned tg = og / nx;
            if (og + 1u == (tg + 1u) * nx) xb_add(&bar[XB_TOPGEN], 1u);
            else XB_SPIN(xb_ld(&bar[XB_TOPGEN]) == tg, bar);
            __builtin_amdgcn_fence(__ATOMIC_ACQUIRE, "agent");
            xb_add(&bar[XB_XGEN(b.x)], 1u);
            asm volatile("s_waitcnt vmcnt(0)" ::: "memory");
        } else {
            XB_SPIN(xb_ld(&bar[XB_XGEN(b.x)]) == gen, bar);
            __builtin_amdgcn_fence(__ATOMIC_ACQUIRE, "agent");
            asm volatile("s_waitcnt vmcnt(0)" ::: "memory");
        }
    }
    __syncthreads();
}

namespace fk {
constexpr int T = 32768, D = 1024, SEQ = 4096, NB = 8, NWAVES = 8, NTHR = 512;
constexpr int NPS = 2304;
constexpr int NIN = 4352;
constexpr int MAXSLOT = 131072 + 8192;
constexpr float QSCALE = 0.10206207261596577f * 1.4426950408889634f;
constexpr size_t MiB = 1u << 20;
constexpr size_t WS_CTL = 0, CTL_ZERO_BYTES = 1 * MiB;
constexpr size_t WS_MODP = 1 * MiB;
constexpr size_t WS_MOD = 4 * MiB;
constexpr size_t WS_ROPE = 5 * MiB;
constexpr size_t WS_TOPE = 9 * MiB;
constexpr size_t WS_TOPW = WS_TOPE + 512 * 1024;
constexpr size_t WS_TOKSLOT = WS_TOPW + 512 * 1024;
constexpr size_t WS_ROWTOK = WS_TOKSLOT + 512 * 1024;
constexpr size_t WS_ROWW = WS_ROWTOK + 768 * 1024;
constexpr size_t WS_HIST = WS_ROWW + 768 * 1024;
constexpr size_t WS_TPRE = WS_HIST + 64 * 1024;
constexpr size_t WS_WIN = 13 * MiB;
constexpr size_t WS_WQ = WS_WIN + (size_t)NIN * 1024 * 2;
constexpr size_t WS_WKV = WS_WQ + 768 * 256 * 2;
constexpr size_t WS_WLORA = WS_WKV + 1024 * 256 * 2;
constexpr size_t WS_WOA = WS_WLORA + 1536 * 256 * 2;
constexpr size_t WS_WOB = WS_WOA + 1024 * 512 * 2;
constexpr size_t WS_WOUT = WS_WOB + 1024 * 512 * 2;
static_assert(WS_WOUT + 1024 * 1024 * 2 <= 28 * MiB, "small weights");
constexpr size_t WS_PS = 28 * MiB;
constexpr size_t WS_H = 172 * MiB;
constexpr size_t WS_AQ = 236 * MiB, WS_AKV = 252 * MiB, WS_ALORA = 268 * MiB;
constexpr size_t WS_QRAW = 524 * MiB;
constexpr size_t WS_KVRAW = 300 * MiB;
constexpr size_t WS_DEC = 396 * MiB;
constexpr size_t WS_AA = 460 * MiB;
constexpr size_t WS_GG = 492 * MiB;
constexpr size_t WS_Q = 524 * MiB;
constexpr size_t WS_K = 572 * MiB;
constexpr size_t WS_V = 620 * MiB;
constexpr size_t WS_SCANIN = 652 * MiB;
constexpr size_t WS_OA = 172 * MiB;
constexpr size_t WS_OBIN = 204 * MiB;
constexpr size_t WS_Y = 236 * MiB;
constexpr size_t WS_M1 = 300 * MiB;
constexpr size_t WS_MERGED = 396 * MiB;
constexpr size_t WS_WGU = 780 * MiB;
constexpr size_t WS_WDN = 364 * MiB;
constexpr size_t WS_ACT = 620 * MiB;
constexpr size_t WS_YS = 28 * MiB;
constexpr size_t WS_X1B = 460 * MiB;
constexpr size_t WS_END = 924 * MiB;
constexpr int CW_BAR = 4096;
constexpr int RING_BYTES = 131072, XTRA_OFF = RING_BYTES + 1024, LDS_BYTES = 163840, MISC_OFF = LDS_BYTES - 256;
constexpr int NPHASE = 16;

struct Args {
    const float* in[34]; float* out; unsigned char* ws; int ph_lo, ph_hi, bar_region, pad;
};
struct Frame {
    LAS unsigned char* lds; int tid, lane, wave, vcu, G;
};

#define EPI_LOOP_BEGIN \
    _Pragma("unroll") for (int ai = 0; ai < 2; ++ai) _Pragma("unroll") for (int m = 0; m < 4; ++m) { const int row = u.pm * 256 + ai * 128 + wr * 64 + m * 16 + fr; \
    _Pragma("unroll") for (int bj = 0; bj < 2; ++bj) { const int colt = bj * 128 + wc * 32 + 8 * fq; const f32x4 v0 = acc[ai][bj][m][0], v1 = acc[ai][bj][m][1];
#define EPI_LOOP_END } }
__device__ __forceinline__ u32x4 pack8(f32x4 a, f32x4 b) { u32x4 w; w.x = cvt_pk_bf16(a[0], a[1]); w.y = cvt_pk_bf16(a[2], a[3]); w.z = cvt_pk_bf16(b[0], b[1]); w.w = cvt_pk_bf16(b[2], b[3]); return w; }
__device__ __forceinline__ void unpack8(u32x4 w, f32x4& a, f32x4& b) { a = (f32x4){bf_lo(w.x), bf_hi(w.x), bf_lo(w.y), bf_hi(w.y)}; b = (f32x4){bf_lo(w.z), bf_hi(w.z), bf_lo(w.w), bf_hi(w.w)}; }
__device__ __forceinline__ f32x4 sig4(f32x4 v) { return (f32x4){fsigmoid(v[0]), fsigmoid(v[1]), fsigmoid(v[2]), fsigmoid(v[3])}; }

struct EpiP {
    static constexpr bool PERM = true; bf16_t* PS; bf16_t* Gt;
    __device__ __forceinline__ void operator()(const f32x4 (&acc)[2][2][4][2], const pg8::Unit& u, int wr, int wc, int fr, int fq) const {
        const bool gate = u.pn >= 9;
        EPI_LOOP_BEGIN
            if (gate) { *(u32x4*)(Gt + (size_t)row * 2048 + (u.pn - 9) * 256 + colt) = pack8(sig4(v0), sig4(v1)); }
            else { *(u32x4*)(PS + (size_t)row * NPS + u.pn * 256 + colt) = pack8(v0, v1); }
        EPI_LOOP_END
    }
};
struct EpiPlain {
    static constexpr bool PERM = true; bf16_t* O; int ldc;
    __device__ __forceinline__ void operator()(const f32x4 (&acc)[2][2][4][2], const pg8::Unit& u, int wr, int wc, int fr, int fq) const {
        EPI_LOOP_BEGIN
            *(u32x4*)(O + (size_t)row * ldc + u.pn * 256 + colt) = pack8(v0, v1);
        EPI_LOOP_END
    }
};
struct EpiKV {
    static constexpr bool PERM = true; bf16_t* KVRAW; bf16_t* Vo;
    __device__ __forceinline__ void operator()(const f32x4 (&acc)[2][2][4][2], const pg8::Unit& u, int wr, int wc, int fr, int fq) const {
        EPI_LOOP_BEGIN
            if (wc < 2) { *(u32x4*)(KVRAW + (size_t)row * 1024 + u.pn * 256 + colt) = pack8(v0, v1); }
            else { const int h = 2 * u.pn + bj, bb_ = row >> 12, s = row & (SEQ - 1), key = s & 63, tile = s >> 6;
                *(u32x4*)(Vo + ((size_t)(bb_ * 8 + h) * 64 + tile) * 4096 + ((wc - 2) * 4 + (key >> 4)) * 512 + (key & 15) * 32 + 8 * fq) = pack8(v0, v1); }
        EPI_LOOP_END
    }
};
struct EpiLora {
    static constexpr bool PERM = true; bf16_t* DEC; bf16_t* AA; bf16_t* GG;
    __device__ __forceinline__ void operator()(const f32x4 (&acc)[2][2][4][2], const pg8::Unit& u, int wr, int wc, int fr, int fq) const {
        const int kind = u.pn >> 1; const int cb = (u.pn & 1) * 256; bf16_t* O = (bf16_t*)((unsigned char*)GG - (size_t)(kind == 0) * ((unsigned char*)GG - (unsigned char*)DEC) - (size_t)(kind == 1) * ((unsigned char*)GG - (unsigned char*)AA));
        EPI_LOOP_BEGIN
            const int c = cb + colt;
            *(u32x4*)(O + (size_t)row * 512 + c) = pack8(v0, v1);
        EPI_LOOP_END
    }
};
struct EpiOA {
    static constexpr bool PERM = true; const bf16_t* Gt; bf16_t* M1;
    __device__ __forceinline__ void operator()(const f32x4 (&acc)[2][2][4][2], const pg8::Unit& u, int wr, int wc, int fr, int fq) const {
        EPI_LOOP_BEGIN
            const int c = u.pn * 256 + colt; f32x4 g0, g1; unpack8(*(const u32x4*)(Gt + (size_t)row * 2048 + c), g0, g1);
            *(u32x4*)(M1 + (size_t)row * 1024 + c) = pack8(g0 * v0, g1 * v1);
        EPI_LOOP_END
    }
};
struct EpiOB {
    static constexpr bool PERM = true; const bf16_t* Gt; const bf16_t* M1; bf16_t* MG;
    __device__ __forceinline__ void operator()(const f32x4 (&acc)[2][2][4][2], const pg8::Unit& u, int wr, int wc, int fr, int fq) const {
        EPI_LOOP_BEGIN
            const int c = u.pn * 256 + colt; f32x4 g0, g1, p0, p1; unpack8(*(const u32x4*)(Gt + (size_t)row * 2048 + 1024 + c), g0, g1); unpack8(*(const u32x4*)(M1 + (size_t)row * 1024 + c), p0, p1);
            *(u32x4*)(MG + (size_t)row * 1024 + c) = pack8(p0 + g0 * v0, p1 + g1 * v1);
        EPI_LOOP_END
    }
};
struct EpiOAB {
    static constexpr bool PERM = true; static constexpr bool CHAIN = true; const bf16_t* Gt; bf16_t* MG;
    __device__ __forceinline__ void mid(f32x4 (&acc)[2][2][4][2], const pg8::Unit& u, int wr, int wc, int fr, int fq) const {
#pragma unroll
        for (int ai = 0; ai < 2; ++ai)
#pragma unroll
            for (int m = 0; m < 4; ++m) { const int row = u.pm * 256 + ai * 128 + wr * 64 + m * 16 + fr;
#pragma unroll
                for (int bj = 0; bj < 2; ++bj) { const int c = u.pn * 256 + bj * 128 + wc * 32 + 8 * fq; f32x4 a0, a1, b0, b1;
                    unpack8(*(const u32x4*)(Gt + (size_t)row * 2048 + c), a0, a1); unpack8(*(const u32x4*)(Gt + (size_t)row * 2048 + 1024 + c), b0, b1);
#pragma unroll
                    for (int i = 0; i < 4; ++i) { acc[ai][bj][m][0][i] *= a0[i] * __builtin_amdgcn_rcpf(fmaxf(b0[i], 1e-30f)); acc[ai][bj][m][1][i] *= a1[i] * __builtin_amdgcn_rcpf(fmaxf(b1[i], 1e-30f)); } } }
    }
    __device__ __forceinline__ void operator()(const f32x4 (&acc)[2][2][4][2], const pg8::Unit& u, int wr, int wc, int fr, int fq) const {
        EPI_LOOP_BEGIN
            const int c = u.pn * 256 + colt; f32x4 g0, g1; unpack8(*(const u32x4*)(Gt + (size_t)row * 2048 + 1024 + c), g0, g1);
            *(u32x4*)(MG + (size_t)row * 1024 + c) = pack8(g0 * v0, g1 * v1);
        EPI_LOOP_END
    }
};
struct EpiOut {
    static constexpr bool PERM = true; const float* x; const float* mod; bf16_t* out;
    __device__ __forceinline__ void operator()(const f32x4 (&acc)[2][2][4][2], const pg8::Unit& u, int wr, int wc, int fr, int fq) const {
        const float* g1p = mod + (size_t)((u.pm * 256) >> 12) * 6144 + 2 * 1024;
        EPI_LOOP_BEGIN
            const int c = u.pn * 256 + colt; const size_t o = (size_t)row * 1024 + c;
            const f32x4 ga = *(const f32x4*)(g1p + c), gb = *(const f32x4*)(g1p + c + 4), xa = *(const f32x4*)(x + o), xb = *(const f32x4*)(x + o + 4);
            *(u32x4*)(out + o) = pack8(xa + ga * v0, xb + gb * v1);
        EPI_LOOP_END
    }
};
constexpr float GUSC = 1.f / 64.f;
struct EpiGU {
    static constexpr bool PERM = true; const float* bias; bf16_t* ACT;
    __device__ __forceinline__ void operator()(const f32x4 (&acc)[2][2][4][2], const pg8::Unit& u, int wr, int wc, int fr, int fq) const {
        const float* bp = bias + (size_t)u.e * 2048 + u.pn * 256 + wc * 32 + 8 * fq;
        unsigned char* ob = (unsigned char*)ACT + (size_t)(u.pm * 256 + wr * 64 + fr) * 1024 + ((u.pn * 256 + wc * 32 + 8 * fq) >> 1);
#pragma unroll
        for (int bj = 0; bj < 2; ++bj) { const f32x4 b0 = *(const f32x4*)(bp + bj * 128) + (f32x4){0.f, 1.f, 0.f, 1.f}, b1 = *(const f32x4*)(bp + bj * 128 + 4) + (f32x4){0.f, 1.f, 0.f, 1.f};
#pragma unroll
            for (int ai = 0; ai < 2; ++ai)
#pragma unroll
                for (int m = 0; m < 4; ++m) { const f32x4 a = acc[ai][bj][m][0] * GUSC + b0, b = acc[ai][bj][m][1] * GUSC + b1;
                    const float g0 = fminf(a[0], 7.f), g1 = fminf(a[2], 7.f), g2 = fminf(b[0], 7.f), g3 = fminf(b[2], 7.f);
                    const float u0 = __builtin_amdgcn_fmed3f(a[1], -6.f, 8.f), u1 = __builtin_amdgcn_fmed3f(a[3], -6.f, 8.f), u2 = __builtin_amdgcn_fmed3f(b[1], -6.f, 8.f), u3 = __builtin_amdgcn_fmed3f(b[3], -6.f, 8.f);
                    const float r0 = u0 * g0 * fsigmoid(1.702f * g0), r1 = u1 * g1 * fsigmoid(1.702f * g1), r2 = u2 * g2 * fsigmoid(1.702f * g2), r3 = u3 * g3 * fsigmoid(1.702f * g3);
                    unsigned w8 = 0u; w8 = __builtin_amdgcn_cvt_pk_fp8_f32(r0, r1, w8, false); w8 = __builtin_amdgcn_cvt_pk_fp8_f32(r2, r3, w8, true);
                    *(unsigned*)(ob + (size_t)(ai * 128 + m * 16) * 1024 + bj * 64) = w8; } }
    }
};
constexpr float YSC = 32.f;
struct EpiDN {
    static constexpr bool PERM = true; const float* bias; const float* roww; bf16_t* YS;
    __device__ __forceinline__ void operator()(const f32x4 (&acc)[2][2][4][2], const pg8::Unit& u, int wr, int wc, int fr, int fq) const {
        const float* bp = bias + (size_t)u.e * 1024 + u.pn * 256 + wc * 32 + 8 * fq; const int row0 = u.pm * 256 + wr * 64 + fr;
        unsigned char* ob = (unsigned char*)YS + (size_t)row0 * 1024 + u.pn * 256 + wc * 32 + 8 * fq;
        float rw[2][4];
#pragma unroll
        for (int ai = 0; ai < 2; ++ai)
#pragma unroll
            for (int m = 0; m < 4; ++m) rw[ai][m] = roww[row0 + ai * 128 + m * 16] * YSC;
#pragma unroll
        for (int bj = 0; bj < 2; ++bj) { const f32x4 b0 = *(const f32x4*)(bp + bj * 128), b1 = *(const f32x4*)(bp + bj * 128 + 4);
#pragma unroll
            for (int ai = 0; ai < 2; ++ai)
#pragma unroll
                for (int m = 0; m < 4; ++m) { const float w = rw[ai][m]; const f32x4 p = (acc[ai][bj][m][0] * GUSC + b0) * w, q = (acc[ai][bj][m][1] * GUSC + b1) * w;
#define YCL(x) __builtin_amdgcn_fmed3f((x), -440.f, 440.f)
                    u32x2 o; o.x = 0u; o.y = 0u;
                    o.x = __builtin_amdgcn_cvt_pk_fp8_f32(YCL(p[0]), YCL(p[1]), o.x, false); o.x = __builtin_amdgcn_cvt_pk_fp8_f32(YCL(p[2]), YCL(p[3]), o.x, true);
                    o.y = __builtin_amdgcn_cvt_pk_fp8_f32(YCL(q[0]), YCL(q[1]), o.y, false); o.y = __builtin_amdgcn_cvt_pk_fp8_f32(YCL(q[2]), YCL(q[3]), o.y, true);
#undef YCL
                    *(u32x2*)(ob + (size_t)(ai * 128 + m * 16) * 1024 + bj * 128) = o; } }
    }
};
__device__ __forceinline__ f32x4 ld4f8(const unsigned char* p) { const unsigned w = *(const unsigned*)p;
    return (f32x4){__builtin_amdgcn_cvt_f32_fp8(w, 0), __builtin_amdgcn_cvt_f32_fp8(w, 1), __builtin_amdgcn_cvt_f32_fp8(w, 2), __builtin_amdgcn_cvt_f32_fp8(w, 3)}; }

__device__ __forceinline__ void transpose_item(const float* W, int N, bf16_t* WT, int ldk, int koff, int row_off, LAS float* scr, int kb, int nb, int lane) {
    const int k0 = 64 * kb, n0 = 32 * nb;
    { f32x4 v[8]; const int n4 = lane & 7, kr = lane >> 3;
#pragma unroll
      for (int i = 0; i < 8; ++i) v[i] = *(const f32x4*)(W + (size_t)(k0 + 8 * i + kr) * N + n0 + 4 * n4);
#pragma unroll
      for (int i = 0; i < 8; ++i) { LAS float* d = scr + (8 * i + kr) * 33 + 4 * n4; d[0] = v[i][0]; d[1] = v[i][1]; d[2] = v[i][2]; d[3] = v[i][3]; } }
    asm volatile("s_waitcnt lgkmcnt(0)" ::: "memory");
    const int c = lane & 7;
#pragma unroll
    for (int j = 0; j < 4; ++j) { const int n = (lane >> 3) + 8 * j; const LAS float* s = scr + (8 * c) * 33 + n;
        u32x4 o; o.x = cvt_pk_bf16(s[0 * 33], s[1 * 33]); o.y = cvt_pk_bf16(s[2 * 33], s[3 * 33]); o.z = cvt_pk_bf16(s[4 * 33], s[5 * 33]); o.w = cvt_pk_bf16(s[6 * 33], s[7 * 33]);
        *(u32x4*)(WT + (size_t)(row_off + n0 + n) * ldk + koff + k0 + 8 * c) = o; }
    asm volatile("s_waitcnt lgkmcnt(0)" ::: "memory");
}
__device__ __forceinline__ void transpose_item8(const float* W, int N, unsigned char* WT, int ldkb, float scale, LAS float* scr, int kb, int nb, int lane) {
    const int k0 = 64 * kb, n0 = 32 * nb;
#pragma unroll 8
    for (int i = 0; i < 32; ++i) { const int kk = 2 * i + (lane >> 5); scr[kk * 33 + (lane & 31)] = W[(size_t)(k0 + kk) * N + n0 + (lane & 31)]; }
    asm volatile("s_waitcnt lgkmcnt(0)" ::: "memory");
    const int c = lane & 7;
#pragma unroll
    for (int j = 0; j < 4; ++j) { const int n = (lane >> 3) + 8 * j; const LAS float* s = scr + (8 * c) * 33 + n;
        unsigned w0 = 0u, w1 = 0u;
        w0 = __builtin_amdgcn_cvt_pk_fp8_f32(s[0 * 33] * scale, s[1 * 33] * scale, w0, false); w0 = __builtin_amdgcn_cvt_pk_fp8_f32(s[2 * 33] * scale, s[3 * 33] * scale, w0, true);
        w1 = __builtin_amdgcn_cvt_pk_fp8_f32(s[4 * 33] * scale, s[5 * 33] * scale, w1, false); w1 = __builtin_amdgcn_cvt_pk_fp8_f32(s[6 * 33] * scale, s[7 * 33] * scale, w1, true);
        *(u32x2*)(WT + (size_t)(n0 + n) * ldkb + k0 + 8 * c) = (u32x2){w0, w1}; }
    asm volatile("s_waitcnt lgkmcnt(0)" ::: "memory");
}
__device__ __forceinline__ void transpose_item8w(const float* W, int N, unsigned char* WT, int ldkb, float scale, LAS float* scr, int kb, int nb, int lane) {
    const int k0 = 64 * kb, n0 = 64 * nb; const int kr = lane >> 4, nc = 4 * (lane & 15);
    f32x4 v[16];
#pragma unroll
    for (int i = 0; i < 16; ++i) v[i] = *(const f32x4*)(W + (size_t)(k0 + 4 * i + kr) * N + n0 + nc);
#pragma unroll
    for (int i = 0; i < 16; ++i) { LAS float* d = scr + (4 * i + kr) * 65 + nc; d[0] = v[i][0]; d[1] = v[i][1]; d[2] = v[i][2]; d[3] = v[i][3]; }
    asm volatile("s_waitcnt lgkmcnt(0)" ::: "memory");
    unsigned char* o = WT + (size_t)(n0 + lane) * ldkb + k0;
#pragma unroll
    for (int q = 0; q < 4; ++q) { u32x4 w;
#pragma unroll
        for (int d = 0; d < 4; ++d) { const LAS float* s = scr + (16 * q + 4 * d) * 65 + lane; unsigned x = 0u;
            x = __builtin_amdgcn_cvt_pk_fp8_f32(s[0] * scale, s[65] * scale, x, false); x = __builtin_amdgcn_cvt_pk_fp8_f32(s[130] * scale, s[195] * scale, x, true); w[d] = x; }
        *(u32x4*)(o + 16 * q) = w; }
    asm volatile("s_waitcnt lgkmcnt(0)" ::: "memory");
}
struct CvtRegs { f32x4 v[16]; };
__device__ __forceinline__ void convert_load8r(CvtRegs& R, const float* W, int N, int kb, int nb, int lane) {
    const float* src = W + (size_t)(64 * kb + 16 * (lane >> 4)) * N + 64 * nb + 4 * (lane & 15);
#pragma unroll
    for (int k = 0; k < 16; ++k) R.v[k] = *(const f32x4*)(src + (size_t)k * N);
}
__device__ __forceinline__ u32x4 convert_pack16(const f32x16& v, float scale) { u32x4 w;
#pragma unroll
    for (int d = 0; d < 4; ++d) { unsigned x = 0u; x = __builtin_amdgcn_cvt_pk_fp8_f32(v[4 * d] * scale, v[4 * d + 1] * scale, x, false); x = __builtin_amdgcn_cvt_pk_fp8_f32(v[4 * d + 2] * scale, v[4 * d + 3] * scale, x, true); w[d] = x; }
    return w; }
__device__ __forceinline__ void convert_store8r(const CvtRegs& R, unsigned char* WT, int ldkb, float scale, int kb, int nb, int lane) {
    unsigned char* o = WT + (size_t)(64 * nb + 4 * (lane & 15)) * ldkb + 64 * kb + 16 * (lane >> 4);
#pragma unroll
    for (int i = 0; i < 4; ++i) { u32x4 w;
#pragma unroll
        for (int d = 0; d < 4; ++d) { unsigned x = 0u; x = __builtin_amdgcn_cvt_pk_fp8_f32(R.v[4 * d][i] * scale, R.v[4 * d + 1][i] * scale, x, false); x = __builtin_amdgcn_cvt_pk_fp8_f32(R.v[4 * d + 2][i] * scale, R.v[4 * d + 3][i] * scale, x, true); w[d] = x; }
        *(u32x4*)(o + (size_t)i * ldkb) = w; }
}
struct CvtHalf { f32x16 a; };
__device__ __forceinline__ void convert_load8h(CvtHalf& R, const float* W, int N, int kb, int nb, int qtr, int lane) {
    const float* src = W + (size_t)(64 * kb + 16 * qtr) * N + 64 * nb + lane;
#pragma unroll
    for (int k = 0; k < 16; ++k) R.a[k] = src[(size_t)k * N];
}
__device__ __forceinline__ void convert_store8h(const CvtHalf& R, unsigned char* WT, int ldkb, float scale, int kb, int nb, int qtr, int lane) {
    unsigned char* o = WT + (size_t)(64 * nb + lane) * ldkb + 64 * kb + 16 * qtr;
    *(u32x4*)(o) = convert_pack16(R.a, scale);
}
__device__ __forceinline__ void convert_item8r(const float* W, int N, unsigned char* WT, int ldkb, float scale, int kb, int nb, int lane) {
    CvtRegs R; convert_load8r(R, W, N, kb, nb, lane); convert_store8r(R, WT, ldkb, scale, kb, nb, lane);
}
__device__ __forceinline__ bool tr_try(int& r, const float* W, int K, int N, bf16_t* WT, int ldk, int koff, int row_off, LAS float* scr, int lane) {
    const int nblk = N / 32, items = (K / 64) * nblk;
    if (r < items) { transpose_item(W, N, WT, ldk, koff, row_off, scr, r / nblk, r % nblk, lane); return true; }
    r -= items; return false;
}
__device__ __forceinline__ void zero_block(bf16_t* WT, int ldk, int r0, int nr, int k0, int k1, int gthread, int nthreads) {
    const int per = (k1 - k0) / 8; const int total = nr * per;
    for (int i = gthread; i < total; i += nthreads) { const int r = i / per, c = i % per; *(u32x4*)(WT + (size_t)(r0 + r) * ldk + k0 + 8 * c) = (u32x4){0u, 0u, 0u, 0u}; }
}

__device__ __forceinline__ f32x4 ld4bf(const bf16_t* p) { const u32x2 w = *(const u32x2*)p; return (f32x4){bf_lo(w.x), bf_hi(w.x), bf_lo(w.y), bf_hi(w.y)}; }
__device__ __forceinline__ void st4bf(bf16_t* p, f32x4 v) { u32x2 w; w.x = cvt_pk_bf16(v[0], v[1]); w.y = cvt_pk_bf16(v[2], v[3]); *(u32x2*)p = w; }
__device__ __forceinline__ void ld8bf(const bf16_t* p, float (&v)[8]) { const u32x4 w = *(const u32x4*)p; v[0] = bf_lo(w.x); v[1] = bf_hi(w.x); v[2] = bf_lo(w.y); v[3] = bf_hi(w.y); v[4] = bf_lo(w.z); v[5] = bf_hi(w.z); v[6] = bf_lo(w.w); v[7] = bf_hi(w.w); }
__device__ __forceinline__ void st8bf(bf16_t* p, const float (&v)[8]) { u32x4 w; w.x = cvt_pk_bf16(v[0], v[1]); w.y = cvt_pk_bf16(v[2], v[3]); w.z = cvt_pk_bf16(v[4], v[5]); w.w = cvt_pk_bf16(v[6], v[7]); *(u32x4*)p = w; }
__device__ __forceinline__ void ld8f(const float* p, float (&v)[8]) { const f32x4 a = *(const f32x4*)p, b = *(const f32x4*)(p + 4); v[0] = a[0]; v[1] = a[1]; v[2] = a[2]; v[3] = a[3]; v[4] = b[0]; v[5] = b[1]; v[6] = b[2]; v[7] = b[3]; }
__device__ __forceinline__ void up8(u32x4 w, float (&v)[8]) { v[0] = bf_lo(w.x); v[1] = bf_hi(w.x); v[2] = bf_lo(w.y); v[3] = bf_hi(w.y); v[4] = bf_lo(w.z); v[5] = bf_hi(w.z); v[6] = bf_lo(w.w); v[7] = bf_hi(w.w); }
__device__ __forceinline__ int crow(int r, int hi) { return (r & 3) + 8 * (r >> 2) + 4 * hi; }
constexpr int AT_KB = 12288, AT_VB = 8192, AT_BUF = AT_KB + AT_VB;
constexpr int AT_WSF = 2 * AT_BUF, AT_OST = AT_WSF + NWAVES * 256, AT_QW = AT_OST + NWAVES * 4096, AT_LDS = AT_QW + 384;
__device__ __forceinline__ void attn_stage(LAS unsigned char* lds, int buf, const bf16_t* Kt, const bf16_t* Vt, int wid, int lane) {
    LAS unsigned char* kb = lds + buf * AT_BUF; LAS unsigned char* vb = kb + AT_KB;
    __builtin_amdgcn_global_load_lds((const unsigned*)((const char*)Kt + wid * 1024 + lane * 16), (LAS unsigned*)(kb + wid * 1024), 16, 0, 0);
    if (wid < 4) __builtin_amdgcn_global_load_lds((const unsigned*)((const char*)Kt + (8 + wid) * 1024 + lane * 16), (LAS unsigned*)(kb + (8 + wid) * 1024), 16, 0, 0);
    __builtin_amdgcn_global_load_lds((const unsigned*)((const char*)Vt + wid * 1024 + lane * 16), (LAS unsigned*)(vb + wid * 1024), 16, 0, 0);
}
__device__ __forceinline__ void attn_unit(LAS unsigned char* lds, int bh, int qb, const bf16_t* QRAW, const float* ROPE, const bf16_t* Kg, const bf16_t* Vg, bf16_t* OA) {
    const int tid = threadIdx.x, lane = tid & 63, r32 = lane & 31, hi = lane >> 5; const int wid = __builtin_amdgcn_readfirstlane(tid >> 6);
    const int b = bh >> 3, h = bh & 7; const int q0 = qb * 256;
    const size_t tq = (size_t)b * SEQ + q0 + wid * 32 + r32;
    const bf16_t* Qw = QRAW + tq * 768 + h * 96;
    const bf16_t* Kt = Kg + (size_t)bh * 64 * 6144; const bf16_t* Vt = Vg + (size_t)bh * 64 * 4096;
    LAS float* wsf = (LAS float*)(lds + AT_WSF) + wid * 64;
    const int NT = 4 * (qb + 1);
    __syncthreads();
    attn_stage(lds, 0, Kt, Vt, wid, lane);
    bf16x8 qr[6];
    { float xf[6][8]; float ss = 0.f; u32x4 qraw[6];
#pragma unroll
      for (int d0 = 0; d0 < 6; ++d0) qraw[d0] = *(const u32x4*)(Qw + d0 * 16 + hi * 8);
      float cs[8], sn[8]; ld8f(ROPE + tq * 32 + 8 * hi, cs); ld8f(ROPE + tq * 32 + 16 + 8 * hi, sn);
#pragma unroll
      for (int d0 = 0; d0 < 6; ++d0) { up8(qraw[d0], xf[d0]);
#pragma unroll
          for (int i = 0; i < 8; ++i) ss += xf[d0][i] * xf[d0][i]; }
      ss += __shfl_xor(ss, 32); const float rr = rsqrtf(ss * (1.f / 96.f) + 1e-6f) * QSCALE;
#pragma unroll
      for (int d0 = 0; d0 < 6; ++d0) { float w[8]; { const f32x4 wa = *(const LAS f32x4*)(lds + AT_QW + (16 * d0 + 8 * hi) * 4), wb = *(const LAS f32x4*)(lds + AT_QW + (16 * d0 + 8 * hi) * 4 + 16);
              w[0] = wa[0]; w[1] = wa[1]; w[2] = wa[2]; w[3] = wa[3]; w[4] = wb[0]; w[5] = wb[1]; w[6] = wb[2]; w[7] = wb[3]; }
#pragma unroll
          for (int i = 0; i < 8; ++i) xf[d0][i] *= rr * w[i]; }
#pragma unroll
      for (int i = 0; i < 8; ++i) { const float x1 = xf[4][i], x2 = xf[5][i]; xf[4][i] = x1 * cs[i] - x2 * sn[i]; xf[5][i] = x2 * cs[i] + x1 * sn[i]; }
#pragma unroll
      for (int d0 = 0; d0 < 6; ++d0) { u32x4 w; w.x = cvt_pk_bf16(xf[d0][0], xf[d0][1]); w.y = cvt_pk_bf16(xf[d0][2], xf[d0][3]); w.z = cvt_pk_bf16(xf[d0][4], xf[d0][5]); w.w = cvt_pk_bf16(xf[d0][6], xf[d0][7]);
          qr[d0] = __builtin_bit_cast(bf16x8, w); } }
    float mrun = 0.f, lrun = 0.f; f32x16 o0 = {}, o1 = {};
    const bf16x8 aext = __builtin_bit_cast(bf16x8, (u32x4){hi == 0 ? 0x3F80u : 0u, 0u, 0u, 0u});
    bf16x8 qext = __builtin_bit_cast(bf16x8, (u32x4){0u, 0u, 0u, 0u});
    const int qrel = wid * 32 + r32;
    for (int t = 0; t < NT; ++t) {
        asm volatile("s_waitcnt vmcnt(0)" ::: "memory"); __syncthreads();
        if (t + 1 < NT) attn_stage(lds, (t + 1) & 1, Kt + (size_t)(t + 1) * 6144, Vt + (size_t)(t + 1) * 4096, wid, lane);
        const LAS unsigned char* kb = lds + (t & 1) * AT_BUF + hi * 1024 + r32 * 16; const LAS unsigned char* vbase = lds + (t & 1) * AT_BUF + AT_KB;
        if (t - (NT - 4) >= 0 && 64 * (t - (NT - 4)) > wid * 32 + 31) continue;
        const int jb = t - (NT - 4); const f32x16 zz = {};
        f32x16 p0, p1;
        p0 = __builtin_amdgcn_mfma_f32_32x32x16_bf16(aext, qext, zz, 0, 0, 0);
#pragma unroll
        for (int d0 = 0; d0 < 6; ++d0) { const bf16x8 a0 = *(const LAS bf16x8*)(kb + d0 * 2048); p0 = __builtin_amdgcn_mfma_f32_32x32x16_bf16(a0, qr[d0], p0, 0, 0, 0); }
        bf16x8 k1[6];
#pragma unroll
        for (int d0 = 0; d0 < 6; ++d0) k1[d0] = *(const LAS bf16x8*)(kb + d0 * 2048 + 512);
        if (jb >= 0) { const int kbase = 64 * jb + 4 * hi;
#pragma unroll
            for (int r = 0; r < 16; ++r) { const int kv = kbase + (r & 3) + 8 * (r >> 2); if (kv > qrel) p0[r] = -INFINITY; } }
        const LAS unsigned char* vp = vbase + ((lane >> 4) & 1) * 32 + (lane & 3) * 8 + (4 * hi + ((lane & 15) >> 2)) * 64; const int vpi = (int)(size_t)vp;
#define AT_TR(dst, off) asm volatile("ds_read_b64_tr_b16 %0, %1 offset:%2" : "=&v"(dst) : "v"(vpi), "i"(off) : "memory")
#define AT_CAT(lo, hh) (bf16x8){lo[0], lo[1], lo[2], lo[3], hh[0], hh[1], hh[2], hh[3]}
        s16x4 va0, vb0, va1, vb1, vc0, vd0, vc1, vd1;
        AT_TR(va0, 0); AT_TR(vb0, 512); AT_TR(va1, 1024); AT_TR(vb1, 1536); AT_TR(vc0, 4096); AT_TR(vd0, 4608); AT_TR(vc1, 5120); AT_TR(vd1, 5632);
        float mx = -INFINITY; f32x2 ps2 = {0.f, 0.f}; unsigned pw[16];
#define AT_FIL(P, pr, W) do { const float e0_ = __builtin_amdgcn_exp2f(P[2 * (pr)]), e1_ = __builtin_amdgcn_exp2f(P[2 * (pr) + 1]); mx = fmaxf(mx, fmaxf(P[2 * (pr)], P[2 * (pr) + 1])); \
            ps2 += (f32x2){e0_, e1_}; W = cvt_pk_bf16(e0_, e1_); asm volatile("" : "+v"(W), "+v"(mx), "+v"(ps2)); } while (0)
        __builtin_amdgcn_sched_barrier(0);
        p1 = __builtin_amdgcn_mfma_f32_32x32x16_bf16(aext, qext, zz, 0, 0, 0); AT_FIL(p0, 0, pw[0]); __builtin_amdgcn_sched_barrier(0);
        p1 = __builtin_amdgcn_mfma_f32_32x32x16_bf16(k1[0], qr[0], p1, 0, 0, 0); AT_FIL(p0, 1, pw[1]); __builtin_amdgcn_sched_barrier(0);
        p1 = __builtin_amdgcn_mfma_f32_32x32x16_bf16(k1[1], qr[1], p1, 0, 0, 0); AT_FIL(p0, 2, pw[2]); __builtin_amdgcn_sched_barrier(0);
        p1 = __builtin_amdgcn_mfma_f32_32x32x16_bf16(k1[2], qr[2], p1, 0, 0, 0); AT_FIL(p0, 3, pw[3]); __builtin_amdgcn_sched_barrier(0);
        p1 = __builtin_amdgcn_mfma_f32_32x32x16_bf16(k1[3], qr[3], p1, 0, 0, 0); AT_FIL(p0, 4, pw[4]); __builtin_amdgcn_sched_barrier(0);
        p1 = __builtin_amdgcn_mfma_f32_32x32x16_bf16(k1[4], qr[4], p1, 0, 0, 0); AT_FIL(p0, 5, pw[5]); __builtin_amdgcn_sched_barrier(0);
        p1 = __builtin_amdgcn_mfma_f32_32x32x16_bf16(k1[5], qr[5], p1, 0, 0, 0); AT_FIL(p0, 6, pw[6]); AT_FIL(p0, 7, pw[7]); __builtin_amdgcn_sched_barrier(0);
        if (jb >= 0) { const int kbase = 64 * jb + 4 * hi;
#pragma unroll
            for (int r = 0; r < 16; ++r) { const int kv = kbase + (r & 3) + 8 * (r >> 2); if (kv + 32 > qrel) p1[r] = -INFINITY; } }
        const bf16x8 pa0 = __builtin_bit_cast(bf16x8, (u32x4){pw[0], pw[1], pw[2], pw[3]}), pa1 = __builtin_bit_cast(bf16x8, (u32x4){pw[4], pw[5], pw[6], pw[7]});
        asm volatile("s_waitcnt lgkmcnt(0)" ::: "memory");
        s16x4 ve0, vf0, ve1, vf1, vg0, vh0, vg1, vh1;
        AT_TR(ve0, 2048); AT_TR(vf0, 2560); AT_TR(ve1, 3072); AT_TR(vf1, 3584); AT_TR(vg0, 6144); AT_TR(vh0, 6656); AT_TR(vg1, 7168); AT_TR(vh1, 7680);
        __builtin_amdgcn_sched_barrier(0);
        o0 = __builtin_amdgcn_mfma_f32_32x32x16_bf16(pa0, AT_CAT(va0, vb0), o0, 0, 0, 0); AT_FIL(p1, 0, pw[8]); AT_FIL(p1, 1, pw[9]); __builtin_amdgcn_sched_barrier(0);
        o1 = __builtin_amdgcn_mfma_f32_32x32x16_bf16(pa0, AT_CAT(vc0, vd0), o1, 0, 0, 0); AT_FIL(p1, 2, pw[10]); AT_FIL(p1, 3, pw[11]); __builtin_amdgcn_sched_barrier(0);
        o0 = __builtin_amdgcn_mfma_f32_32x32x16_bf16(pa1, AT_CAT(va1, vb1), o0, 0, 0, 0); AT_FIL(p1, 4, pw[12]); AT_FIL(p1, 5, pw[13]); __builtin_amdgcn_sched_barrier(0);
        o1 = __builtin_amdgcn_mfma_f32_32x32x16_bf16(pa1, AT_CAT(vc1, vd1), o1, 0, 0, 0); AT_FIL(p1, 6, pw[14]); AT_FIL(p1, 7, pw[15]); __builtin_amdgcn_sched_barrier(0);
        const bf16x8 pa2 = __builtin_bit_cast(bf16x8, (u32x4){pw[8], pw[9], pw[10], pw[11]}), pa3 = __builtin_bit_cast(bf16x8, (u32x4){pw[12], pw[13], pw[14], pw[15]});
        asm volatile("s_waitcnt lgkmcnt(0)" ::: "memory"); __builtin_amdgcn_sched_barrier(0);
        o0 = __builtin_amdgcn_mfma_f32_32x32x16_bf16(pa2, AT_CAT(ve0, vf0), o0, 0, 0, 0); o1 = __builtin_amdgcn_mfma_f32_32x32x16_bf16(pa2, AT_CAT(vg0, vh0), o1, 0, 0, 0);
        o0 = __builtin_amdgcn_mfma_f32_32x32x16_bf16(pa3, AT_CAT(ve1, vf1), o0, 0, 0, 0); o1 = __builtin_amdgcn_mfma_f32_32x32x16_bf16(pa3, AT_CAT(vg1, vh1), o1, 0, 0, 0);
#undef AT_FIL
#undef AT_CAT
#undef AT_TR
        lrun += ps2[0] + ps2[1];
        float rm = fmaxf(mx, __shfl_xor(mx, 32));
        const bool need = (t == 0) || (rm > 6.f);
        if (__any(need)) {
            const float mnew = need ? __builtin_bit_cast(float, cvt_pk_bf16(mrun + rm, 0.f) << 16) : mrun; const float delta = mnew - mrun; mrun = mnew;
            qext = __builtin_bit_cast(bf16x8, (u32x4){hi == 0 ? (cvt_pk_bf16(-mnew, 0.f) & 0xffffu) : 0u, 0u, 0u, 0u});
            const float alpha = __builtin_amdgcn_exp2f(-delta); lrun *= alpha;
            if (hi == 0) wsf[r32] = alpha;
            asm volatile("s_waitcnt lgkmcnt(0)" ::: "memory");
#pragma unroll
            for (int r = 0; r < 16; ++r) { const float f = wsf[crow(r, hi)]; o0[r] *= f; o1[r] *= f; }
        }
    }
    lrun += __shfl_xor(lrun, 32);
    if (hi == 0) wsf[32 + r32] = 1.f / lrun;
    asm volatile("s_waitcnt lgkmcnt(0)" ::: "memory");
    LAS bf16_t* stg = (LAS bf16_t*)(lds + AT_OST) + wid * 2048;
#pragma unroll
    for (int r = 0; r < 16; ++r) { const int orow = crow(r, hi); const float il = wsf[32 + orow];
        stg[orow * 64 + r32] = (bf16_t)(cvt_pk_bf16(o0[r] * il, 0.f) & 0xffffu); stg[orow * 64 + 32 + r32] = (bf16_t)(cvt_pk_bf16(o1[r] * il, 0.f) & 0xffffu); }
    asm volatile("s_waitcnt lgkmcnt(0)" ::: "memory");
    bf16_t* Ow = OA + ((size_t)b * SEQ + q0 + wid * 32) * 512 + h * 64;
#pragma unroll
    for (int i = 0; i < 4; ++i) { const int row = i * 8 + (lane >> 3), ch = lane & 7; const u32x4 v = *(const LAS u32x4*)(stg + row * 64 + ch * 8); *(u32x4*)(Ow + (size_t)row * 512 + ch * 8) = v; }
}

constexpr int SC_CH = 32;
constexpr int SC_BUF = SC_CH * 384 * 4;
constexpr int SC_Y = 2 * SC_BUF;
__device__ __forceinline__ void scan_unit(LAS unsigned char* lds, int bh, const bf16_t* SIN, float* Y) {
    const int tid = threadIdx.x, v = tid >> 3, kq = tid & 7; const int b = bh >> 3, h = bh & 7;
    const bf16_t* src = SIN + (size_t)bh * SEQ * 384;
    float S[8];
#pragma unroll
    for (int i = 0; i < 8; ++i) S[i] = 0.f;
    u32x4 st[3];
    auto load_chunk = [&](int c) {
#pragma unroll
        for (int j = 0; j < 3; ++j) st[j] = *(const u32x4*)((const char*)src + (size_t)c * (SC_CH * 768) + (size_t)(j * 512 + tid) * 16); };
    auto write_chunk = [&](int buf) { LAS float* dst = (LAS float*)(lds + buf * SC_BUF);
#pragma unroll
        for (int j = 0; j < 3; ++j) { const int e0 = (j * 512 + tid) * 8; f32x4 a, bq; unpack8(st[j], a, bq); *(LAS f32x4*)(dst + e0) = a; *(LAS f32x4*)(dst + e0 + 4) = bq; } };
    __syncthreads();
    load_chunk(0); write_chunk(0);
    const int NCH = SEQ / SC_CH;
    LAS float* yb = (LAS float*)(lds + SC_Y);
    for (int c = 0; c < NCH; ++c) {
        __syncthreads();
        if (c + 1 < NCH) load_chunk(c + 1);
        const LAS float* in = (const LAS float*)(lds + (c & 1) * SC_BUF);
#pragma unroll 2
        for (int t = 0; t < SC_CH; ++t) {
            const LAS float* p = in + t * 384 + 8 * kq;
            const f32x4 r0 = *(const LAS f32x4*)(p), r1 = *(const LAS f32x4*)(p + 4);
            const f32x4 x0 = *(const LAS f32x4*)(p + 64), x1 = *(const LAS f32x4*)(p + 68);
            const f32x4 k0 = *(const LAS f32x4*)(p + 128), k1 = *(const LAS f32x4*)(p + 132);
            const f32x4 n0 = *(const LAS f32x4*)(p + 256), n1 = *(const LAS f32x4*)(p + 260);
            const f32x4 b0 = *(const LAS f32x4*)(p + 320), b1 = *(const LAS f32x4*)(p + 324);
            const float vv = in[t * 384 + 192 + v];
            float sa = (S[0] * n0[0] + S[1] * n0[1]) + (S[2] * n0[2] + S[3] * n0[3]) + (S[4] * n1[0] + S[5] * n1[1]) + (S[6] * n1[2] + S[7] * n1[3]);
            sa = -sum8(sa);
            float yy = 0.f;
#pragma unroll
            for (int i = 0; i < 4; ++i) { S[i] = S[i] - S[i] * x0[i] + sa * b0[i] + vv * k0[i]; S[4 + i] = S[4 + i] - S[4 + i] * x1[i] + sa * b1[i] + vv * k1[i]; }
            yy = (S[0] * r0[0] + S[1] * r0[1]) + (S[2] * r0[2] + S[3] * r0[3]) + (S[4] * r1[0] + S[5] * r1[1]) + (S[6] * r1[2] + S[7] * r1[3]);
            yy = sum8(yy);
            if (kq == 0) yb[t * 64 + v] = yy;
        }
        __syncthreads();
        { const int e0 = tid * 4; const int t = e0 >> 6, vv0 = e0 & 63; const f32x4 yv = *(const LAS f32x4*)(yb + e0);
          *(f32x4*)(Y + ((size_t)b * SEQ + (size_t)c * SC_CH + t) * 512 + h * 64 + vv0) = yv; }
        if (c + 1 < NCH) write_chunk((c + 1) & 1);
    }
}
}

namespace fk {
constexpr size_t WS_WM = 684 * MiB;
constexpr size_t WS_WN = 236 * MiB;
constexpr size_t WS_WQ1 = 748 * MiB;
constexpr size_t WS_WQ2 = 844 * MiB;
constexpr size_t WS_WSB = 876 * MiB;
constexpr size_t WS_WBS = 908 * MiB;
constexpr size_t WS_WVL = 652 * MiB;
static_assert(WS_WBS + (size_t)T * 8 * 4 <= WS_END, "wkv buffers");

constexpr int IMG = 8192;
enum { I_AT = 0, I_RT = 1, I_BT = 2, I_KT = 3, I_VTR = 4, I_ATR = 5, I_BH = 6, I_KH = 7, I_AAK = 8, I_ARB = 9, I_ARK = 10, I_G0 = 11  , I_G1 = 12  ,
       I_AO16 = 14, I_AO32 = 15, I_DTA = 16, I_ZTR = I_BT, I_W1TR = I_KT, I_W2TR = I_AT, I_XTR = I_KT, I_DTB = I_AT };
constexpr int WA_TOT = 17 * IMG;
constexpr int WA_PL = WA_TOT + 2048;
static_assert(WA_PL + 256 <= LDS_BYTES - 512, "wkv lds");

struct WLane { int r32, hi, trb; };
__device__ __forceinline__ WLane wlane(int lane) { WLane L; L.r32 = lane & 31; L.hi = lane >> 5; L.trb = (8 * L.hi + ((lane & 15) >> 2)) * 64 + ((lane >> 4) & 1) * 32 + (lane & 3) * 8; return L; }
__device__ __forceinline__ bf16x8 frag_cm(const LAS unsigned char* img, int blk, int d0, const WLane& L) { return *(const LAS bf16x8*)(img + (((2 * d0 + L.hi) * 64 + 32 * blk + L.r32) * 16)); }
__device__ __forceinline__ bf16x8 frag_tr(const LAS unsigned char* img, int blk, int d0, const WLane& L) {
    const LAS unsigned char* p = img + (blk * 4 + d0) * 1024 + L.trb;
    const s16x4 lo = __builtin_bit_cast(s16x4, __builtin_amdgcn_ds_read_tr16_b64_v4i16((LAS s16x4*)p));
    const s16x4 hh = __builtin_bit_cast(s16x4, __builtin_amdgcn_ds_read_tr16_b64_v4i16((LAS s16x4*)(p + 256)));
    return (bf16x8){lo[0], lo[1], lo[2], lo[3], hh[0], hh[1], hh[2], hh[3]};
}
template <bool ATR, bool BTR, int D0 = 0, int D1 = 4> __device__ __forceinline__ f32x16 tile_mm(f32x16 acc, const LAS unsigned char* ia, int ba, const LAS unsigned char* ib, int bb, const WLane& L) {
    bf16x8 a[D1 - D0], b[D1 - D0];
#pragma unroll
    for (int d0 = D0; d0 < D1; ++d0) { a[d0 - D0] = ATR ? frag_tr(ia, ba, d0, L) : frag_cm(ia, ba, d0, L); b[d0 - D0] = BTR ? frag_tr(ib, bb, d0, L) : frag_cm(ib, bb, d0, L); }
#pragma unroll
    for (int d0 = D0; d0 < D1; ++d0) acc = __builtin_amdgcn_mfma_f32_32x32x16_bf16(a[d0 - D0], b[d0 - D0], acc, 0, 0, 0);
    return acc;
}
__device__ __forceinline__ void st_cm(LAS unsigned char* img, const f32x16& v, int ba, int bb, const WLane& L) {
#pragma unroll
    for (int g = 0; g < 4; ++g) { u32x2 w; w.x = cvt_pk_bf16(v[4 * g], v[4 * g + 1]); w.y = cvt_pk_bf16(v[4 * g + 2], v[4 * g + 3]);
        *(LAS u32x2*)(img + (((4 * ba + g) * 64 + 32 * bb + L.r32) * 16 + 8 * L.hi)) = w; }
}
__device__ __forceinline__ void st_tr(LAS unsigned char* img, const f32x16& v, int ba, int bb, const WLane& L) {
    const int J = 32 * bb + L.r32;
#pragma unroll
    for (int g = 0; g < 4; ++g) { u32x2 w; w.x = cvt_pk_bf16(v[4 * g], v[4 * g + 1]); w.y = cvt_pk_bf16(v[4 * g + 2], v[4 * g + 3]);
        *(LAS u32x2*)(img + ((ba * 4 + (J >> 4)) * 1024 + (J & 15) * 64 + (8 * g + 4 * L.hi) * 2)) = w; }
}
#ifndef WREPID
#define WREPID -1
#endif
#define WREP(id) for (int _w = 0; _w < ((WREPID == (id)) ? 3 : 1); ++_w)
#define WBAR() do { asm volatile("s_waitcnt lgkmcnt(0)" ::: "memory"); __builtin_amdgcn_s_barrier(); asm volatile("" ::: "memory"); } while (0)


template <int R> __device__ __forceinline__ void subst16(const LAS float* af, LAS unsigned char* dcm, LAS unsigned char* dtr, int blk, int j, f32x16& tc) {
    float acc = (R == j) ? 1.f : 0.f;
    constexpr int NQ = (R + 3) / 4;
#pragma unroll
    for (int q = 0; q < NQ; ++q) { const f32x4 av = *(const LAS f32x4*)(af + R * 64 + 4 * q);
#pragma unroll
        for (int e = 0; e < 4; ++e) { const int sI = 4 * q + e; if (sI < R) acc += av[e] * tc[sI]; } }
    tc[R] = acc;
    const int t = 16 * blk + R, sg = 16 * blk + j; const unsigned short hv = (unsigned short)(cvt_pk_bf16(acc, 0.f) & 0xffffu);
    *(LAS unsigned short*)(dcm + (((sg >> 3) * 64 + t) * 16 + (sg & 7) * 2)) = hv;
    *(LAS unsigned short*)(dtr + (((sg >> 5) * 4 + (t >> 4)) * 1024 + (t & 15) * 64 + (sg & 31) * 2)) = hv;
    if constexpr (R + 1 < 16) subst16<R + 1>(af, dcm, dtr, blk, j, tc);
}
#ifndef WCVA_ITEMS
#define WCVA_ITEMS 7168
#endif
constexpr int WCV_IG = 16 * 32, WCV_ID = 16 * 16, WCV_NIT = 32 * (WCV_IG + WCV_ID), WCV_A = WCVA_ITEMS;
__device__ __forceinline__ void wcv_load(CvtRegs& R, const Args& a, int it, int lane) {
    if (it < 32 * WCV_IG) { const int e = it / WCV_IG, rr = it % WCV_IG; convert_load8r(R, a.in[30] + (size_t)e * 1024 * 2048, 2048, rr / 32, rr % 32, lane); }
    else { const int qq = it - 32 * WCV_IG; const int e = qq / WCV_ID, rr = qq % WCV_ID; convert_load8r(R, a.in[32] + (size_t)e * 1024 * 1024, 1024, rr / 16, rr % 16, lane); }
}
constexpr int WA_CVB = 143360;
static_assert(WA_CVB >= WA_PL + 256 && WA_CVB + 16384 <= LDS_BYTES - 512, "wkv cvt lds");
__device__ __forceinline__ void wcv_q_src(const Args& a, int hit, const float*& W, int& N, unsigned char*& WT, int& kb, int& nb) { const int it = hit >> 2;
    if (it < 32 * WCV_IG) { const int e = it / WCV_IG, rr = it % WCV_IG; W = a.in[30] + (size_t)e * 1024 * 2048; N = 2048; WT = a.ws + WS_WGU + (size_t)e * 2048 * 1024; kb = rr / 32; nb = rr % 32; }
    else { const int qq = it - 32 * WCV_IG; const int e = qq / WCV_ID, rr = qq % WCV_ID; W = a.in[32] + (size_t)e * 1024 * 1024; N = 1024; WT = a.ws + WS_WDN + (size_t)e * 1024 * 1024; kb = rr / 16; nb = rr % 16; }
}
__device__ __forceinline__ void wcv_issue_q(LAS unsigned char* buf, const Args& a, int hit, int lane) {
    const float* W; int N, kb, nb; unsigned char* WT; wcv_q_src(a, hit, W, N, WT, kb, nb);
    const float* src = W + (size_t)(64 * kb + 16 * (hit & 3) + (lane >> 4)) * N + 64 * nb + (lane & 15) * 4;
#pragma unroll
    for (int i = 0; i < 4; ++i) __builtin_amdgcn_global_load_lds((const unsigned*)(src + (size_t)(4 * i) * N), (LAS unsigned*)(buf + i * 1024), 16, 0, 0);
}
__device__ __forceinline__ void wcv_finish_q(const LAS unsigned char* buf, const Args& a, int hit, int lane) {
    const float* W; int N, kb, nb; unsigned char* WT; wcv_q_src(a, hit, W, N, WT, kb, nb);
    asm volatile("s_waitcnt vmcnt(0)" ::: "memory");
    f32x16 v;
#pragma unroll
    for (int k = 0; k < 16; ++k) v[k] = *(const LAS float*)(buf + k * 256 + lane * 4);
    *(u32x4*)(WT + (size_t)(64 * nb + lane) * 1024 + 64 * kb + 16 * (hit & 3)) = convert_pack16(v, 64.f);
}
__device__ __forceinline__ void wcv_store(const CvtRegs& R, const Args& a, int it, int lane) {
    unsigned char* WGU = a.ws + WS_WGU; unsigned char* WDN = a.ws + WS_WDN;
    if (it < 32 * WCV_IG) { const int e = it / WCV_IG, rr = it % WCV_IG; convert_store8r(R, WGU + (size_t)e * 2048 * 1024, 1024, 64.f, rr / 32, rr % 32, lane); }
    else { const int qq = it - 32 * WCV_IG; const int e = qq / WCV_ID, rr = qq % WCV_ID; convert_store8r(R, WDN + (size_t)e * 1024 * 1024, 1024, 64.f, rr / 16, rr % 16, lane); }
}
__device__ __forceinline__ void wkv_phase_a(const Frame& F, const Args& a) {
    unsigned char* ws = a.ws; const bf16_t* PS = (const bf16_t*)(ws + WS_PS); const bf16_t* DEC = (const bf16_t*)(ws + WS_DEC); const bf16_t* AA = (const bf16_t*)(ws + WS_AA); bf16_t* WVL = (bf16_t*)(ws + WS_WVL);
    const float* mu = a.in[15]; const float* w0p = a.in[16]; const float* a0p = a.in[18]; const float* k_k = a.in[21]; const float* k_a = a.in[22]; const float* r_k = a.in[23];
    float* WM = (float*)(ws + WS_WM); float* WN = (float*)(ws + WS_WN); bf16_t* WQ1 = (bf16_t*)(ws + WS_WQ1); bf16_t* WQ2 = (bf16_t*)(ws + WS_WQ2); float* WBS = (float*)(ws + WS_WBS);
    LAS unsigned char* lds = F.lds; const int tid = F.tid, lane = F.lane, wave = F.wave; const WLane L = wlane(lane);
    LAS float* tot = (LAS float*)(lds + WA_TOT); LAS float* PLs = (LAS float*)(lds + WA_PL);
#define IMGP(i) (lds + (i) * IMG)
    for (int ck = F.vcu; ck < 4096; ck += F.G) {
        const int bh = ck >> 6, ch = ck & 63, h = bh & 7;
        WREP(0) { const int t = tid >> 3, j = tid & 7; const int c0 = h * 64 + 8 * j; const int sq = ch * 64 + t; const size_t tg = (size_t)(bh >> 3) * SEQ + sq;
          const bf16_t* ps = PS + tg * NPS + 512;
          float r[8], kp[8], v[8], kk[8], bb[8], G[8], lw[8], dw[8], aa[8];
          { float k[8], pr[8], pk[8], pv[8]; ld8bf(ps + c0, r); ld8bf(ps + 512 + c0, k); ld8bf(ps + 1024 + c0, v);
            if (sq != 0) { ld8bf(ps - NPS + c0, pr); ld8bf(ps - NPS + 512 + c0, pk); ld8bf(ps - NPS + 1024 + c0, pv); }
            else {
#pragma unroll
                for (int i = 0; i < 8; ++i) { pr[i] = 0.f; pk[i] = 0.f; pv[i] = 0.f; } }
            ld8bf(DEC + tg * 512 + c0, dw); ld8bf(AA + tg * 512 + c0, aa);
            float mur[8], muk[8], muv[8], kkc[8], kac[8], w0c[8], a0c[8];
            ld8f(mu + c0, mur); ld8f(mu + 512 + c0, muk); ld8f(mu + 1024 + c0, muv); ld8f(k_k + c0, kkc); ld8f(k_a + c0, kac); ld8f(w0p + c0, w0c); ld8f(a0p + c0, a0c);
            float ss = 0.f;
#pragma unroll
            for (int i = 0; i < 8; ++i) { r[i] += (pr[i] - r[i]) * mur[i]; k[i] += (pk[i] - k[i]) * muk[i]; v[i] += (pv[i] - v[i]) * muv[i]; kk[i] = k[i] * kkc[i]; ss += kk[i] * kk[i];
                const float z = -(w0c[i] + dw[i]); lw[i] = -0.60653066f * __builtin_amdgcn_rcpf(1.f + __expf(z));
                aa[i] = fsigmoid(a0c[i] + aa[i]); }
            const float inv = 1.f / fmaxf(sqrtf(sum8(ss)), 1e-12f);
#pragma unroll
            for (int i = 0; i < 8; ++i) { kk[i] *= inv; kp[i] = k[i] * (1.f + (aa[i] - 1.f) * kac[i]); bb[i] = kk[i] * aa[i]; } }
          u32x4 vraw; vraw.x = cvt_pk_bf16(v[0], v[1]); vraw.y = cvt_pk_bf16(v[2], v[3]); vraw.z = cvt_pk_bf16(v[4], v[5]); vraw.w = cvt_pk_bf16(v[6], v[7]);
          *(u32x4*)(WVL + tg * 512 + c0) = vraw;
          float rkc[8]; ld8f(r_k + h * 64 + 8 * j, rkc); float bs = 0.f;
#pragma unroll
          for (int i = 0; i < 8; ++i) { G[i] = lw[i]; bs += r[i] * kp[i] * rkc[i]; }
          bs = sum8(bs); if (j == 0) WBS[((size_t)(bh >> 3) * SEQ + ch * 64 + t) * 8 + h] = bs;
#pragma unroll
          for (int off = 8; off < 64; off <<= 1) {
#pragma unroll
              for (int i = 0; i < 8; ++i) { const float o = __shfl_up(G[i], off); if (lane >= off) G[i] += o; } }
          if (lane >= 56) { *(LAS f32x4*)(tot + wave * 64 + 8 * j) = (f32x4){G[0], G[1], G[2], G[3]}; *(LAS f32x4*)(tot + wave * 64 + 8 * j + 4) = (f32x4){G[4], G[5], G[6], G[7]}; }
          WBAR();
          float GL[8];
#pragma unroll
          for (int i = 0; i < 8; ++i) GL[i] = 0.f;
#pragma unroll
          for (int w = 0; w < 8; ++w) { const f32x4 t0 = *(const LAS f32x4*)(tot + w * 64 + 8 * j), t1 = *(const LAS f32x4*)(tot + w * 64 + 8 * j + 4);
#pragma unroll
              for (int i = 0; i < 4; ++i) { GL[i] += t0[i]; GL[4 + i] += t1[i]; if (w < wave) { G[i] += t0[i]; G[4 + i] += t1[i]; } } }
          float At[8], Rt[8], Bt[8], Kt[8], Bh[8], Kh[8];
#pragma unroll
          for (int i = 0; i < 8; ++i) { const float P = __expf(G[i]), Pi = __expf(-G[i]), Pex = __expf(G[i] - lw[i]), Pl = __expf(GL[i] - G[i]);
              At[i] = -kk[i] * Pex; Rt[i] = r[i] * P; Bt[i] = bb[i] * Pi; Kt[i] = kp[i] * Pi; Bh[i] = bb[i] * Pl; Kh[i] = kp[i] * Pl; }
          if (t == 0) { *(LAS f32x4*)(PLs + 8 * j) = (f32x4){__expf(GL[0]), __expf(GL[1]), __expf(GL[2]), __expf(GL[3])}; *(LAS f32x4*)(PLs + 8 * j + 4) = (f32x4){__expf(GL[4]), __expf(GL[5]), __expf(GL[6]), __expf(GL[7])}; }
          const int cmo = (j * 64 + t) * 16; const int tro = ((j >> 2) * 4 + (t >> 4)) * 1024 + (t & 15) * 64 + (j & 3) * 16;
          u32x4 w;
#define PK8(A) (w.x = cvt_pk_bf16(A[0], A[1]), w.y = cvt_pk_bf16(A[2], A[3]), w.z = cvt_pk_bf16(A[4], A[5]), w.w = cvt_pk_bf16(A[6], A[7]), w)
          { const u32x4 p = PK8(At); *(LAS u32x4*)(IMGP(I_AT) + cmo) = p; *(LAS u32x4*)(IMGP(I_ATR) + tro) = p; }
          *(LAS u32x4*)(IMGP(I_RT) + cmo) = PK8(Rt); *(LAS u32x4*)(IMGP(I_BT) + cmo) = PK8(Bt); *(LAS u32x4*)(IMGP(I_KT) + cmo) = PK8(Kt);
          *(LAS u32x4*)(IMGP(I_BH) + tro) = PK8(Bh); *(LAS u32x4*)(IMGP(I_KH) + tro) = PK8(Kh); *(LAS u32x4*)(IMGP(I_VTR) + tro) = vraw;
#undef PK8
        WBAR(); }
        const int cvj = 16384 + ((ck / F.G) * F.G + F.vcu) * 3 + (wave - 1); const bool cvon2 = (wave >= 1) && (wave <= 3) && (cvj < 4 * WCV_A); LAS unsigned char* cvb2 = lds + WA_CVB + wave * 4096;
        if (cvon2) wcv_issue_q(cvb2, a, cvj, lane);
        WREP(1) { const int p = wave >> 1, fb = wave & 1; const LAS unsigned char* Lop = (p < 2) ? IMGP(I_AT) : IMGP(I_RT); const LAS unsigned char* Rop = (p & 1) ? IMGP(I_KT) : IMGP(I_BT);
          f32x16 x0 = {}, x1 = {}; x0 = tile_mm<false, false>(x0, Rop, 0, Lop, fb, L); x1 = tile_mm<false, false>(x1, Rop, 1, Lop, fb, L);
          const int tt = 32 * fb + L.r32; const bool incl = p >= 2;
#pragma unroll
          for (int rg = 0; rg < 16; ++rg) { const int s0 = crow(rg, L.hi); const bool k0 = incl ? (s0 <= tt) : (s0 < tt); const bool k1 = incl ? (s0 + 32 <= tt) : (s0 + 32 < tt); x0[rg] = k0 ? x0[rg] : 0.f; x1[rg] = k1 ? x1[rg] : 0.f; }
          if (p == 0) {
              LAS float* af = (LAS float*)IMGP(I_G1) + (32 * fb + L.r32) * 64;
#pragma unroll
              for (int g = 0; g < 4; ++g) { *(LAS f32x4*)(af + 8 * g + 4 * L.hi) = (f32x4){x0[4 * g], x0[4 * g + 1], x0[4 * g + 2], x0[4 * g + 3]};
                  *(LAS f32x4*)(af + 32 + 8 * g + 4 * L.hi) = (f32x4){x1[4 * g], x1[4 * g + 1], x1[4 * g + 2], x1[4 * g + 3]}; }
              f32x16 m0, m1;
#pragma unroll
              for (int rg = 0; rg < 16; ++rg) { const int s0 = crow(rg, L.hi); const bool todd = ((tt >> 4) & 1) != 0; const bool sev = ((s0 >> 4) & 1) == 0;
                  m0[rg] = (fb == 0 && todd && sev) ? x0[rg] : 0.f; m1[rg] = (fb == 1 && todd && sev) ? x1[rg] : 0.f; }
              st_cm(IMGP(I_AO16), m0, 0, fb, L); st_cm(IMGP(I_AO16), m1, 1, fb, L);
#pragma unroll
              for (int rg = 0; rg < 16; ++rg) { m0[rg] = (fb == 1) ? x0[rg] : 0.f; m1[rg] = 0.f; }
              st_cm(IMGP(I_AO32), m0, 0, fb, L); st_cm(IMGP(I_AO32), m1, 1, fb, L); }
          else { LAS unsigned char* dst = (p == 1) ? IMGP(I_AAK) : (p == 2) ? IMGP(I_ARB) : IMGP(I_ARK); st_cm(dst, x0, 0, fb, L); st_cm(dst, x1, 1, fb, L);
              if (p == 3) { LAS unsigned char* zi = fb ? IMGP(I_DTA) : IMGP(I_G0);
#pragma unroll
                  for (int i = 0; i < 8; ++i) *(LAS u32x4*)(zi + (i * 64 + lane) * 16) = (u32x4){0u, 0u, 0u, 0u}; } }
        WBAR(); }
        WREP(2) {
        if (wave == 0) { const int blk = lane >> 4, jj = lane & 15; f32x16 tc = {}; subst16<0>((const LAS float*)IMGP(I_G1) + blk * (16 * 64 + 16), IMGP(I_G0), IMGP(I_DTA), blk, jj, tc); }
        else if (wave >= 4) { const int fb = (wave >> 1) & 1, sb = wave & 1; f32x16 z = {}; z = tile_mm<true, false>(z, IMGP(I_VTR), sb, IMGP(I_AAK), fb, L); st_tr(IMGP(I_ZTR), z, sb, fb, L); }
        else if (cvon2) wcv_finish_q(cvb2, a, cvj, lane);
        WBAR(); }
#define WDIAG1(V, SB, FB) do { if ((SB) == (FB)) { const int tt_ = 32 * (FB) + L.r32; _Pragma("unroll") for (int rg = 0; rg < 16; ++rg) if (32 * (SB) + crow(rg, L.hi) == tt_) V[rg] += 1.f; } } while (0)
        const int cvi = ((ck / F.G) * F.G + F.vcu) * 4 + (wave - 4); const bool cvon = (wave >= 4) && (cvi < 4 * WCV_A); LAS unsigned char* cvb = lds + WA_CVB + (wave & 3) * 4096;
        WREP(3) {
        if (wave < 4) { const int sb = wave & 1, fb = wave >> 1; f32x16 xx = {}; xx = tile_mm<true, false>(xx, IMGP(I_DTA), sb, IMGP(I_AO16), fb, L); WDIAG1(xx, sb, fb); st_tr(IMGP(I_XTR), xx, sb, fb, L); }
        else if (cvon) wcv_issue_q(cvb, a, cvi, lane);
        WBAR();
        if (wave < 4) { const int sb = wave & 1, fb = wave >> 1; f32x16 dd = {}; dd = tile_mm<true, false>(dd, IMGP(I_XTR), sb, IMGP(I_G0), fb, L); st_cm(IMGP(I_G1), dd, sb, fb, L); st_tr(IMGP(I_DTB), dd, sb, fb, L); }
        WBAR();
        if (wave < 4) { const int sb = wave & 1, fb = wave >> 1; f32x16 xx = {}; xx = tile_mm<true, false>(xx, IMGP(I_DTB), sb, IMGP(I_AO32), fb, L); WDIAG1(xx, sb, fb); st_tr(IMGP(I_XTR), xx, sb, fb, L); }
        WBAR();
        if (wave < 4) { const int sb = wave & 1, fb = wave >> 1; f32x16 dd = {}; dd = tile_mm<true, false>(dd, IMGP(I_XTR), sb, IMGP(I_G1), fb, L); st_cm(IMGP(I_G0), dd, sb, fb, L); }
        else if (cvon) wcv_finish_q(cvb, a, cvi, lane);
        WBAR();
        }
#undef WDIAG1
        WREP(4) { const int fb = (wave >> 1) & 1, sb = wave & 1; f32x16 wv = {};
          if (wave < 4) { wv = tile_mm<true, false>(wv, IMGP(I_ATR), sb, IMGP(I_G0), fb, L); st_tr(IMGP(I_W1TR), wv, sb, fb, L); }
          else { wv = tile_mm<true, false>(wv, IMGP(I_ZTR), sb, IMGP(I_G0), fb, L); st_tr(IMGP(I_W2TR), wv, sb, fb, L); }
        WBAR(); }
        WREP(5) { const int fb = (wave >> 1) & 1, sb = wave & 1; const int J = 32 * fb + L.r32;
          LAS unsigned char* SQ1 = IMGP(11); LAS unsigned char* SQ2 = IMGP(12); LAS unsigned char* SM = IMGP(13); LAS unsigned char* SN = IMGP(15);
          if (wave < 4) {
              f32x16 q = {}; q = tile_mm<true, false>(q, IMGP(I_W1TR), sb, IMGP(I_ARB), fb, L);
#pragma unroll
              for (int g = 0; g < 4; ++g) { const int c0 = 32 * sb + 8 * g + 4 * L.hi; const u32x2 rr = *(const LAS u32x2*)(IMGP(I_RT) + (((c0 >> 3) * 64 + J) * 16 + (c0 & 7) * 2));
                  u32x2 w; w.x = cvt_pk_bf16(q[4 * g] + bf_lo(rr.x), q[4 * g + 1] + bf_hi(rr.x)); w.y = cvt_pk_bf16(q[4 * g + 2] + bf_lo(rr.y), q[4 * g + 3] + bf_hi(rr.y));
                  *(LAS u32x2*)(SQ1 + J * 128 + (((c0 >> 3) ^ (J & 7)) * 16) + L.hi * 8) = w; }
              f32x16 q2 = {}; q2 = tile_mm<true, false>(q2, IMGP(I_W2TR), sb, IMGP(I_ARB), fb, L); q2 = tile_mm<true, false>(q2, IMGP(I_VTR), sb, IMGP(I_ARK), fb, L);
#pragma unroll
              for (int g = 0; g < 4; ++g) { const int c0 = 32 * sb + 8 * g + 4 * L.hi; u32x2 w; w.x = cvt_pk_bf16(q2[4 * g], q2[4 * g + 1]); w.y = cvt_pk_bf16(q2[4 * g + 2], q2[4 * g + 3]);
                  *(LAS u32x2*)(SQ2 + J * 128 + (((c0 >> 3) ^ (J & 7)) * 16) + L.hi * 8) = w; }
          } else {
              f32x16 m = {}; m = tile_mm<true, true>(m, IMGP(I_W1TR), sb, IMGP(I_BH), fb, L);
              const float pl = PLs[J];
#pragma unroll
              for (int g = 0; g < 4; ++g) { const int c0 = 32 * sb + 8 * g + 4 * L.hi; f32x4 o = (f32x4){m[4 * g], m[4 * g + 1], m[4 * g + 2], m[4 * g + 3]};
#pragma unroll
                  for (int jj = 0; jj < 4; ++jj) if (c0 + jj == J) o[jj] += pl;
                  *(LAS f32x4*)(SM + J * 256 + (((c0 >> 2) ^ (J & 15)) * 16)) = o; }
              f32x16 n = {}; n = tile_mm<true, true>(n, IMGP(I_W2TR), sb, IMGP(I_BH), fb, L); n = tile_mm<true, true>(n, IMGP(I_VTR), sb, IMGP(I_KH), fb, L);
#pragma unroll
              for (int g = 0; g < 4; ++g) { const int c0 = 32 * sb + 8 * g + 4 * L.hi; *(LAS f32x4*)(SN + J * 256 + (((c0 >> 2) ^ (J & 15)) * 16)) = (f32x4){n[4 * g], n[4 * g + 1], n[4 * g + 2], n[4 * g + 3]}; }
          }
          WBAR();
          { const int row = tid >> 3, qq = tid & 7; const int so = row * 128 + ((qq ^ (row & 7)) * 16); const size_t go = (size_t)ck * 4096 + (size_t)row * 64 + qq * 8;
            *(u32x4*)(WQ1 + go) = *(const LAS u32x4*)(SQ1 + so); *(u32x4*)(WQ2 + go) = *(const LAS u32x4*)(SQ2 + so); }
#pragma unroll
          for (int i = 0; i < 2; ++i) { const int idx = tid + 512 * i, row = idx >> 4, qq = idx & 15; const int so = row * 256 + ((qq ^ (row & 15)) * 16); const size_t go = (size_t)ck * 4096 + (size_t)row * 64 + qq * 4;
            *(f32x4*)(WM + go) = *(const LAS f32x4*)(SM + so); *(f32x4*)(WN + go) = *(const LAS f32x4*)(SN + so); }
        }
    }
#undef IMGP
}

constexpr int WB_S = 0;
constexpr int WB_CNT = 2 * 4352;
struct WBStage { f32x4 m0, m1, m2, m3, n; };
__device__ __forceinline__ void wb_load(WBStage& st, const float* WM, const float* WN, int ck, int wave, int j, int kk, int vq) {
    const float* mp = WM + (size_t)ck * 4096 + (size_t)(16 * wave + j) * 64 + 16 * kk;
    st.m0 = *(const f32x4*)(mp); st.m1 = *(const f32x4*)(mp + 4); st.m2 = *(const f32x4*)(mp + 8); st.m3 = *(const f32x4*)(mp + 12);
    st.n = *(const f32x4*)(WN + (size_t)ck * 4096 + (size_t)(16 * wave + j) * 64 + 16 * vq + 4 * kk);
}
__device__ __forceinline__ void wb_step(const WBStage& st, LAS float* Sl, LAS unsigned* cnt, bf16_t* WSB, int ck, int vq, int t256, int wave, int j, int kk, int step, bool pub) {
    const LAS float* Sin = Sl + (step & 1) * 1088; LAS float* Sout = Sl + ((step + 1) & 1) * 1088;
    if (pub) { const int v = t256 >> 4, c4 = (t256 & 15) * 4; const f32x4 sv = *(const LAS f32x4*)(Sin + v * 68 + c4); u32x2 w; w.x = cvt_pk_bf16(sv[0], sv[1]); w.y = cvt_pk_bf16(sv[2], sv[3]);
      *(u32x2*)(WSB + (size_t)ck * 4096 + (size_t)(16 * vq + v) * 64 + c4) = w; }
    f32x4 acc0 = st.n, acc1 = (f32x4){0.f, 0.f, 0.f, 0.f}; f32x4 sv[4];
#pragma unroll
    for (int q = 0; q < 4; ++q) sv[q] = *(const LAS f32x4*)(Sin + j * 68 + 16 * kk + 4 * q);
#define WB_2(SV, MV) acc0 = __builtin_amdgcn_mfma_f32_16x16x4f32(SV[0], MV[0], acc0, 0, 0, 0); acc1 = __builtin_amdgcn_mfma_f32_16x16x4f32(SV[1], MV[1], acc1, 0, 0, 0); \
                     acc0 = __builtin_amdgcn_mfma_f32_16x16x4f32(SV[2], MV[2], acc0, 0, 0, 0); acc1 = __builtin_amdgcn_mfma_f32_16x16x4f32(SV[3], MV[3], acc1, 0, 0, 0)
    WB_2(sv[0], st.m0); WB_2(sv[1], st.m1); WB_2(sv[2], st.m2); WB_2(sv[3], st.m3);
#undef WB_2
    acc0 = acc0 + acc1;
#pragma unroll
    for (int rg = 0; rg < 4; ++rg) Sout[(4 * kk + rg) * 68 + 16 * wave + j] = acc0[rg];
    asm volatile("s_waitcnt lgkmcnt(0)" ::: "memory");
    if ((t256 & 63) == 0) __hip_atomic_fetch_add(cnt, 1u, __ATOMIC_RELAXED, __HIP_MEMORY_SCOPE_WORKGROUP);
    const unsigned want = 4u * (unsigned)(step + 1);
    while (__hip_atomic_load(cnt, __ATOMIC_RELAXED, __HIP_MEMORY_SCOPE_WORKGROUP) < want) { }
    asm volatile("" ::: "memory");
}
__device__ __forceinline__ void wkv_phase_b(const Frame& F, const Args& a) {
    unsigned char* ws = a.ws; const float* WM = (const float*)(ws + WS_WM); const float* WN = (const float*)(ws + WS_WN); bf16_t* WSB = (bf16_t*)(ws + WS_WSB);
    LAS float* Sl = (LAS float*)(F.lds + WB_S); LAS unsigned* cnt = (LAS unsigned*)(F.lds + WB_CNT); const int lane = F.lane, wave = F.wave, tid = F.tid;
    __syncthreads();
    for (int i = tid; i < 2 * 1088; i += NTHR) Sl[i] = 0.f;
    if (tid == 0) *cnt = 0u;
    __syncthreads();
#ifndef WBREC_N
#define WBREC_N 1
#endif
#ifndef WBCONV_N
#define WBCONV_N 1
#endif
    if (wave < 4) {
        const int item = F.vcu; if (item < 256) {
        const int bh = item >> 2, vq = item & 3; const int j = lane & 15, kk = lane >> 4; const int ck0 = bh * 64;
        WBStage sA, sB, sC, sD;
        wb_load(sA, WM, WN, ck0 + 0, wave, j, kk, vq); wb_load(sB, WM, WN, ck0 + 1, wave, j, kk, vq); wb_load(sC, WM, WN, ck0 + 2, wave, j, kk, vq); wb_load(sD, WM, WN, ck0 + 3, wave, j, kk, vq);
#pragma unroll 1
        for (int ch = 0; ch < 64 * WBREC_N; ch += 4) {
#if WBREC_N > 1
            const int nx = (ch + 4) & 63, cc = ch & 63; const bool pub = ch < 64;
#else
            const int nx = (ch + 4 < 64) ? ch + 4 : 60, cc = ch; constexpr bool pub = true;
#endif
            { const WBStage cur = sA; wb_load(sA, WM, WN, ck0 + nx + 0, wave, j, kk, vq); wb_step(cur, Sl, cnt, WSB, ck0 + cc + 0, vq, tid, wave, j, kk, ch + 0, pub); }
            { const WBStage cur = sB; wb_load(sB, WM, WN, ck0 + nx + 1, wave, j, kk, vq); wb_step(cur, Sl, cnt, WSB, ck0 + cc + 1, vq, tid, wave, j, kk, ch + 1, pub); }
            { const WBStage cur = sC; wb_load(sC, WM, WN, ck0 + nx + 2, wave, j, kk, vq); wb_step(cur, Sl, cnt, WSB, ck0 + cc + 2, vq, tid, wave, j, kk, ch + 2, pub); }
            { const WBStage cur = sD; wb_load(sD, WM, WN, ck0 + nx + 3, wave, j, kk, vq); wb_step(cur, Sl, cnt, WSB, ck0 + cc + 3, vq, tid, wave, j, kk, ch + 3, pub); }
        } }
    } else {
        const int gwc = F.vcu * 4 + (wave - 4), NGWC = F.G * 4;
        unsigned char* WGU = ws + WS_WGU; unsigned char* WDN = ws + WS_WDN;
#pragma unroll 1
        for (int itx = WCV_A + gwc; itx < WCV_A + (WCV_NIT - WCV_A) * WBCONV_N; itx += NGWC) { const int it = WCV_A + (itx - WCV_A) % (WCV_NIT - WCV_A);
            CvtRegs R; wcv_load(R, a, it, lane); wcv_store(R, a, it, lane); }
        { LAS float* scr = (LAS float*)(F.lds + 16384 + (wave - 4) * 8448);
          bf16_t* WoaT = (bf16_t*)(ws + WS_WOA); bf16_t* WobT = (bf16_t*)(ws + WS_WOB); bf16_t* WoutT = (bf16_t*)(ws + WS_WOUT);
          for (int it = gwc; it < 256 + 256 + 512; it += NGWC) { int r = it;
              if (tr_try(r, a.in[14], 512, 1024, WoaT, 512, 0, 0, scr, lane)) continue;
              if (tr_try(r, a.in[26], 512, 1024, WobT, 512, 0, 0, scr, lane)) continue;
              tr_try(r, a.in[27], 1024, 1024, WoutT, 1024, 0, 0, scr, lane); } }
    }
}

__device__ __forceinline__ void wkv_phase_c(const Frame& F, const Args& a) {
    unsigned char* ws = a.ws; const bf16_t* WQ1 = (const bf16_t*)(ws + WS_WQ1); const bf16_t* WQ2 = (const bf16_t*)(ws + WS_WQ2); const bf16_t* WSB = (const bf16_t*)(ws + WS_WSB); const float* WBS = (const float*)(ws + WS_WBS);
    const bf16_t* WVL = (const bf16_t*)(ws + WS_WVL); const bf16_t* GG = (const bf16_t*)(ws + WS_GG); bf16_t* OB = (bf16_t*)(ws + WS_OBIN); const float* ln_w = a.in[24]; const float* ln_b = a.in[25];
    const int gw = F.vcu * NWAVES + F.wave, NGW = F.G * NWAVES, lane = F.lane, r32 = lane & 31, hi = lane >> 5;
    __syncthreads();
    for (int u = gw; u < 8192; u += NGW) {
        const int ck = u >> 1, tb = u & 1, bh = ck >> 6, ch = ck & 63, b = bh >> 3, h = bh & 7; const int tl = 32 * tb + r32; const size_t tg = (size_t)b * SEQ + ch * 64 + tl;
        const bf16_t* sp = WSB + (size_t)ck * 4096; const bf16_t* qp = WQ1 + (size_t)ck * 4096 + (size_t)tl * 64; f32x16 y0 = {}, y1 = {};
#pragma unroll
        for (int d0 = 0; d0 < 4; ++d0) { const bf16x8 bq = *(const bf16x8*)(qp + 16 * d0 + 8 * hi); const bf16x8 a0 = *(const bf16x8*)(sp + (size_t)r32 * 64 + 16 * d0 + 8 * hi), a1 = *(const bf16x8*)(sp + (size_t)(32 + r32) * 64 + 16 * d0 + 8 * hi);
            y0 = __builtin_amdgcn_mfma_f32_32x32x16_bf16(a0, bq, y0, 0, 0, 0); y1 = __builtin_amdgcn_mfma_f32_32x32x16_bf16(a1, bq, y1, 0, 0, 0); }
        LAS unsigned char* stg = F.lds + F.wave * 8192;
#pragma unroll
        for (int g = 0; g < 4; ++g) { const int c16 = 2 * g + hi;
            *(LAS f32x4*)(stg + r32 * 256 + ((c16 ^ (r32 & 15)) * 16)) = (f32x4){y0[4 * g], y0[4 * g + 1], y0[4 * g + 2], y0[4 * g + 3]};
            *(LAS f32x4*)(stg + r32 * 256 + (((8 + c16) ^ (r32 & 15)) * 16)) = (f32x4){y1[4 * g], y1[4 * g + 1], y1[4 * g + 2], y1[4 * g + 3]}; }
        asm volatile("s_waitcnt lgkmcnt(0)" ::: "memory");
        const int c8 = lane & 7; float lw[8], lb[8]; ld8f(ln_w + h * 64 + 8 * c8, lw); ld8f(ln_b + h * 64 + 8 * c8, lb);
        const size_t tg0 = (size_t)b * SEQ + ch * 64 + 32 * tb;
        u32x4 q2r[4], vvr[4], ggr[4]; float bsr[4];
#pragma unroll
        for (int i = 0; i < 4; ++i) { const int tok = (lane >> 3) + 8 * i; const size_t tg = tg0 + tok;
            q2r[i] = *(const u32x4*)(WQ2 + (size_t)ck * 4096 + (size_t)(32 * tb + tok) * 64 + 8 * c8);
            vvr[i] = *(const u32x4*)(WVL + tg * 512 + h * 64 + 8 * c8); ggr[i] = *(const u32x4*)(GG + tg * 512 + h * 64 + 8 * c8); bsr[i] = WBS[tg * 8 + h]; }
#pragma unroll
        for (int i = 0; i < 4; ++i) { const int tok = (lane >> 3) + 8 * i; const size_t tg = tg0 + tok;
            const f32x4 ya = *(const LAS f32x4*)(stg + tok * 256 + (((2 * c8) ^ (tok & 15)) * 16)), yb = *(const LAS f32x4*)(stg + tok * 256 + (((2 * c8 + 1) ^ (tok & 15)) * 16));
            float y[8], q2[8], vv[8], gg[8]; up8(q2r[i], q2); up8(vvr[i], vv); up8(ggr[i], gg);
#pragma unroll
            for (int k = 0; k < 4; ++k) { y[k] = ya[k] + q2[k]; y[4 + k] = yb[k] + q2[4 + k]; }
            float sm = 0.f;
#pragma unroll
            for (int k = 0; k < 8; ++k) sm += y[k];
            const float mean = sum8(sm) * (1.f / 64.f); float vs = 0.f;
#pragma unroll
            for (int k = 0; k < 8; ++k) { y[k] -= mean; vs += y[k] * y[k]; }
            const float rstd = rsqrtf(sum8(vs) * (1.f / 64.f) + 64e-5f); float o[8];
#pragma unroll
            for (int k = 0; k < 8; ++k) o[k] = (y[k] * rstd * lw[k] + lb[k] + bsr[i] * vv[k]) * gg[k];
            st8bf(OB + tg * 512 + h * 64 + 8 * c8, o); }
        asm volatile("s_waitcnt lgkmcnt(0)" ::: "memory");
    }
}
}

#ifndef REPMASK
#define REPMASK 0
#endif
#ifndef REPN
#define REPN 1
#endif
namespace fk {
#define LDSW() asm volatile("s_waitcnt lgkmcnt(0)" ::: "memory")

__device__ __forceinline__ void phase_p0b(const Frame& F, const Args& a, int it0, int stride, int it_end, int scr_off, bool tail) {
    unsigned char* ws = a.ws;
    LAS float* scr = (LAS float*)(F.lds + scr_off);
    const int gw = F.vcu * NWAVES + F.wave, NGW = F.G * NWAVES;
    const int gthread = gw * 64 + F.lane, nthreads = NGW * 64;
    bf16_t* WinT = (bf16_t*)(ws + WS_WIN); bf16_t* WqT = (bf16_t*)(ws + WS_WQ); bf16_t* WkvT = (bf16_t*)(ws + WS_WKV); bf16_t* WloT = (bf16_t*)(ws + WS_WLORA);
    bf16_t* WoaT = (bf16_t*)(ws + WS_WOA); bf16_t* WobT = (bf16_t*)(ws + WS_WOB); bf16_t* WoutT = (bf16_t*)(ws + WS_WOUT);
    constexpr int I_IN = 16 * 133;
    constexpr int NITEMS = I_IN + 96 + 64 + 16 + 16 + 32;
    for (int it = it0; it < (it_end < NITEMS ? it_end : NITEMS); it += stride) {
        int r = it;
        if (r < I_IN) { const int kb = r / 133, nb = r % 133; transpose_item(a.in[7], 4256, WinT, 1024, 0, (nb >= 13) ? 96 : 0, scr, kb, nb, F.lane); continue; } r -= I_IN;
        if (tr_try(r, a.in[9], 256, 768, WqT, 256, 0, 0, scr, F.lane)) continue;
        if (tr_try(r, a.in[11], 128, 1024, WkvT, 256, 0, 0, scr, F.lane)) continue;
        if (tr_try(r, a.in[17], 64, 512, WloT, 256, 0, 0, scr, F.lane)) continue;
        if (tr_try(r, a.in[19], 64, 512, WloT, 256, 64, 512, scr, F.lane)) continue;
        tr_try(r, a.in[20], 128, 512, WloT, 256, 128, 1024, scr, F.lane);
    }
    if (!tail) return;
    zero_block(WinT, 1024, 416, 96, 0, 1024, gthread, nthreads);
    zero_block(WkvT, 256, 0, 1024, 128, 256, gthread, nthreads);
    zero_block(WloT, 256, 0, 512, 64, 256, gthread, nthreads);
    zero_block(WloT, 256, 512, 512, 0, 64, gthread, nthreads);
    zero_block(WloT, 256, 512, 512, 128, 256, gthread, nthreads);
    zero_block(WloT, 256, 1024, 512, 0, 128, gthread, nthreads);
    const int* pos = (const int*)a.in[2]; float* ROPE = (float*)(ws + WS_ROPE);
    for (int i = gthread; i < T * 16; i += nthreads) { const int t = i >> 4, j = i & 15; const float inv = powf(10000.f, -(float)j / 16.f); const float ang = (float)pos[t] * inv;
        ROPE[(size_t)t * 32 + j] = cosf(ang); ROPE[(size_t)t * 32 + 16 + j] = sinf(ang); }
}

__device__ __forceinline__ void phase_p0(const Frame& F, const Args& a) {
    unsigned char* ws = a.ws; const float* c = a.in[1]; const float* ada_w = a.in[3]; float* MODP = (float*)(ws + WS_MODP);
    const int gw = F.vcu * NWAVES + F.wave, NGW = F.G * NWAVES;
    LAS float* SC = (LAS float*)F.lds;
    for (int i = F.tid; i < 8 * 1024; i += NTHR) { const float cv = c[i]; SC[i] = cv * fsigmoid(cv); }
    __syncthreads();
    for (int it = gw; it < 96 * 16; it += NGW) {
        const int cg = it % 96, ks = it / 96; const int n = cg * 64 + F.lane;
        float acc[8];
#pragma unroll
        for (int b = 0; b < 8; ++b) acc[b] = 0.f;
#pragma unroll 1
        for (int k0 = ks * 64; k0 < ks * 64 + 64; k0 += 16) { float w[16];
#pragma unroll
            for (int i = 0; i < 16; ++i) w[i] = ada_w[(size_t)(k0 + i) * 6144 + n];
#pragma unroll
            for (int i = 0; i < 16; ++i)
#pragma unroll
                for (int b = 0; b < 8; ++b) acc[b] += SC[b * 1024 + k0 + i] * w[i]; }
#pragma unroll
        for (int b = 0; b < 8; ++b) MODP[((size_t)ks * 8 + b) * 6144 + n] = acc[b];
    }
    if (NGW == 2048 && gw >= 1536) phase_p0b(F, a, gw - 1536, 512, 1024, 32768 + F.wave * 8448, false);
}

__device__ __forceinline__ void load_row16(const float* xr, int lane, f32x4 (&v)[4]) {
#pragma unroll
    for (int j = 0; j < 4; ++j) v[j] = *(const f32x4*)(xr + 4 * lane + 256 * j);
}
__device__ __forceinline__ void phase_p1(const Frame& F, const Args& a) {
    unsigned char* ws = a.ws; const float* MODP = (const float*)(ws + WS_MODP); float* MOD = (float*)(ws + WS_MOD); const float* ada_b = a.in[4];
    const int wg = F.vcu;
    if (F.tid < 192) { const int i = wg * 192 + F.tid; const int b = i / 6144, n = i % 6144; float s = ada_b[n];
#pragma unroll
        for (int ks = 0; ks < 16; ++ks) s += MODP[((size_t)ks * 8 + b) * 6144 + n];
        MOD[i] = s; }
    const int b = (wg * 128) >> 12; LAS float* LA = (LAS float*)F.lds; LAS float* LB = LA + 1024; const float* nw = a.in[5];
    for (int i = F.tid; i < 1024; i += NTHR) { float sh = ada_b[i], sc = ada_b[1024 + i];
#pragma unroll
        for (int ks = 0; ks < 16; ++ks) { sh += MODP[((size_t)ks * 8 + b) * 6144 + i]; sc += MODP[((size_t)ks * 8 + b) * 6144 + 1024 + i]; }
        LA[i] = nw[i] * (1.f + sc); LB[i] = sh; }
    __syncthreads();
    const float* x = a.in[0]; bf16_t* H = (bf16_t*)(ws + WS_H);
    for (int rr = 0; rr < 16; rr += 4) { const int row = wg * 128 + F.wave * 16 + rr; f32x4 v[4][4];
#pragma unroll
        for (int q = 0; q < 4; ++q) load_row16(x + (size_t)(row + q) * 1024, F.lane, v[q]);
#pragma unroll
        for (int q = 0; q < 4; ++q) { float ss = 0.f;
#pragma unroll
            for (int j = 0; j < 4; ++j) ss += (v[q][j][0] * v[q][j][0] + v[q][j][1] * v[q][j][1]) + (v[q][j][2] * v[q][j][2] + v[q][j][3] * v[q][j][3]);
            const float rstd = rsqrtf(wave_sum(ss) * (1.f / 1024.f) + 1e-6f);
#pragma unroll
            for (int j = 0; j < 4; ++j) { const f32x4 A = *(const LAS f32x4*)(LA + 4 * F.lane + 256 * j), B = *(const LAS f32x4*)(LB + 4 * F.lane + 256 * j); const f32x4 o = v[q][j] * rstd * A + B;
                u32x2 w; w.x = cvt_pk_bf16(o[0], o[1]); w.y = cvt_pk_bf16(o[2], o[3]); *(u32x2*)(H + (size_t)(row + q) * 1024 + 4 * F.lane + 256 * j) = w; } } }
    __syncthreads();
    { const int gw_ = F.vcu * NWAVES + F.wave, NGW_ = F.G * NWAVES; const int first = (NGW_ == 2048) ? 1024 : 0;
      phase_p0b(F, a, first + gw_, NGW_, 1 << 30, F.wave * 16384, true); }
}

__device__ __forceinline__ void phase_p3(const Frame& F, const Args& a) {
    unsigned char* ws = a.ws; const bf16_t* PS = (const bf16_t*)(ws + WS_PS); bf16_t* AQ = (bf16_t*)(ws + WS_AQ); bf16_t* AKV = (bf16_t*)(ws + WS_AKV); bf16_t* AL = (bf16_t*)(ws + WS_ALORA);
    const float* qaw = a.in[8]; const float* kvaw = a.in[10]; const float* mu = a.in[15];
    const int gw = F.vcu * NWAVES + F.wave, NGW = F.G * NWAVES, l = F.lane;
    const f32x4 wq = *(const f32x4*)(qaw + 4 * l); const f32x4 wkv = (l < 32) ? *(const f32x4*)(kvaw + 4 * l) : (f32x4){0.f, 0.f, 0.f, 0.f}; const f32x4 mul = *(const f32x4*)(mu + 1536 + 4 * l);
    for (int t0 = gw; t0 < T; t0 += 2 * NGW) {
        f32x4 cq[2], ck[2], cur[2], prv[2];
#pragma unroll
        for (int u = 0; u < 2; ++u) { const int t = t0 + u * NGW; const bf16_t* ps = PS + (size_t)t * NPS;
            cq[u] = ld4bf(ps + 4 * l); ck[u] = (l < 32) ? ld4bf(ps + 256 + 4 * l) : (f32x4){0.f, 0.f, 0.f, 0.f};
            cur[u] = ld4bf(ps + 2048 + 4 * l); prv[u] = ((t & (SEQ - 1)) != 0) ? ld4bf(ps - NPS + 2048 + 4 * l) : (f32x4){0.f, 0.f, 0.f, 0.f}; }
#pragma unroll
        for (int u = 0; u < 2; ++u) { const int t = t0 + u * NGW;
            const float sq = wave_sum((cq[u][0] * cq[u][0] + cq[u][1] * cq[u][1]) + (cq[u][2] * cq[u][2] + cq[u][3] * cq[u][3]));
            const float sk = wave_sum((ck[u][0] * ck[u][0] + ck[u][1] * ck[u][1]) + (ck[u][2] * ck[u][2] + ck[u][3] * ck[u][3]));
            const float rq = rsqrtf(sq * (1.f / 256.f) + 1e-6f), rk = rsqrtf(sk * (1.f / 128.f) + 1e-6f);
            st4bf(AQ + (size_t)t * 256 + 4 * l, cq[u] * rq * wq); st4bf(AKV + (size_t)t * 256 + 4 * l, ck[u] * rk * wkv);
            f32x4 p = cur[u] + (prv[u] - cur[u]) * mul;
            if (l < 16) { const f32x4 s2 = sig4(p * 2.f); p = s2 * 2.f - 1.f; } else if (l >= 32) { p = sig4(p); }
            st4bf(AL + (size_t)t * 256 + 4 * l, p); }
    }
}

struct P5Raw { u32x4 k8; unsigned ka, kb; float cs0, cs1, sn0, sn1; };
__device__ __forceinline__ void p5_load(P5Raw& R, int t, int h, int j, const bf16_t* QRAW, const bf16_t* KVRAW, const bf16_t* PS, const float* ROPE) {
    R.k8 = *(const u32x4*)(KVRAW + (size_t)t * 1024 + h * 128 + 8 * j); R.ka = *(const unsigned*)(PS + (size_t)t * NPS + 384 + 2 * j); R.kb = *(const unsigned*)(PS + (size_t)t * NPS + 400 + 2 * j);
    const f32x2 cc = *(const f32x2*)(ROPE + (size_t)t * 32 + 2 * j), sn = *(const f32x2*)(ROPE + (size_t)t * 32 + 16 + 2 * j); R.cs0 = cc[0]; R.cs1 = cc[1]; R.sn0 = sn[0]; R.sn1 = sn[1];
}
__device__ __forceinline__ void p5_norm_rope(u32x4 raw8, unsigned ra, unsigned rb, const float (&w8)[8], float wr0, float wr1, float wr2, float wr3, float scale, const P5Raw& R, float (&x)[8], unsigned& o1, unsigned& o2) {
    up8(raw8, x); float x10 = bf_lo(ra), x11 = bf_hi(ra), x20 = bf_lo(rb), x21 = bf_hi(rb); float ss = x10 * x10 + x11 * x11 + x20 * x20 + x21 * x21;
#pragma unroll
    for (int i = 0; i < 8; ++i) ss += x[i] * x[i];
    const float rr = rsqrtf(sum8(ss) * (1.f / 96.f) + 1e-6f) * scale;
#pragma unroll
    for (int i = 0; i < 8; ++i) x[i] = x[i] * rr * w8[i];
    x10 *= rr * wr0; x11 *= rr * wr1; x20 *= rr * wr2; x21 *= rr * wr3;
    o1 = cvt_pk_bf16(x10 * R.cs0 - x20 * R.sn0, x11 * R.cs1 - x21 * R.sn1); o2 = cvt_pk_bf16(x20 * R.cs0 + x10 * R.sn0, x21 * R.cs1 + x11 * R.sn1);
}
__device__ __forceinline__ void phase_p5(const Frame& F, const Args& a) {
    unsigned char* ws = a.ws; const bf16_t* PS = (const bf16_t*)(ws + WS_PS); const bf16_t* QRAW = (const bf16_t*)(ws + WS_QRAW); const bf16_t* KVRAW = (const bf16_t*)(ws + WS_KVRAW); const float* ROPE = (const float*)(ws + WS_ROPE);
    bf16_t* Qo = (bf16_t*)(ws + WS_Q); bf16_t* Ko = (bf16_t*)(ws + WS_K); bf16_t* Vo = (bf16_t*)(ws + WS_V);
    const float* qnw = a.in[12]; const float* knw = a.in[13];
    const int gw = F.vcu * NWAVES + F.wave, NGW = F.G * NWAVES, l = F.lane, kl = l >> 3, j = l & 7;
    float qw[8], kw[8]; ld8f(qnw + 8 * j, qw); ld8f(knw + 8 * j, kw);
    const float qwr0 = qnw[64 + 2 * j], qwr1 = qnw[65 + 2 * j], qwr2 = qnw[80 + 2 * j], qwr3 = qnw[81 + 2 * j];
    const float kwr0 = knw[64 + 2 * j], kwr1 = knw[65 + 2 * j], kwr2 = knw[80 + 2 * j], kwr3 = knw[81 + 2 * j];
    for (int i0 = gw; i0 < T; i0 += 2 * NGW) {
        P5Raw R[2];
#pragma unroll
        for (int u = 0; u < 2; ++u) { const int it = i0 + u * NGW; p5_load(R[u], (it >> 3) * 8 + kl, it & 7, j, QRAW, KVRAW, PS, ROPE); }
#pragma unroll
        for (int u = 0; u < 2; ++u) { const int it = i0 + u * NGW; const int t = (it >> 3) * 8 + kl, h = it & 7; const int b = t >> 12, s = t & (SEQ - 1), bh = b * 8 + h, key = s & 63, tile = s >> 6;
            float x[8]; unsigned o1, o2;
            p5_norm_rope(R[u].k8, R[u].ka, R[u].kb, kw, kwr0, kwr1, kwr2, kwr3, 1.f, R[u], x, o1, o2);
            bf16_t* kt = Ko + ((size_t)bh * 64 + tile) * 6144; st8bf(kt + j * 512 + key * 8, x);
            *(unsigned*)(kt + (8 + (j >> 2)) * 512 + key * 8 + ((2 * j) & 7)) = o1; *(unsigned*)(kt + (10 + (j >> 2)) * 512 + key * 8 + ((2 * j) & 7)) = o2;
            }
    }
}

__device__ __forceinline__ void phase_p6b(const Frame& F, const Args& a) {
    unsigned char* ws = a.ws; const float* Y = (const float*)(ws + WS_Y); const bf16_t* SIN = (const bf16_t*)(ws + WS_SCANIN); const bf16_t* GG = (const bf16_t*)(ws + WS_GG); bf16_t* OB = (bf16_t*)(ws + WS_OBIN);
    const float* r_k = a.in[23]; const float* ln_w = a.in[24]; const float* ln_b = a.in[25];
    const int gw = F.vcu * NWAVES + F.wave, NGW = F.G * NWAVES, l = F.lane, h = l >> 3, j = l & 7, c0 = h * 64 + 8 * j;
    float rkc[8], lw[8], lb[8]; ld8f(r_k + c0, rkc); ld8f(ln_w + c0, lw); ld8f(ln_b + c0, lb);
    for (int t = gw; t < T; t += NGW) {
        const int b = t >> 12, s = t & (SEQ - 1), bh = b * 8 + h;
        float y[8], r[8], kp[8], v[8], g[8]; ld8f(Y + (size_t)t * 512 + c0, y);
        const bf16_t* si = SIN + ((size_t)bh * SEQ + s) * 384 + 8 * j; ld8bf(si, r); ld8bf(si + 128, kp); ld8bf(si + 192, v); ld8bf(GG + (size_t)t * 512 + c0, g);
        float sm = 0.f, bs = 0.f;
#pragma unroll
        for (int i = 0; i < 8; ++i) { sm += y[i]; bs += r[i] * kp[i] * rkc[i]; }
        const float mean = sum8(sm) * (1.f / 64.f); bs = sum8(bs); float vs = 0.f;
#pragma unroll
        for (int i = 0; i < 8; ++i) { y[i] -= mean; vs += y[i] * y[i]; }
        const float rstd = rsqrtf(sum8(vs) * (1.f / 64.f) + 64e-5f); float o[8];
#pragma unroll
        for (int i = 0; i < 8; ++i) o[i] = (y[i] * rstd * lw[i] + lb[i] + bs * v[i]) * g[i];
        st8bf(OB + (size_t)t * 512 + c0, o);
    }
}

constexpr int P9_AS = 4608;
constexpr int P9_A = 0;
constexpr int P9_BS = 9216;
constexpr int P9_B = 8 * P9_AS;
constexpr int P9_LG = P9_B + 2 * P9_BS;
constexpr int P9_AB = P9_LG + 8 * 2112;
constexpr int P9_H = P9_AB + 8192;
__device__ __forceinline__ void phase_p9(const Frame& F, const Args& a) {
    unsigned char* ws = a.ws; const float* MOD = (const float*)(ws + WS_MOD); const bf16_t* x1 = (const bf16_t*)(ws + WS_X1B); unsigned char* H8 = ws + WS_H;
    int* TOPE = (int*)(ws + WS_TOPE); float* TOPW = (float*)(ws + WS_TOPW); int* HIST = (int*)(ws + WS_HIST);
    const float* nw = a.in[6]; const float* wr = a.in[28]; const float* br = a.in[29];
    const int wg = F.vcu, b = (wg * 128) >> 12, l = F.lane, wave = F.wave, tid = F.tid;
    LAS float* LAt = (LAS float*)(F.lds + P9_A + wave * P9_AS); LAS unsigned char* LAb = F.lds + P9_A + wave * P9_AS; LAS unsigned char* LBb = F.lds + P9_B; LAS float* LG = (LAS float*)(F.lds + P9_LG) + wave * 528;
    LAS float* LA = (LAS float*)(F.lds + P9_AB); LAS float* LB = LA + 1024; LAS int* LH = (LAS int*)(F.lds + P9_H);
    for (int i = tid; i < 1024; i += NTHR) { LA[i] = nw[i] * (1.f + MOD[(size_t)b * 6144 + 4 * 1024 + i]); LB[i] = MOD[(size_t)b * 6144 + 3 * 1024 + i]; }
    if (tid < 32) LH[tid] = 0;
    const int bk = tid >> 3, be = (tid & 7) * 4;
#define P9_STAGE_B(buf, w) do { _Pragma("unroll") for (int i_ = 0; i_ < 4; ++i_) { const unsigned hi_ = cvt_pk_bf16((w)[i_], 0.f) & 0xffffu; const unsigned lo_ = cvt_pk_bf16((w)[i_] - __uint_as_float(hi_ << 16), 0.f) & 0xffffu; \
        LAS unsigned short* d_ = (LAS unsigned short*)(LBb + (buf) * P9_BS + (be + i_) * 144 + bk * 2); d_[0] = (unsigned short)hi_; d_[2304] = (unsigned short)lo_; } } while (0)
    { const f32x4 w = *(const f32x4*)(wr + (size_t)bk * 32 + be); P9_STAGE_B(0, w); }
    const int r = l >> 2, q = l & 3; const int row0 = wg * 128 + wave * 16; const bf16_t* xr = x1 + (size_t)(row0 + r) * 1024;
    {
#pragma unroll 16
        for (int rr = 0; rr < 16; ++rr) { const bf16_t* xp = x1 + (size_t)(row0 + rr) * 1024 + 8 * l; float va[8], vb[8]; ld8bf(xp, va); ld8bf(xp + 512, vb); float s = 0.f;
#pragma unroll
            for (int i = 0; i < 8; ++i) s += va[i] * va[i] + vb[i] * vb[i];
            LAt[rr * 64 + l] = s; }
        asm volatile("s_waitcnt lgkmcnt(0)" ::: "memory");
    }
    float ss = 0.f;
#pragma unroll
    for (int i = 0; i < 4; ++i) { const f32x4 p = *(const LAS f32x4*)(LAt + r * 64 + 16 * q + 4 * i); ss += (p[0] + p[1]) + (p[2] + p[3]); }
    ss += __shfl_xor(ss, 1); ss += __shfl_xor(ss, 2);
    const float rstd = rsqrtf(ss * (1.f / 1024.f) + 1e-6f);
    __syncthreads();
    f32x4 acc0 = {0.f, 0.f, 0.f, 0.f}, acc1 = {0.f, 0.f, 0.f, 0.f};
    const int mi = l & 15, mk = l >> 4;
    u32x4 xv[2];
#pragma unroll
    for (int i = 0; i < 2; ++i) xv[i] = *(const u32x4*)(xr + 16 * q + 8 * i);
    for (int sl = 0; sl < 16; ++sl) {
        f32x4 wn; u32x4 xn[2]; if (sl + 1 < 16) { wn = *(const f32x4*)(wr + (size_t)((sl + 1) * 64 + bk) * 32 + be);
#pragma unroll
            for (int i = 0; i < 2; ++i) xn[i] = *(const u32x4*)(xr + 64 * (sl + 1) + 16 * q + 8 * i); }
        { const int kb0 = 64 * sl + 16 * q; unsigned char* ho = H8 + (size_t)(row0 + r) * 1024 + kb0; u32x4 pk; u32x4 hw[2], lw[2];
#pragma unroll
          for (int i = 0; i < 4; ++i) { const unsigned w0_ = xv[i >> 1][2 * (i & 1)], w1_ = xv[i >> 1][2 * (i & 1) + 1]; const f32x4 v = (f32x4){bf_lo(w0_), bf_hi(w0_), bf_lo(w1_), bf_hi(w1_)}; const f32x4 A = *(const LAS f32x4*)(LA + kb0 + 4 * i), B = *(const LAS f32x4*)(LB + kb0 + 4 * i); const f32x4 hv = v * rstd * A + B;
              const unsigned h0 = cvt_pk_bf16(hv[0], hv[1]), h1 = cvt_pk_bf16(hv[2], hv[3]);
              hw[i >> 1][2 * (i & 1)] = h0; hw[i >> 1][2 * (i & 1) + 1] = h1;
              lw[i >> 1][2 * (i & 1)] = cvt_pk_bf16(hv[0] - bf_lo(h0), hv[1] - bf_hi(h0)); lw[i >> 1][2 * (i & 1) + 1] = cvt_pk_bf16(hv[2] - bf_lo(h1), hv[3] - bf_hi(h1));
              unsigned w8 = 0u; w8 = __builtin_amdgcn_cvt_pk_fp8_f32(hv[0], hv[1], w8, false); w8 = __builtin_amdgcn_cvt_pk_fp8_f32(hv[2], hv[3], w8, true); pk[i] = w8; }
          *(u32x4*)ho = pk;
          LAS unsigned char* ad = LAb + r * 144 + 32 * q; *(LAS u32x4*)ad = hw[0]; *(LAS u32x4*)(ad + 16) = hw[1]; *(LAS u32x4*)(ad + 2304) = lw[0]; *(LAS u32x4*)(ad + 2304 + 16) = lw[1]; }
        asm volatile("s_waitcnt lgkmcnt(0)" ::: "memory");
        { const LAS unsigned char* ab = LAb + mi * 144 + 16 * mk; const LAS unsigned char* bb = LBb + (sl & 1) * P9_BS + mi * 144 + 16 * mk;
#pragma unroll
          for (int s = 0; s < 2; ++s) { const bf16x8 ah = *(const LAS bf16x8*)(ab + 64 * s), al = *(const LAS bf16x8*)(ab + 2304 + 64 * s);
              const bf16x8 b0h = *(const LAS bf16x8*)(bb + 64 * s), b0l = *(const LAS bf16x8*)(bb + 4608 + 64 * s), b1h = *(const LAS bf16x8*)(bb + 16 * 144 + 64 * s), b1l = *(const LAS bf16x8*)(bb + 4608 + 16 * 144 + 64 * s);
              acc0 = __builtin_amdgcn_mfma_f32_16x16x32_bf16(ah, b0h, acc0, 0, 0, 0); acc1 = __builtin_amdgcn_mfma_f32_16x16x32_bf16(ah, b1h, acc1, 0, 0, 0);
              acc0 = __builtin_amdgcn_mfma_f32_16x16x32_bf16(ah, b0l, acc0, 0, 0, 0); acc1 = __builtin_amdgcn_mfma_f32_16x16x32_bf16(ah, b1l, acc1, 0, 0, 0);
              acc0 = __builtin_amdgcn_mfma_f32_16x16x32_bf16(al, b0h, acc0, 0, 0, 0); acc1 = __builtin_amdgcn_mfma_f32_16x16x32_bf16(al, b1h, acc1, 0, 0, 0); } }
        asm volatile("s_waitcnt lgkmcnt(0)" ::: "memory");
        if (sl + 1 < 16) { P9_STAGE_B((sl + 1) & 1, wn);
#pragma unroll
            for (int i = 0; i < 2; ++i) xv[i] = xn[i]; }
        WBAR();
    }
#undef P9_STAGE_B
#pragma unroll
    for (int rg = 0; rg < 4; ++rg) { LG[(4 * mk + rg) * 33 + mi] = acc0[rg] + br[mi]; LG[(4 * mk + rg) * 33 + 16 + mi] = acc1[rg] + br[16 + mi]; }
    asm volatile("s_waitcnt lgkmcnt(0)" ::: "memory");
    if (l < 16) { const int row = row0 + l; float lg[32];
#pragma unroll
        for (int e = 0; e < 32; ++e) lg[e] = LG[l * 33 + e];
        unsigned taken = 0u; int ie0 = 0, ie1 = 0, ie2 = 0, ie3 = 0; float ve0 = 0.f, ve1 = 0.f, ve2 = 0.f, ve3 = 0.f;
#pragma unroll
        for (int k = 0; k < 4; ++k) { int bi = 0; float bv = -INFINITY;
#pragma unroll
            for (int e = 0; e < 32; ++e) { const bool ok = !((taken >> e) & 1u) && (lg[e] > bv); bv = ok ? lg[e] : bv; bi = ok ? e : bi; }
            taken |= 1u << bi;
            if (k == 0) { ie0 = bi; ve0 = bv; } else if (k == 1) { ie1 = bi; ve1 = bv; } else if (k == 2) { ie2 = bi; ve2 = bv; } else { ie3 = bi; ve3 = bv; } }
        const float p1 = __expf(ve1 - ve0), p2 = __expf(ve2 - ve0), p3 = __expf(ve3 - ve0); const float inv = 1.f / (1.f + p1 + p2 + p3);
        *(int4*)(TOPE + (size_t)row * 4) = make_int4(ie0, ie1, ie2, ie3); *(float4*)(TOPW + (size_t)row * 4) = make_float4(inv, p1 * inv, p2 * inv, p3 * inv);
        __hip_atomic_fetch_add(&LH[ie0], 1, __ATOMIC_RELAXED, __HIP_MEMORY_SCOPE_WORKGROUP); __hip_atomic_fetch_add(&LH[ie1], 1, __ATOMIC_RELAXED, __HIP_MEMORY_SCOPE_WORKGROUP);
        __hip_atomic_fetch_add(&LH[ie2], 1, __ATOMIC_RELAXED, __HIP_MEMORY_SCOPE_WORKGROUP); __hip_atomic_fetch_add(&LH[ie3], 1, __ATOMIC_RELAXED, __HIP_MEMORY_SCOPE_WORKGROUP); }
    __syncthreads();
    if (tid < 32) HIST[wg * 32 + tid] = LH[tid];
}

__device__ __forceinline__ void phase_p10(const Frame& F, const Args& a) {
    unsigned char* ws = a.ws; const int* HIST = (const int*)(ws + WS_HIST); const int* TOPE = (const int*)(ws + WS_TOPE); const float* TOPW = (const float*)(ws + WS_TOPW);
    int* TOKSLOT = (int*)(ws + WS_TOKSLOT); int* ROWTOK = (int*)(ws + WS_ROWTOK); float* ROWW = (float*)(ws + WS_ROWW); int* TPRE = (int*)(ws + WS_TPRE);
    LAS int* Lcnt = (LAS int*)F.lds; LAS int* Lbase = Lcnt + 32; LAS int* Lpad = Lbase + 32; LAS int* Lrun = Lpad + 33; LAS int* Lred = Lrun + 32;
    const int wg = F.vcu;
    { const int e = F.tid & 31, w0 = F.tid >> 5; int tot = 0, bas = 0;
#pragma unroll 8
      for (int w = w0; w < F.G; w += 16) { const int c = HIST[w * 32 + e]; tot += c; bas += (w < wg) ? c : 0; }
      Lred[w0 * 64 + e] = tot; Lred[w0 * 64 + 32 + e] = bas; }
    __syncthreads();
    if (F.tid < 32) { int tot = 0, bas = 0;
#pragma unroll
        for (int w = 0; w < 16; ++w) { tot += Lred[w * 64 + F.tid]; bas += Lred[w * 64 + 32 + F.tid]; }
        Lcnt[F.tid] = tot; Lbase[F.tid] = bas; Lrun[F.tid] = 0; }
    __syncthreads();
    if (F.tid < 64) {
        const int e = F.tid; const int v = (e < 32) ? ((Lcnt[e] + 255) >> 8) : 0; int inc = v;
#pragma unroll
        for (int off = 1; off < 32; off <<= 1) { const int t = __shfl_up(inc, off); if (e >= off) inc += t; }
        if (e < 32) Lpad[e] = inc - v;
        if (e == 31) Lpad[32] = inc; }
    __syncthreads();
    if (wg == 0 && F.tid < 33) TPRE[F.tid] = Lpad[F.tid];
    { const int row = wg * 128 + (F.tid >> 2), k = F.tid & 3; const int e = TOPE[(size_t)row * 4 + k]; const float w = TOPW[(size_t)row * 4 + k];
      const int rank = __hip_atomic_fetch_add(&Lrun[e], 1, __ATOMIC_RELAXED, __HIP_MEMORY_SCOPE_WORKGROUP); const int slot = Lpad[e] * 256 + Lbase[e] + rank;
      ROWTOK[slot] = row; ROWW[slot] = w; TOKSLOT[(size_t)row * 4 + k] = slot; }
    if (wg == 0) { const int e = F.tid >> 4; const int s0 = Lpad[e] * 256 + Lcnt[e], s1 = Lpad[e + 1] * 256; for (int s = s0 + (F.tid & 15); s < s1; s += 16) { ROWTOK[s] = 0; ROWW[s] = 0.f; } }
}

__device__ __forceinline__ void phase_p13(const Frame& F, const Args& a) {
    unsigned char* ws = a.ws; const float* MOD = (const float*)(ws + WS_MOD); const unsigned char* YS = ws + WS_YS; const int* TOKSLOT = (const int*)(ws + WS_TOKSLOT); float* out = a.out; const bf16_t* X1 = (const bf16_t*)(ws + WS_X1B);
    const int gw = F.vcu * NWAVES + F.wave, NGW = F.G * NWAVES, l = F.lane;
    int4 sn[4];
#pragma unroll
    for (int q = 0; q < 4; ++q) sn[q] = *(const int4*)(TOKSLOT + (size_t)((gw + q * NGW) < T ? (gw + q * NGW) : gw) * 4);
    for (int t = gw; t < T; t += 4 * NGW) {
        int4 sl[4];
#pragma unroll
        for (int q = 0; q < 4; ++q) sl[q] = sn[q];
        if (t + 4 * NGW < T) {
#pragma unroll
            for (int q = 0; q < 4; ++q) { const int tn = t + (4 + q) * NGW; sn[q] = *(const int4*)(TOKSLOT + (size_t)(tn < T ? tn : t) * 4); } }
        f32x4 y[4][4];
#pragma unroll
        for (int q = 0; q < 4; ++q)
#pragma unroll
            for (int j = 0; j < 4; ++j) { const int c = 4 * l + 256 * j;
                y[q][j] = (ld4f8(YS + (size_t)sl[q].x * 1024 + c) + ld4f8(YS + (size_t)sl[q].y * 1024 + c)) + (ld4f8(YS + (size_t)sl[q].z * 1024 + c) + ld4f8(YS + (size_t)sl[q].w * 1024 + c)); }
#pragma unroll
        for (int q = 0; q < 4; ++q) { const int tq = t + q * NGW, b = tq >> 12; if (tq >= T) break;
#pragma unroll
            for (int j = 0; j < 4; ++j) { const int c = 4 * l + 256 * j; const f32x4 g2 = *(const f32x4*)(MOD + (size_t)b * 6144 + 5 * 1024 + c) * (1.f / YSC);
                const f32x4 xv = ld4bf(X1 + (size_t)tq * 1024 + c); *(f32x4*)(out + (size_t)tq * 1024 + c) = xv + g2 * y[q][j]; } } }
}

__global__ void __launch_bounds__(NTHR, 2) mega(Args args) {
    extern __shared__ __attribute__((aligned(16))) unsigned char lds_raw[];
    Frame F; F.lds = (LAS unsigned char*)lds_raw; F.tid = threadIdx.x; F.lane = F.tid & 63; F.wave = __builtin_amdgcn_readfirstlane(F.tid >> 6);
    F.G = gridDim.x; { const int bx = blockIdx.x; F.vcu = (F.G % 8 == 0) ? (bx % 8) * (F.G / 8) + bx / 8 : bx; }
    volatile LAS unsigned* MISC = (volatile LAS unsigned*)(F.lds + MISC_OFF);
    unsigned char* ws = args.ws;
    for (int u = F.tid; u < 64; u += NTHR) MISC[u] = 0u;
    __syncthreads();
    const int lo = args.ph_lo, hi = args.ph_hi;
    XcdBarrier bar; bar.bar = (unsigned*)(ws + WS_CTL) + CW_BAR + args.bar_region * XCD_BAR_WORDS; bar.x = 0; bar.st = nullptr;
    if (hi - lo > 1) bar = xcd_barrier_post((unsigned*)(ws + WS_CTL) + CW_BAR + args.bar_region * XCD_BAR_WORDS, MISC + 8);
#ifndef ONLY
#define ONLY -1
#endif
#define IN(k) (lo <= (k) && (k) < hi && (ONLY < 0 || ONLY == (k)))
#ifndef REPMASK
#define REPMASK 0
#endif
#ifndef REPN
#define REPN 1
#endif
#define RP(k) for (int _rp = 0; _rp < (((REPMASK >> (k)) & 1) ? REPN : 1); ++_rp)
#if defined(TS_A) || defined(TSPIN)
#define TSREC(k) do { if (blockIdx.x == 0 && F.tid == 0) ((unsigned long long*)(ws + 768 * 1024))[(k)] = __builtin_amdgcn_s_memrealtime(); } while (0)
#else
#define TSREC(k) do {} while (0)
#endif
#define SEAM(k) do { if (IN(k) && IN((k) + 1)) xcd_barrier(bar); TSREC((k) + 1); } while (0)
    bf16_t* Gt = (bf16_t*)args.out;
    TSREC(0);
    if (IN(0)) RP(0) { phase_p0(F, args); } SEAM(0);
    if (IN(1)) RP(1) { phase_p1(F, args); } SEAM(1);
    if (IN(2)) RP(2) { pg8::Gemm g{(const bf16_t*)(ws + WS_H), (const bf16_t*)(ws + WS_WIN), T, NIN, 1024, 0}; pg8::StaticOrder S; S.init(T, NIN, F.G, (int)blockIdx.x);
        EpiP E{(bf16_t*)(ws + WS_PS), Gt}; pg8::gemm_phase<EpiP, pg8::StaticOrder>(F.lds, g, S, E); } SEAM(2);
    if (IN(3)) RP(3) { phase_p3(F, args); } SEAM(3);
    if (IN(4)) RP(4) {
        { pg8::Gemm g{(const bf16_t*)(ws + WS_AQ), (const bf16_t*)(ws + WS_WQ), T, 768, 256, 0}; pg8::StaticOrder S; S.init(T, 768, F.G, (int)blockIdx.x);
          EpiPlain E{(bf16_t*)(ws + WS_QRAW), 768}; pg8::gemm_phase<EpiPlain, pg8::StaticOrder>(F.lds, g, S, E); }
        { pg8::Gemm g{(const bf16_t*)(ws + WS_AKV), (const bf16_t*)(ws + WS_WKV), T, 1024, 256, 0}; pg8::StaticOrder S; S.init(T, 1024, F.G, (int)blockIdx.x);
          EpiKV E{(bf16_t*)(ws + WS_KVRAW), (bf16_t*)(ws + WS_V)}; pg8::gemm_phase<EpiKV, pg8::StaticOrder>(F.lds, g, S, E); }
        { pg8::Gemm g{(const bf16_t*)(ws + WS_ALORA), (const bf16_t*)(ws + WS_WLORA), T, 1536, 256, 0}; pg8::StaticOrder S; S.init(T, 1536, F.G, (int)blockIdx.x);
          EpiLora E{(bf16_t*)(ws + WS_DEC), (bf16_t*)(ws + WS_AA), (bf16_t*)(ws + WS_GG)}; pg8::gemm_phase<EpiLora, pg8::StaticOrder>(F.lds, g, S, E); }
    } SEAM(4);
    if (IN(5)) RP(5) { phase_p5(F, args); }
    TSREC(6);
    if (IN(6)) RP(6) { wkv_phase_a(F, args); } SEAM(6);
    if (IN(7)) RP(7) { wkv_phase_b(F, args); } SEAM(7);
    if (IN(8)) RP(8) {
        if (F.tid < 96) *(LAS float*)(F.lds + AT_QW + F.tid * 4) = args.in[12][F.tid];
        const int c = F.vcu;
#ifndef ATTN_N
#define ATTN_N 1
#endif
#ifndef WC_N
#define WC_N 1
#endif
#pragma unroll 1
        for (int r = 0; r < 4 * ATTN_N; ++r) { const int pos = (r & 1) ? (F.G - 1 - c) : c; const int uidx = (r & 3) * F.G + pos; if (uidx >= 1024) continue;
            const int qb = 15 - (uidx >> 6), bh = uidx & 63;
            attn_unit(F.lds, bh, qb, (const bf16_t*)(ws + WS_QRAW), (const float*)(ws + WS_ROPE), (const bf16_t*)(ws + WS_K), (const bf16_t*)(ws + WS_V), (bf16_t*)(ws + WS_OA)); }
#pragma unroll 1
        for (int wcr = 0; wcr < WC_N; ++wcr) wkv_phase_c(F, args);
    } SEAM(8);
    if (IN(9)) RP(9) {
        { pg8::Gemm g{(const bf16_t*)(ws + WS_OA), (const bf16_t*)(ws + WS_WOA), T, 1024, 512, WS_WOB - WS_WOA, WS_OBIN - WS_OA}; pg8::PairOrder S; S.init(T, 1024, F.G, (int)blockIdx.x);
          EpiOAB E{Gt, (bf16_t*)(ws + WS_MERGED)}; pg8::gemm_phase<EpiOAB, pg8::PairOrder>(F.lds, g, S, E); }
    } SEAM(9);
    if (IN(10)) RP(10) { pg8::Gemm g{(const bf16_t*)(ws + WS_MERGED), (const bf16_t*)(ws + WS_WOUT), T, 1024, 1024, 0}; pg8::StaticOrder S; S.init(T, 1024, F.G, (int)blockIdx.x);
        EpiOut E{args.in[0], (const float*)(ws + WS_MOD), (bf16_t*)(ws + WS_X1B)}; pg8::gemm_phase<EpiOut, pg8::StaticOrder>(F.lds, g, S, E); } SEAM(10);
    if (IN(11)) RP(11) { phase_p9(F, args); } SEAM(11);
    if (IN(12)) RP(12) { phase_p10(F, args); } SEAM(12);
    if (IN(13) || IN(14)) {
        LAS int* tpre = (LAS int*)(F.lds + XTRA_OFF); LAS int* rowtab = tpre + 64;
        const int* TPRE = (const int*)(ws + WS_TPRE); const int* ROWTOK = (const int*)(ws + WS_ROWTOK);
        if (F.tid < 33) tpre[F.tid] = TPRE[F.tid];
        __syncthreads();
        if (IN(13)) RP(13) {
            pg8::MoeOrder<8, true> S; S.tpre = tpre; S.rowtab = rowtab; S.G = F.G; S.c = F.vcu;
            { int rt[17];
#pragma unroll
              for (int i = 0; i < 17; ++i) { pg8::Unit u; const bool ok = S.next(i, u); rt[i] = ok ? ROWTOK[u.pm * 256 + (F.tid & 255)] : 0; }
#pragma unroll
              for (int i = 0; i < 17; ++i) if (F.tid < 256) rowtab[i * 256 + F.tid] = rt[i];
              pg8::Unit u; for (int i = 17; S.next(i, u); ++i) { if (F.tid < 256) rowtab[i * 256 + F.tid] = ROWTOK[u.pm * 256 + F.tid]; } }
            __syncthreads();
            pg8::Gemm g{(const bf16_t*)(ws + WS_H), (const bf16_t*)(ws + WS_WGU), MAXSLOT, 2048, 512, (size_t)2048 * 1024};
            EpiGU E{args.in[31], (bf16_t*)(ws + WS_ACT)}; pg8::gemm_phase<EpiGU, pg8::MoeOrder<8, true>, true, true>(F.lds, g, S, E);
        }
        SEAM(13);
        if (IN(14)) RP(14) {
#ifdef STG14
            { const unsigned long long t0 = __builtin_amdgcn_s_memrealtime(); const unsigned long long dt = (unsigned long long)(((F.vcu >> 3) & 7) * STG14); while (__builtin_amdgcn_s_memrealtime() - t0 < dt) __builtin_amdgcn_s_sleep(4); }
#endif
            pg8::MoeOrder<4, false> S; S.tpre = tpre; S.rowtab = rowtab; S.G = F.G; S.c = F.vcu;
            pg8::Gemm g{(const bf16_t*)(ws + WS_ACT), (const bf16_t*)(ws + WS_WDN), MAXSLOT, 1024, 512, (size_t)1024 * 1024};
            EpiDN E{args.in[33], (const float*)(ws + WS_ROWW), (bf16_t*)(ws + WS_YS)}; pg8::gemm_phase<EpiDN, pg8::MoeOrder<4, false>, true, true>(F.lds, g, S, E);
        }
    }
    SEAM(14);
    if (IN(15)) { phase_p13(F, args); }
#ifdef XBARS
#pragma unroll 1
    for (int _x = 0; _x < XBARS; ++_x) xcd_barrier(bar);
#endif
#ifdef TSPIN
    TSREC(16);
    if (blockIdx.x == 0 && F.tid == 0) { const unsigned long long* ts = (const unsigned long long*)(ws + 768 * 1024); const unsigned long long dt = (ts[TSPIN + 1] - ts[TSPIN]) * 4ull; const unsigned long long t0 = __builtin_amdgcn_s_memrealtime();
        while (__builtin_amdgcn_s_memrealtime() - t0 < dt) __builtin_amdgcn_s_sleep(8); }
#endif
#ifdef TS_A
    xcd_barrier(bar); TSREC(16); xcd_barrier(bar);
    { const unsigned long long* ts = (const unsigned long long*)(ws + 768 * 1024); const float c1 = (float)(ts[TS_A + 1] - ts[TS_A]) * 1e-3f, c2 = (float)(ts[TS_B + 1] - ts[TS_B]) * 1e-2f;
      const size_t gt = (size_t)blockIdx.x * NTHR + F.tid; for (size_t i = gt; i < (size_t)T * 1024; i += (size_t)F.G * NTHR) args.out[i] = (i == 0) ? c2 : c1; }
#endif
#undef IN
#undef SEAM
}

static int g_grid = 0;
inline bool host_init(size_t ws_size) {
    if (g_grid) return g_grid > 0;
    int dev = 0, cus = 0;
    if (hipGetDevice(&dev) != hipSuccess || hipDeviceGetAttribute(&cus, hipDeviceAttributeMultiprocessorCount, dev) != hipSuccess) { g_grid = -1; return false; }
    if (hipFuncSetAttribute((const void*)mega, hipFuncAttributeMaxDynamicSharedMemorySize, LDS_BYTES) != hipSuccess) { fprintf(stderr, "hipFuncSetAttribute failed\n"); g_grid = -1; return false; }
    if (ws_size < WS_END) { fprintf(stderr, "workspace too small: %zu < %zu\n", ws_size, (size_t)WS_END); g_grid = -1; return false; }
    (void)hipGetLastError();
    g_grid = cus;
    if (g_grid != 256) fprintf(stderr, "note: %d CUs (kernel tuned for 256)\n", g_grid);
    return true;
}
inline void fill_args(Args& a, void* const* d_in, void* d_out, void* d_ws) { memset(&a, 0, sizeof(a)); for (int i = 0; i < 34; ++i) a.in[i] = (const float*)d_in[i]; a.out = (float*)d_out; a.ws = (unsigned char*)d_ws; }
inline void launch_range(hipStream_t st, Args a, int lo, int hi, int region) { a.ph_lo = lo; a.ph_hi = hi; a.bar_region = region; hipLaunchKernelGGL(mega, dim3(g_grid), dim3(NTHR), LDS_BYTES, st, a); }
}

#if MODE == 2
namespace orc {
constexpr int D = 1024, SEQ = 4096, NB = 8;
constexpr int DIN = 4256, SLAB = 1792;
constexpr int OFF_CQ = 0, OFF_CKV = 256, OFF_KR = 384, OFF_SLAB = 416, OFF_GA = 2208, OFF_GB = 3232;

__device__ __forceinline__ float sigmoidf_(float x) { return 1.f / (1.f + expf(-x)); }
__device__ __forceinline__ float softplusf_(float x) { return x > 20.f ? x : log1pf(expf(x)); }

__global__ void k_mod(const float* c, const float* ada_w, const float* ada_b, float* mod, int b) {
    int n = blockIdx.x * blockDim.x + threadIdx.x; if (n >= 6 * D) return;
    float acc = 0.f;
    for (int k = 0; k < D; ++k) { float cv = c[b * D + k]; float s = cv / (1.f + expf(-cv)); acc += s * ada_w[(size_t)k * 6 * D + n]; }
    mod[n] = acc + ada_b[n];
}
__global__ void k_adaln(const float* x, const float* w, const float* shift, const float* scale, float* h) {
    __shared__ float red[256];
    const float* xr = x + (size_t)blockIdx.x * D; float ss = 0.f;
    for (int i = threadIdx.x; i < D; i += 256) ss += xr[i] * xr[i];
    red[threadIdx.x] = ss; __syncthreads();
    for (int o = 128; o > 0; o >>= 1) { if (threadIdx.x < o) red[threadIdx.x] += red[threadIdx.x + o]; __syncthreads(); }
    float r = rsqrtf(red[0] / D + 1e-6f);
    for (int i = threadIdx.x; i < D; i += 256) h[(size_t)blockIdx.x * D + i] = xr[i] * r * w[i] * (1.f + scale[i]) + shift[i];
}
__global__ void k_rmsrows(const float* in, int ld, int off, int n, const float* w, float* out, int rows) {
    int row = blockIdx.x * (blockDim.x / 64) + (threadIdx.x >> 6), lane = threadIdx.x & 63; if (row >= rows) return;
    const float* p = in + (size_t)row * ld + off; float ss = 0.f;
    for (int i = lane; i < n; i += 64) ss += p[i] * p[i];
    for (int o = 32; o > 0; o >>= 1) ss += __shfl_xor(ss, o);
    float r = rsqrtf(ss / n + 1e-6f);
    for (int i = lane; i < n; i += 64) out[(size_t)row * n + i] = p[i] * r * w[i];
}
struct GA { const float* A; const int* aidx; const float* W; size_t wstride; float* C; const float* bias; const int* goff; const int* gcnt; int lda, ldw, ldc, bstride, M, N, K, pad; };
__global__ __launch_bounds__(256) void k_gemm(GA g) {
    __shared__ float As[16][64 + 4], Ws[16][64 + 4];
    const int z = blockIdx.z; const int rowbase = g.goff ? g.goff[z] : 0; const int M = g.gcnt ? g.gcnt[z] : g.M;
    const int m0 = blockIdx.y * 64, n0 = blockIdx.x * 64; if (m0 >= M) return;
    const float* W = g.W + (size_t)z * g.wstride; const float* bias = g.bias ? g.bias + (size_t)z * g.bstride : nullptr;
    const int tx = threadIdx.x & 15, ty = threadIdx.x >> 4;
    float acc[4][4] = {};
    const int ar = threadIdx.x >> 2, ak = (threadIdx.x & 3) * 4;
    const int wk = threadIdx.x >> 4, wn = (threadIdx.x & 15) * 4;
    long arow = -1; if (m0 + ar < M) { int rr = rowbase + m0 + ar; arow = g.aidx ? g.aidx[rr] : rr; }
    for (int k0 = 0; k0 < g.K; k0 += 16) {
        float4 av = make_float4(0, 0, 0, 0);
        if (arow >= 0) av = *(const float4*)(g.A + (size_t)arow * g.lda + k0 + ak);
        As[ak + 0][ar] = av.x; As[ak + 1][ar] = av.y; As[ak + 2][ar] = av.z; As[ak + 3][ar] = av.w;
#pragma unroll
        for (int j = 0; j < 4; ++j) { int n = n0 + wn + j; Ws[wk][wn + j] = (n < g.N) ? W[(size_t)(k0 + wk) * g.ldw + n] : 0.f; }
        __syncthreads();
#pragma unroll
        for (int kk = 0; kk < 16; ++kk) {
            float a[4], w[4];
#pragma unroll
            for (int i = 0; i < 4; ++i) { a[i] = As[kk][ty * 4 + i]; w[i] = Ws[kk][tx * 4 + i]; }
#pragma unroll
            for (int i = 0; i < 4; ++i)
#pragma unroll
                for (int j = 0; j < 4; ++j) acc[i][j] += a[i] * w[j];
        }
        __syncthreads();
    }
#pragma unroll
    for (int i = 0; i < 4; ++i) { int m = m0 + ty * 4 + i; if (m >= M) continue;
#pragma unroll
        for (int j = 0; j < 4; ++j) { int n = n0 + tx * 4 + j; if (n >= g.N) continue;
            g.C[(size_t)(rowbase + m) * g.ldc + n] = acc[i][j] + (bias ? bias[n] : 0.f); } }
}
__global__ void k_qkfin(const float* q, const float* kv, const float* P, const int* positions, int b, const float* q_norm_w, const float* k_norm_w,
                        float* qf, float* kf, float* vf, int So) {
    int idx = blockIdx.x * (blockDim.x / 64) + (threadIdx.x >> 6), lane = threadIdx.x & 63; if (idx >= So * 8) return;
    int s = idx >> 3, h = idx & 7;
    float pos = (float)positions[b * SEQ + s];
    float q0 = q[(size_t)s * 768 + h * 96 + lane], q1 = lane < 32 ? q[(size_t)s * 768 + h * 96 + 64 + lane] : 0.f;
    float k0 = kv[(size_t)s * 1024 + h * 128 + lane], k1 = lane < 32 ? P[(size_t)s * DIN + OFF_KR + lane] : 0.f;
    float sq = q0 * q0 + q1 * q1, sk = k0 * k0 + k1 * k1;
    for (int o = 32; o > 0; o >>= 1) { sq += __shfl_xor(sq, o); sk += __shfl_xor(sk, o); }
    float rq = rsqrtf(sq / 96.f + 1e-6f), rk = rsqrtf(sk / 96.f + 1e-6f);
    q0 = q0 * rq * q_norm_w[lane]; k0 = k0 * rk * k_norm_w[lane];
    if (lane < 32) { q1 = q1 * rq * q_norm_w[64 + lane]; k1 = k1 * rk * k_norm_w[64 + lane]; }
    int i = lane & 15; float inv = powf(10000.f, -(float)i / 16.f); float ang = pos * inv; float cs = cosf(ang), sn = sinf(ang);
    float qo = __shfl(q1, lane ^ 16), ko = __shfl(k1, lane ^ 16);
    float q1r, k1r;
    if (lane < 16) { q1r = q1 * cs - qo * sn; k1r = k1 * cs - ko * sn; } else { q1r = q1 * cs + qo * sn; k1r = k1 * cs + ko * sn; }
    qf[((size_t)s * 8 + h) * 96 + lane] = q0; kf[((size_t)s * 8 + h) * 96 + lane] = k0;
    if (lane < 32) { qf[((size_t)s * 8 + h) * 96 + 64 + lane] = q1r; kf[((size_t)s * 8 + h) * 96 + 64 + lane] = k1r; }
    vf[((size_t)s * 8 + h) * 64 + lane] = kv[(size_t)s * 1024 + h * 128 + 64 + lane];
}
__global__ __launch_bounds__(64) void k_attn(const float* qf, const float* kf, const float* vf, float* oa) {
    __shared__ float Ks[64][96], Vs[64][64];
    const int qb = blockIdx.x, h = blockIdx.y, lane = threadIdx.x; const int sq = qb * 64 + lane;
    float q[96], o[64];
#pragma unroll
    for (int d = 0; d < 96; ++d) q[d] = qf[((size_t)sq * 8 + h) * 96 + d] * 0.10206207261596577f;
#pragma unroll
    for (int d = 0; d < 64; ++d) o[d] = 0.f;
    float m = -INFINITY, l = 0.f;
    for (int t = 0; t <= qb; ++t) {
        __syncthreads();
        for (int i = lane; i < 64 * 96; i += 64) { int r = i / 96, d = i % 96; Ks[r][d] = kf[((size_t)(t * 64 + r) * 8 + h) * 96 + d]; }
        for (int i = lane; i < 64 * 64; i += 64) { int r = i / 64, d = i % 64; Vs[r][d] = vf[((size_t)(t * 64 + r) * 8 + h) * 64 + d]; }
        __syncthreads();
        for (int j = 0; j < 64; ++j) {
            int sk = t * 64 + j; if (sk > sq) break;
            float s = 0.f;
#pragma unroll
            for (int d = 0; d < 96; ++d) s += q[d] * Ks[j][d];
            float mn = fmaxf(m, s), f = expf(m - mn), p = expf(s - mn);
            l = l * f + p;
#pragma unroll
            for (int d = 0; d < 64; ++d) o[d] = o[d] * f + p * Vs[j][d];
            m = mn;
        }
    }
    float il = 1.f / l;
#pragma unroll
    for (int d = 0; d < 64; ++d) oa[(size_t)sq * 512 + h * 64 + d] = o[d] * il;
}
__global__ void k_rwkv_prep1(const float* P, const float* mu, float* r, float* k, float* v, float* tw, float* al, float* sg, int So) {
    int s = blockIdx.x;
    for (int i = threadIdx.x; i < SLAB; i += blockDim.x) {
        float cur = P[(size_t)s * DIN + OFF_SLAB + i]; float prev = s > 0 ? P[(size_t)(s - 1) * DIN + OFF_SLAB + i] : 0.f;
        float p = cur + (prev - cur) * mu[i];
        if (i < 512) r[(size_t)s * 512 + i] = p; else if (i < 1024) k[(size_t)s * 512 + i - 512] = p; else if (i < 1536) v[(size_t)s * 512 + i - 1024] = p;
        else if (i < 1600) tw[(size_t)s * 64 + i - 1536] = tanhf(p); else if (i < 1664) al[(size_t)s * 64 + i - 1600] = p; else sg[(size_t)s * 128 + i - 1664] = sigmoidf_(p);
    }
}
__global__ void k_rwkv_prep2(const float* r, const float* k, const float* v, const float* dw, const float* da, const float* w0, const float* a0,
                             const float* k_k, const float* k_a, const float* r_k, float* scan_in, float* bonus, int So) {
    int idx = blockIdx.x * (blockDim.x / 64) + (threadIdx.x >> 6), lane = threadIdx.x & 63; if (idx >= So * 8) return;
    int s = idx >> 3, h = idx & 7, c = h * 64 + lane;
    float rv = r[(size_t)s * 512 + c], kv_ = k[(size_t)s * 512 + c], vv = v[(size_t)s * 512 + c];
    float lw = -softplusf_(-(w0[c] + dw[(size_t)s * 512 + c])) - 0.5f; float dec = expf(-expf(lw));
    float a = sigmoidf_(a0[c] + da[(size_t)s * 512 + c]);
    float kk = kv_ * k_k[c]; float ss = kk * kk; for (int o = 32; o > 0; o >>= 1) ss += __shfl_xor(ss, o);
    kk = kk / fmaxf(sqrtf(ss), 1e-12f);
    float kp = kv_ * (1.f + (a - 1.f) * k_a[c]);
    float bs = rv * kp * r_k[c]; for (int o = 32; o > 0; o >>= 1) bs += __shfl_xor(bs, o);
    float* si = scan_in + ((size_t)h * So + s) * 6 * 64;
    si[0 * 64 + lane] = rv; si[1 * 64 + lane] = dec; si[2 * 64 + lane] = kp; si[3 * 64 + lane] = vv; si[4 * 64 + lane] = kk; si[5 * 64 + lane] = kk * a;
    bonus[(size_t)s * 512 + c] = bs * vv;
}
__global__ __launch_bounds__(256) void k_scan(const float* scan_in, float* y, int So, float* sdump) {
    __shared__ float buf[32][6][64];
    const int h = blockIdx.x, tid = threadIdx.x, vrow = tid >> 2, kq = tid & 3;
    float S[16];
#pragma unroll
    for (int i = 0; i < 16; ++i) S[i] = 0.f;
    for (int s0 = 0; s0 < So; s0 += 32) {
        if (sdump && (s0 & 63) == 0) {
#pragma unroll
            for (int i = 0; i < 16; ++i) sdump[(((size_t)h * (So / 64) + (s0 >> 6)) * 64 + vrow) * 64 + kq * 16 + i] = S[i]; }
        __syncthreads();
        const float* src = scan_in + ((size_t)h * So + s0) * 384;
        for (int i = tid; i < 32 * 384; i += 256) (&buf[0][0][0])[i] = src[i];
        __syncthreads();
        for (int t = 0; t < 32; ++t) {
            const float* rr = &buf[t][0][kq * 16]; const float* ww = &buf[t][1][kq * 16]; const float* kp = &buf[t][2][kq * 16];
            const float* kk = &buf[t][4][kq * 16]; const float* bb = &buf[t][5][kq * 16]; const float vv = buf[t][3][vrow];
            float sa = 0.f;
#pragma unroll
            for (int i = 0; i < 16; ++i) sa += S[i] * kk[i];
            sa += __shfl_xor(sa, 1); sa += __shfl_xor(sa, 2); sa = -sa;
            float yy = 0.f;
#pragma unroll
            for (int i = 0; i < 16; ++i) { S[i] = S[i] * ww[i] + sa * bb[i] + vv * kp[i]; yy += S[i] * rr[i]; }
            yy += __shfl_xor(yy, 1); yy += __shfl_xor(yy, 2);
            if (kq == 0) y[(size_t)(s0 + t) * 512 + h * 64 + vrow] = yy;
        }
    }
}
__global__ void k_rwkv_post(const float* y, const float* bonus, const float* g, const float* ln_w, const float* ln_b, float* yb, int So) {
    int idx = blockIdx.x * (blockDim.x / 64) + (threadIdx.x >> 6), lane = threadIdx.x & 63; if (idx >= So * 8) return;
    int s = idx >> 3, h = idx & 7, c = h * 64 + lane;
    float yv = y[(size_t)s * 512 + c]; float sm = yv; for (int o = 32; o > 0; o >>= 1) sm += __shfl_xor(sm, o);
    float mu = sm / 64.f; float d = yv - mu; float vs = d * d; for (int o = 32; o > 0; o >>= 1) vs += __shfl_xor(vs, o);
    float yn = d * rsqrtf(vs / 64.f + 64e-5f) * ln_w[c] + ln_b[c];
    yb[(size_t)s * 512 + c] = (yn + bonus[(size_t)s * 512 + c]) * g[(size_t)s * 512 + c];
}
__global__ void k_merge(const float* P, const float* oa, const float* ob, float* merged, int So) {
    size_t i = (size_t)blockIdx.x * blockDim.x + threadIdx.x; if (i >= (size_t)So * D) return; size_t s = i / D; int n = i % D;
    merged[i] = sigmoidf_(P[s * DIN + OFF_GA + n]) * oa[i] + sigmoidf_(P[s * DIN + OFF_GB + n]) * ob[i];
}
__global__ void k_resid(const float* x, const float* gate, const float* mix, float* out, int So) {
    size_t i = (size_t)blockIdx.x * blockDim.x + threadIdx.x; if (i >= (size_t)So * D) return; int n = i % D;
    out[i] = x[i] + gate[n] * mix[i];
}
__global__ void k_topk(const float* logits, int* top_e, float* top_w, int So) {
    int s = blockIdx.x * blockDim.x + threadIdx.x; if (s >= So) return;
    float l[32];
#pragma unroll
    for (int e = 0; e < 32; ++e) l[e] = logits[(size_t)s * 32 + e];
    unsigned taken = 0u; int ie0 = 0, ie1 = 0, ie2 = 0, ie3 = 0; float ve0 = 0, ve1 = 0, ve2 = 0, ve3 = 0;
#pragma unroll
    for (int k = 0; k < 4; ++k) { int bi = 0; float bv = -INFINITY;
#pragma unroll
        for (int e = 0; e < 32; ++e) { bool ok = !((taken >> e) & 1u) && (l[e] > bv); bv = ok ? l[e] : bv; bi = ok ? e : bi; }
        taken |= 1u << bi;
        if (k == 0) { ie0 = bi; ve0 = bv; } else if (k == 1) { ie1 = bi; ve1 = bv; } else if (k == 2) { ie2 = bi; ve2 = bv; } else { ie3 = bi; ve3 = bv; } }
    float p0 = 1.f, p1 = expf(ve1 - ve0), p2 = expf(ve2 - ve0), p3 = expf(ve3 - ve0); float inv = 1.f / (p0 + p1 + p2 + p3);
    top_e[s * 4 + 0] = ie0; top_e[s * 4 + 1] = ie1; top_e[s * 4 + 2] = ie2; top_e[s * 4 + 3] = ie3;
    top_w[s * 4 + 0] = p0 * inv; top_w[s * 4 + 1] = p1 * inv; top_w[s * 4 + 2] = p2 * inv; top_w[s * 4 + 3] = p3 * inv;
}
__global__ __launch_bounds__(1024) void k_dispatch(const int* top_e, int* cnt, int* off, int* slot_tok, int* tok_slot, int So) {
    __shared__ int c[32], o[32], run[32];
    if (threadIdx.x < 32) { c[threadIdx.x] = 0; run[threadIdx.x] = 0; } __syncthreads();
    for (int i = threadIdx.x; i < So * 4; i += 1024) atomicAdd(&c[top_e[i]], 1);
    __syncthreads();
    if (threadIdx.x == 0) { int a = 0; for (int e = 0; e < 32; ++e) { o[e] = a; a += c[e]; } }
    __syncthreads();
    if (threadIdx.x < 32) { cnt[threadIdx.x] = c[threadIdx.x]; off[threadIdx.x] = o[threadIdx.x]; }
    for (int i = threadIdx.x; i < So * 4; i += 1024) { int e = top_e[i]; int sl = o[e] + atomicAdd(&run[e], 1); slot_tok[sl] = i >> 2; tok_slot[i] = sl; }
}
__global__ void k_swiglu(const float* gu, float* act, int rows) {
    size_t i = (size_t)blockIdx.x * blockDim.x + threadIdx.x; if (i >= (size_t)rows * 1024) return; size_t r = i / 1024; int j = i % 1024;
    float gte = fminf(gu[r * 2048 + 2 * j], 7.f), up = fminf(fmaxf(gu[r * 2048 + 2 * j + 1], -7.f), 7.f);
    act[i] = (up + 1.f) * gte * sigmoidf_(1.702f * gte);
}
__global__ void k_combine(const float* x1, const float* gate2, const float* ye, const int* tok_slot, const float* top_w, float* out, int So) {
    size_t i = (size_t)blockIdx.x * blockDim.x + threadIdx.x; if (i >= (size_t)So * D) return; size_t s = i / D; int n = i % D;
    float acc = 0.f; for (int k = 0; k < 4; ++k) acc += top_w[s * 4 + k] * ye[(size_t)tok_slot[s * 4 + k] * D + n];
    out[i] = x1[i] + gate2[n] * acc;
}

struct Buf {
    float *sdump, *mod, *h, *P, *cqn, *ckvn, *q, *kv, *qf, *kf, *vf, *oa, *o_a, *r, *k, *v, *tw, *al, *sg, *dw, *da, *g, *scan_in, *bonus, *y, *yb, *o_b, *merged, *mix, *x1, *h2, *logits, *top_w, *gu, *act, *ye;
    int *top_e, *cnt, *off, *slot_tok, *tok_slot;
    size_t bytes;
};
inline Buf carve(char* base, int So) {
    Buf B; size_t o = 0; auto F = [&](size_t n) { float* p = (float*)(base + o); o += ((n * 4 + 255) / 256) * 256; return p; };
    size_t S = So;
    B.sdump = F(8 * (S / 64) * 4096); B.mod = F(6 * D); B.h = F(S * D); B.P = F(S * DIN); B.cqn = F(S * 256); B.ckvn = F(S * 128); B.q = F(S * 768); B.kv = F(S * 1024);
    B.qf = F(S * 768); B.kf = F(S * 768); B.vf = F(S * 512); B.oa = F(S * 512); B.o_a = F(S * D);
    B.r = F(S * 512); B.k = F(S * 512); B.v = F(S * 512); B.tw = F(S * 64); B.al = F(S * 64); B.sg = F(S * 128); B.dw = F(S * 512); B.da = F(S * 512); B.g = F(S * 512);
    B.scan_in = F(S * 8 * 384); B.bonus = F(S * 512); B.y = F(S * 512); B.yb = F(S * 512); B.o_b = F(S * D); B.merged = F(S * D); B.mix = F(S * D); B.x1 = F(S * D); B.h2 = F(S * D);
    B.logits = F(S * 32); B.top_w = F(S * 4); B.top_e = (int*)F(S * 4); B.cnt = (int*)F(64); B.off = (int*)F(64); B.slot_tok = (int*)F(S * 4); B.tok_slot = (int*)F(S * 4);
    B.gu = F(S * 4 * 2048); B.act = F(S * 4 * 1024); B.ye = F(S * 4 * 1024);
    B.bytes = o; return B;
}
inline void gemm(hipStream_t st, const float* A, int lda, const float* W, int ldw, float* C, int ldc, const float* bias, int M, int N, int K) {
    GA g; memset(&g, 0, sizeof(g)); g.A = A; g.lda = lda; g.W = W; g.ldw = ldw; g.C = C; g.ldc = ldc; g.bias = bias; g.M = M; g.N = N; g.K = K;
    hipLaunchKernelGGL(k_gemm, dim3((N + 63) / 64, (M + 63) / 64, 1), dim3(256), 0, st, g);
}
inline void run(hipStream_t st, void* const* d_in, int b, int So, const Buf& B, float* out_rows) {
    const float* x = (const float*)d_in[0] + (size_t)b * SEQ * D; const float* c = (const float*)d_in[1]; const int* positions = (const int*)d_in[2];
    const float *ada_w = (const float*)d_in[3], *ada_b = (const float*)d_in[4], *norm_mix_w = (const float*)d_in[5], *norm_ffn_w = (const float*)d_in[6], *w_in = (const float*)d_in[7];
    const float *q_a_norm_w = (const float*)d_in[8], *w_q_up = (const float*)d_in[9], *kv_a_norm_w = (const float*)d_in[10], *w_kv_up = (const float*)d_in[11];
    const float *q_norm_w = (const float*)d_in[12], *k_norm_w = (const float*)d_in[13], *w_o_mla = (const float*)d_in[14];
    const float *mu = (const float*)d_in[15], *w0 = (const float*)d_in[16], *w2 = (const float*)d_in[17], *a0 = (const float*)d_in[18], *a2 = (const float*)d_in[19], *g2 = (const float*)d_in[20];
    const float *k_k = (const float*)d_in[21], *k_a = (const float*)d_in[22], *r_k = (const float*)d_in[23], *ln_w = (const float*)d_in[24], *ln_b = (const float*)d_in[25], *rw_o = (const float*)d_in[26];
    const float *w_out = (const float*)d_in[27], *w_router = (const float*)d_in[28], *b_router = (const float*)d_in[29], *w_gu = (const float*)d_in[30], *b_gu = (const float*)d_in[31], *w_dn = (const float*)d_in[32], *b_dn = (const float*)d_in[33];
    const int nW = (So * 8 + 3) / 4;
    hipLaunchKernelGGL(k_mod, dim3(24), dim3(256), 0, st, c, ada_w, ada_b, B.mod, b);
    hipLaunchKernelGGL(k_adaln, dim3(So), dim3(256), 0, st, x, norm_mix_w, B.mod + 0 * D, B.mod + 1 * D, B.h);
    gemm(st, B.h, D, w_in, DIN, B.P, DIN, nullptr, So, DIN, D);
    hipLaunchKernelGGL(k_rmsrows, dim3((So + 3) / 4), dim3(256), 0, st, B.P, DIN, OFF_CQ, 256, q_a_norm_w, B.cqn, So);
    hipLaunchKernelGGL(k_rmsrows, dim3((So + 3) / 4), dim3(256), 0, st, B.P, DIN, OFF_CKV, 128, kv_a_norm_w, B.ckvn, So);
    gemm(st, B.cqn, 256, w_q_up, 768, B.q, 768, nullptr, So, 768, 256);
    gemm(st, B.ckvn, 128, w_kv_up, 1024, B.kv, 1024, nullptr, So, 1024, 128);
    hipLaunchKernelGGL(k_qkfin, dim3(nW), dim3(256), 0, st, B.q, B.kv, B.P, positions, b, q_norm_w, k_norm_w, B.qf, B.kf, B.vf, So);
    hipLaunchKernelGGL(k_attn, dim3(So / 64, 8), dim3(64), 0, st, B.qf, B.kf, B.vf, B.oa);
    gemm(st, B.oa, 512, w_o_mla, D, B.o_a, D, nullptr, So, D, 512);
    hipLaunchKernelGGL(k_rwkv_prep1, dim3(So), dim3(256), 0, st, B.P, mu, B.r, B.k, B.v, B.tw, B.al, B.sg, So);
    gemm(st, B.tw, 64, w2, 512, B.dw, 512, nullptr, So, 512, 64);
    gemm(st, B.al, 64, a2, 512, B.da, 512, nullptr, So, 512, 64);
    gemm(st, B.sg, 128, g2, 512, B.g, 512, nullptr, So, 512, 128);
    hipLaunchKernelGGL(k_rwkv_prep2, dim3(nW), dim3(256), 0, st, B.r, B.k, B.v, B.dw, B.da, w0, a0, k_k, k_a, r_k, B.scan_in, B.bonus, So);
    hipLaunchKernelGGL(k_scan, dim3(8), dim3(256), 0, st, B.scan_in, B.y, So, B.sdump);
    hipLaunchKernelGGL(k_rwkv_post, dim3(nW), dim3(256), 0, st, B.y, B.bonus, B.g, ln_w, ln_b, B.yb, So);
    gemm(st, B.yb, 512, rw_o, D, B.o_b, D, nullptr, So, D, 512);
    hipLaunchKernelGGL(k_merge, dim3((So * D + 255) / 256), dim3(256), 0, st, B.P, B.o_a, B.o_b, B.merged, So);
    gemm(st, B.merged, D, w_out, D, B.mix, D, nullptr, So, D, D);
    hipLaunchKernelGGL(k_resid, dim3((So * D + 255) / 256), dim3(256), 0, st, x, B.mod + 2 * D, B.mix, B.x1, So);
    hipLaunchKernelGGL(k_adaln, dim3(So), dim3(256), 0, st, B.x1, norm_ffn_w, B.mod + 3 * D, B.mod + 4 * D, B.h2);
    gemm(st, B.h2, D, w_router, 32, B.logits, 32, b_router, So, 32, D);
    hipLaunchKernelGGL(k_topk, dim3((So + 255) / 256), dim3(256), 0, st, B.logits, B.top_e, B.top_w, So);
    hipLaunchKernelGGL(k_dispatch, dim3(1), dim3(1024), 0, st, B.top_e, B.cnt, B.off, B.slot_tok, B.tok_slot, So);
    { GA g; memset(&g, 0, sizeof(g)); g.A = B.h2; g.lda = D; g.aidx = B.slot_tok; g.W = w_gu; g.ldw = 2048; g.wstride = (size_t)D * 2048; g.C = B.gu; g.ldc = 2048; g.bias = b_gu; g.bstride = 2048;
      g.M = So; g.N = 2048; g.K = D; g.goff = B.off; g.gcnt = B.cnt;
      hipLaunchKernelGGL(k_gemm, dim3(2048 / 64, (So + 63) / 64, 32), dim3(256), 0, st, g); }
    hipLaunchKernelGGL(k_swiglu, dim3((So * 4 * 1024 + 255) / 256), dim3(256), 0, st, B.gu, B.act, So * 4);
    { GA g; memset(&g, 0, sizeof(g)); g.A = B.act; g.lda = D; g.W = w_dn; g.ldw = D; g.wstride = (size_t)D * D; g.C = B.ye; g.ldc = D; g.bias = b_dn; g.bstride = D;
      g.M = So; g.N = D; g.K = D; g.goff = B.off; g.gcnt = B.cnt;
      hipLaunchKernelGGL(k_gemm, dim3(D / 64, (So + 63) / 64, 32), dim3(256), 0, st, g); }
    hipLaunchKernelGGL(k_combine, dim3((So * D + 255) / 256), dim3(256), 0, st, B.x1, B.mod + 5 * D, B.ye, B.tok_slot, B.top_w, out_rows, So);
}
}

namespace dbg {
constexpr int OB = 5, SO = 512;
struct CmpArgs { const void* fast; const float* ref; float* res; int mode, rows, C, ldf, coff, ref_ld, ref_off, stage; };
__global__ void k_cmp(CmpArgs a) {
    const size_t n = (size_t)a.rows * a.C; float num = 0.f, den = 0.f, nanc = 0.f;
    for (size_t i = (size_t)blockIdx.x * blockDim.x + threadIdx.x; i < n; i += (size_t)gridDim.x * blockDim.x) {
        int s = (int)(i / a.C), c = (int)(i % a.C); const size_t t = (size_t)OB * 4096 + s; float fv, rv;
        if (a.mode == 13) { fv = ((const float*)a.fast)[i]; const int tt = (int)((i % 4096) / 64), ss = (int)(i % 64); const int quad = (tt >= 32 ? 2 : 0) + (ss >= 32 ? 1 : 0); fv = (quad == a.ldf && !(fabsf(fv) <= 10.f)) ? NAN : 0.f; rv = 0.f; }
        else if (a.mode == 12) { fv = ((const float*)a.fast)[i]; fv = (fabsf(fv) > (a.ldf > 0 ? a.ldf * 0.1f : 1e4f)) ? NAN : 0.f; rv = 0.f; }
        else if (a.mode == 11) { const float xv = __uint_as_float((unsigned)((const unsigned short*)a.fast)[i] << 16); const int arr = (int)((i / 64) % 6); fv = (arr == 1 && !(xv < 1.f && xv >= 0.f)) ? NAN : 0.f; rv = 0.f; }
        else if (a.mode == 9) { fv = ((const float*)a.fast)[i]; rv = 0.f; }
        else if (a.mode == 10) { fv = __uint_as_float((unsigned)((const unsigned short*)a.fast)[i] << 16); rv = 0.f; }
        else if (a.mode == 8) {
            const int per = (a.rows / 8) * 4096; const int h = (int)(i / per); const int rem = (int)(i % per); const int chk = rem / 4096, q = rem % 4096;
            rv = a.ref[i]; const unsigned short* f = (const unsigned short*)a.fast; fv = __uint_as_float((unsigned)f[((size_t)((OB * 8 + h) * 64 + chk)) * 4096 + q] << 16);
            if (a.ldf > 0 && chk != a.ldf) { fv = 0.f; rv = 0.f; }
        } else if (a.mode == 5) {
            const int h = (int)(i / ((size_t)a.rows / 8 * 384)); const size_t rem = i % ((size_t)a.rows / 8 * 384); s = (int)(rem / 384); const int q = (int)(rem % 384); const int arr = q / 64;
            rv = a.ref[i]; const unsigned short* f = (const unsigned short*)a.fast; fv = __uint_as_float((unsigned)f[(((size_t)(OB * 8 + h) * 4096 + s) * 384) + q] << 16); if (arr == 1) fv = 1.f - fv;
        } else {
            rv = a.ref[(size_t)s * a.ref_ld + a.ref_off + c];
            if (a.mode == 7) fv = ((const float*)a.fast)[c];
            else if (a.mode == 0) fv = ((const float*)a.fast)[t * a.ldf + a.coff + c];
            else { const unsigned short* f = (const unsigned short*)a.fast; size_t idx;
                if (a.mode == 1 || a.mode == 6) idx = t * a.ldf + a.coff + c;
                else if (a.mode == 2) { const int h = c / 96, d = c % 96; idx = ((size_t)(OB * 8 + h) * 4096 + s) * 96 + d; }
                else if (a.mode == 3) { const int h = c / 96, d = c % 96; idx = ((size_t)(OB * 8 + h) * 64 + (s >> 6)) * 6144 + (d >> 3) * 512 + (s & 63) * 8 + (d & 7); }
                else { const int h = c / 64, d = c % 64, key = s & 63; idx = ((size_t)(OB * 8 + h) * 64 + (s >> 6)) * 4096 + ((d >> 5) * 4 + (key >> 4)) * 512 + (key & 15) * 32 + (d & 31); }
                fv = __uint_as_float((unsigned)f[idx] << 16);
                if (a.mode == 2) fv *= (1.f / fk::QSCALE);
                if (a.mode == 6) rv = 1.f / (1.f + expf(-rv)); }
        }
        const float d = fv - rv; if (!(d == d) || fabsf(d) > 1e30f) { nanc += 1.f; } else { num += d * d; den += rv * rv; }
    }
    for (int o = 32; o > 0; o >>= 1) { num += __shfl_xor(num, o); den += __shfl_xor(den, o); nanc += __shfl_xor(nanc, o); }
    if ((threadIdx.x & 63) == 0) { atomicAdd(a.res + 2 * a.stage, num); atomicAdd(a.res + 2 * a.stage + 1, den); atomicAdd(a.res + 100 + a.stage, nanc); }
}
__global__ void k_cmp_topk(const int* fe, const int* re, float* res, int stage) {
    int s = blockIdx.x * blockDim.x + threadIdx.x; if (s >= SO) return; const size_t t = (size_t)OB * 4096 + s; int bad = 0;
    for (int k = 0; k < 4; ++k) bad |= (fe[t * 4 + k] != re[s * 4 + k]);
    atomicAdd(res + 2 * stage, (float)bad); atomicAdd(res + 2 * stage + 1, 1.f);
}
__global__ void k_verdict(const float* res, int nstage, float* out, size_t n) {
    int fail = 0;
#ifdef REPORT_STAGE
    { const float num = res[2 * REPORT_STAGE], den = res[2 * REPORT_STAGE + 1]; const float rel = sqrtf(num / fmaxf(den, 1e-30f)); float c = fminf(rel * 100.f, 2000.f); if (res[100 + REPORT_STAGE] > 0.f) { const float nn = res[100 + REPORT_STAGE]; c = nn < 100.f ? 100.f + nn : (nn < 1000.f ? 200.f + nn * 0.1f : 2500.f + fminf(nn * 0.01f, 400.f)); }
      for (size_t i = (size_t)blockIdx.x * blockDim.x + threadIdx.x; i < n; i += (size_t)gridDim.x * blockDim.x) out[i] = c; return; }
#endif
    for (int s = nstage - 1; s >= 0; --s) { const float num = res[2 * s], den = res[2 * s + 1]; const float rel = sqrtf(num / fmaxf(den, 1e-30f)); const float tol = (s == 0) ? 1e-3f : (s == 20 ? 0.2f : 4e-2f);
        if (!(rel <= tol) || res[100 + s] > 0.f) fail = s + 1; }
    if (fail == 0) return;
    for (size_t i = (size_t)blockIdx.x * blockDim.x + threadIdx.x; i < n; i += (size_t)gridDim.x * blockDim.x) out[i] = (float)fail;
}
inline void cmp(hipStream_t st, float* res, int stage, const void* fast, int mode, int ldf, int coff, const float* ref, int ref_ld, int ref_off, int rows, int C) {
    CmpArgs a; memset(&a, 0, sizeof(a)); a.fast = fast; a.ref = ref; a.res = res; a.mode = mode; a.rows = rows; a.C = C; a.ldf = ldf; a.coff = coff; a.ref_ld = ref_ld; a.ref_off = ref_off; a.stage = stage;
    hipLaunchKernelGGL(k_cmp, dim3(512), dim3(256), 0, st, a);
}
}
#endif
extern "C" void kernel_launch(void* const* d_in, const int* in_sizes, int n_in, void* d_out, int out_size, void* d_ws, size_t ws_size, hipStream_t stream) {
    using namespace fk;
    if (!host_init(ws_size)) return;
    Args a; fill_args(a, d_in, d_out, d_ws);
    hipMemsetAsync((char*)d_ws + WS_CTL, 0, CTL_ZERO_BYTES, stream);
#if MODE == 0
    launch_range(stream, a, 0, NPHASE, 0);
#elif MODE == 1
    for (int p = 0; p < NPHASE; ++p) launch_range(stream, a, p, p + 1, 0);
#else
    unsigned char* ws = (unsigned char*)d_ws;
    char* obase = (char*)d_ws + WS_END; orc::Buf B = orc::carve(obase, dbg::SO); float* oout = (float*)(obase + B.bytes);
    if (WS_END + B.bytes + (size_t)dbg::SO * 4096 + 4096 > ws_size) { fprintf(stderr, "debug: ws too small\n"); return; }
    float* res = (float*)(ws + 512 * 1024);
    orc::run(stream, d_in, dbg::OB, dbg::SO, B, oout);
    const int SO = dbg::SO; int st = 0;
    auto P = [&](int p) { launch_range(stream, a, p, p + 1, 0); };
    P(0); P(1);
    dbg::cmp(stream, res, 0, ws + WS_MOD + (size_t)dbg::OB * 6144 * 4, 7, 6144, 0, B.mod, 6144, 0, 1, 6144);
    P(2);
    dbg::cmp(stream, res, 1, ws + WS_PS, 1, NPS, 0, B.P, 4256, 0, SO, 416);
    dbg::cmp(stream, res, 2, ws + WS_PS, 1, NPS, 512, B.P, 4256, 416, SO, 1792);
    dbg::cmp(stream, res, 3, d_out, 6, 2048, 0, B.P, 4256, 2208, SO, 2048);
    P(3); P(4);
    dbg::cmp(stream, res, 4, ws + WS_QRAW, 1, 768, 0, B.q, 768, 0, SO, 768);
    dbg::cmp(stream, res, 5, ws + WS_KVRAW, 1, 1024, 0, B.kv, 1024, 0, SO, 1024);
    dbg::cmp(stream, res, 6, ws + WS_GG, 1, 512, 0, B.g, 512, 0, SO, 512);
    P(5);
    dbg::cmp(stream, res, 7, ws + WS_Q, 2, 0, 0, B.qf, 768, 0, SO, 768);
    dbg::cmp(stream, res, 8, ws + WS_K, 3, 0, 0, B.kf, 768, 0, SO, 768);
    dbg::cmp(stream, res, 9, ws + WS_V, 4, 0, 0, B.vf, 512, 0, SO, 512);
    P(6); P(7); P(8);
    dbg::cmp(stream, res, 11, ws + WS_OA, 1, 512, 0, B.oa, 512, 0, SO, 512);
    dbg::cmp(stream, res, 20, ws + WS_WM + (size_t)(dbg::OB * 8 * 64) * 16384, 9, 0, 0, B.sdump, 0, 0, 64, 4096);
    dbg::cmp(stream, res, 21, ws + WS_WN + (size_t)(dbg::OB * 8 * 64) * 16384, 9, 0, 0, B.sdump, 0, 0, 64, 4096);
    dbg::cmp(stream, res, 22, ws + WS_WQ1 + (size_t)(dbg::OB * 8 * 64) * 8192, 10, 0, 0, B.sdump, 0, 0, 64, 4096);
    dbg::cmp(stream, res, 23, ws + WS_WQ2 + (size_t)(dbg::OB * 8 * 64) * 8192, 10, 0, 0, B.sdump, 0, 0, 64, 4096);
    dbg::cmp(stream, res, 32, ws + WS_WM + (size_t)(dbg::OB * 8 * 64) * 16384, 13, 0, 0, B.sdump, 0, 0, 64, 4096);
    dbg::cmp(stream, res, 33, ws + WS_WM + (size_t)(dbg::OB * 8 * 64) * 16384, 13, 1, 0, B.sdump, 0, 0, 64, 4096);
    dbg::cmp(stream, res, 34, ws + WS_WM + (size_t)(dbg::OB * 8 * 64) * 16384, 13, 2, 0, B.sdump, 0, 0, 64, 4096);
    dbg::cmp(stream, res, 35, ws + WS_WM + (size_t)(dbg::OB * 8 * 64) * 16384, 13, 3, 0, B.sdump, 0, 0, 64, 4096);
    dbg::cmp(stream, res, 30, ws + WS_WM + (size_t)(dbg::OB * 8 * 64) * 16384, 12, 100, 0, B.sdump, 0, 0, 1, 4096);
    dbg::cmp(stream, res, 31, ws + WS_WM + (size_t)(dbg::OB * 8 * 64 + 1) * 16384, 12, 100, 0, B.sdump, 0, 0, 63, 4096);
    dbg::cmp(stream, res, 28, ws + WS_WM + (size_t)(dbg::OB * 8 * 64) * 16384, 12, 11, 0, B.sdump, 0, 0, 64, 4096);
    dbg::cmp(stream, res, 29, ws + WS_WM + (size_t)(dbg::OB * 8 * 64) * 16384, 12, 100, 0, B.sdump, 0, 0, 64, 4096);
    dbg::cmp(stream, res, 26, ws + WS_WM + (size_t)(dbg::OB * 8 * 64) * 16384, 12, 0, 0, B.sdump, 0, 0, 64, 4096);
    dbg::cmp(stream, res, 27, ws + WS_WBS + (size_t)dbg::OB * 4096 * 32, 9, 0, 0, B.sdump, 0, 0, 4096, 8);
    dbg::cmp(stream, res, 24, ws + WS_WM + (size_t)(dbg::OB * 8 * 64) * 16384, 9, 0, 0, B.sdump, 0, 0, 1, 4096);
    dbg::cmp(stream, res, 12, ws + WS_WSB, 8, 0, 0, B.sdump, 0, 0, 8 * (SO / 64), 4096);
    dbg::cmp(stream, res, 18, ws + WS_WSB, 8, 1, 0, B.sdump, 0, 0, 8 * (SO / 64), 4096);
    dbg::cmp(stream, res, 19, ws + WS_WSB, 8, 2, 0, B.sdump, 0, 0, 8 * (SO / 64), 4096);
    dbg::cmp(stream, res, 13, ws + WS_OBIN, 1, 512, 0, B.yb, 512, 0, SO, 512);
    P(9);
    dbg::cmp(stream, res, 14, ws + WS_MERGED, 1, 1024, 0, B.merged, 1024, 0, SO, 1024);
    P(10);
    dbg::cmp(stream, res, 15, d_out, 0, 1024, 0, B.x1, 1024, 0, SO, 1024);
    P(11);
    P(12); P(13); P(14); P(15);
    dbg::cmp(stream, res, 17, d_out, 0, 1024, 0, oout, 1024, 0, SO, 1024);
    hipLaunchKernelGGL(dbg::k_verdict, dim3(1024), dim3(256), 0, stream, res, 18, (float*)d_out, (size_t)T * 1024);
    (void)st;
#endif
}
```
